# Optimizing an MI355X kernel written in HIP

```python
import jax, jax.numpy as jnp
from jax import lax
import numpy as np

D_MODEL = 1024
BATCH = 4
SEQ = 8192
DEPTH = 2

GRID_W = 64
CTX_LEN = 256
HEAD_DIM = 64
N_Q_HEADS = 12
N_KV_HEADS = 4
Q_PER_KV = N_Q_HEADS // N_KV_HEADS
ATTN_W = N_Q_HEADS * HEAD_DIM
KV_W = N_KV_HEADS * HEAD_DIM
ROPE_THETA = 10000.0
ROPE_PAIRS = HEAD_DIM // 4
Q_BLOCK = 128
N_FGROUPS = 4
FGROUP_W = 64
FNET_W = N_FGROUPS * FGROUP_W
EVEN_MIX_W = ATTN_W + FNET_W
EVEN_IN_W = 2 * ATTN_W + 2 * KV_W + 2 * FNET_W
EVEN_SPLITS = [ATTN_W, 2 * ATTN_W, 2 * ATTN_W + KV_W, 2 * ATTN_W + 2 * KV_W, 2 * ATTN_W + 2 * KV_W + FNET_W]
MLSTM_HEADS = 4
MLSTM_HEAD_DIM = 256
MLSTM_W = MLSTM_HEADS * MLSTM_HEAD_DIM
CHUNK = 128
N_GATES = 4 * MLSTM_HEADS
ODD_IN_W = 5 * MLSTM_W + N_GATES
ODD_SPLITS = [MLSTM_W, 2 * MLSTM_W, 3 * MLSTM_W, 4 * MLSTM_W, 5 * MLSTM_W]

N_EVEN = (DEPTH + 1) // 2
N_ODD = DEPTH // 2
ALPHA = (2.0 * DEPTH) ** 0.25
BETA = (8.0 * DEPTH) ** -0.25
EPS = 1e-6

kernel_name = 'hybrid_gqa_fnet_mlstm_prefix_dit'


def layer_norm(x):
    xf = x.astype(jnp.float32)
    mu = jnp.mean(xf, -1, keepdims=True)
    var = jnp.mean(jnp.square(xf - mu), -1, keepdims=True)
    return ((xf - mu) * lax.rsqrt(var + EPS)).astype(x.dtype)


def rms_norm(x, gain):
    xf = x.astype(jnp.float32)
    y = xf * lax.rsqrt(jnp.mean(jnp.square(xf), -1, keepdims=True) + EPS)
    return (y * gain.astype(jnp.float32)).astype(x.dtype)


def axial_rope_tables(n_tokens):
    rows = n_tokens // GRID_W
    row_idx = jnp.repeat(jnp.arange(rows, dtype=jnp.float32), GRID_W)
    col_idx = jnp.tile(jnp.arange(GRID_W, dtype=jnp.float32), rows)
    inv_freq = jnp.power(ROPE_THETA, -jnp.arange(ROPE_PAIRS, dtype=jnp.float32) / ROPE_PAIRS)
    ang = jnp.concatenate([row_idx[:, None] * inv_freq, col_idx[:, None] * inv_freq], axis=-1)
    return jnp.cos(ang), jnp.sin(ang)


def apply_rope(x, cos, sin):
    xf = x.astype(jnp.float32)
    half = HEAD_DIM // 2
    x1, x2 = xf[..., :half], xf[..., half:]
    cs, sn = cos[None, :, None, :], sin[None, :, None, :]
    return jnp.concatenate([x1 * cs - x2 * sn, x1 * sn + x2 * cs], axis=-1).astype(x.dtype)


def attend(q, k, v):
    s = jnp.einsum('bqhgd,bkhd->bhgqk', q, k, preferred_element_type=jnp.float32) * (HEAD_DIM ** -0.5)
    p = jax.nn.softmax(s, axis=-1).astype(v.dtype)
    return jnp.einsum('bhgqk,bkhd->bqhgd', p, v)


def blocked_attention(q, k, v):
    b, t = q.shape[:2]
    nb = t // Q_BLOCK
    qb = q.reshape(b, nb, Q_BLOCK, N_KV_HEADS, Q_PER_KV, HEAD_DIM).transpose(1, 0, 2, 3, 4, 5)
    o = lax.map(lambda qi: attend(qi, k, v), qb)
    return o.transpose(1, 0, 2, 3, 4, 5).reshape(b, t, ATTN_W)


def fourier_mix(u, gain, w_mix):
    un = rms_norm(u, gain).astype(jnp.float32)
    f = jnp.fft.fft2(un, axes=(1, 3), norm='ortho').real.astype(u.dtype)
    return jnp.einsum('btgc,gcd->btgd', f, w_mix)


def mlstm_scan(q, k, v, log_i, log_f, state):
    b, t, h, d = q.shape
    nc = t // CHUNK
    to_chunks = lambda a: a.reshape(b, nc, CHUNK, h, d).transpose(1, 0, 3, 2, 4)
    g_chunks = lambda a: a.reshape(b, nc, CHUNK, h).transpose(1, 0, 3, 2)
    mask = jnp.tril(jnp.ones((CHUNK, CHUNK), dtype=bool))

    def step(carry, inp):
        c_mat, n_vec, m = carry
        qc, kc, vc, li, lf = inp
        cum = jnp.cumsum(lf, axis=-1)
        d_log = jnp.where(mask, cum[..., :, None] - cum[..., None, :] + li[..., None, :], -jnp.inf)
        inter = cum + m[..., None]
        m_t = jnp.maximum(inter, jnp.max(d_log, axis=-1))
        d_w = jnp.exp(d_log - m_t[..., None])
        inter_w = jnp.exp(inter - m_t)
        s = jnp.einsum('bhtd,bhsd->bhts', qc, kc) * d_w
        num = jnp.einsum('bhts,bhse->bhte', s, vc) + inter_w[..., None] * jnp.einsum('bhtd,bhde->bhte', qc, c_mat)
        den = jnp.sum(s, axis=-1) + inter_w * jnp.einsum('bhtd,bhd->bht', qc, n_vec)
        out = num / jnp.maximum(jnp.abs(den), jnp.exp(-m_t))[..., None]
        tot = cum[..., -1]
        w_log = tot[..., None] - cum + li
        m_new = jnp.maximum(tot + m, jnp.max(w_log, axis=-1))
        w = jnp.exp(w_log - m_new[..., None])
        decay = jnp.exp(tot + m - m_new)
        kw = kc * w[..., None]
        c_new = decay[..., None, None] * c_mat + jnp.einsum('bhsd,bhse->bhde', kw, vc)
        n_new = decay[..., None] * n_vec + jnp.sum(kw, axis=2)
        return (c_new, n_new, m_new), out

    state, outs = lax.scan(step, state, (to_chunks(q), to_chunks(k), to_chunks(v), g_chunks(log_i), g_chunks(log_f)))
    return outs.transpose(1, 0, 3, 2, 4).reshape(b, t, h, d), state


def zero_state(b):
    return (jnp.zeros((b, MLSTM_HEADS, MLSTM_HEAD_DIM, MLSTM_HEAD_DIM), jnp.float32),
            jnp.zeros((b, MLSTM_HEADS, MLSTM_HEAD_DIM), jnp.float32),
            jnp.zeros((b, MLSTM_HEADS), jnp.float32))


def bidir_mlstm(q, k, v, gates, state_f, state_b):
    li_f, lf_f, li_b, lf_b = gates
    flip = lambda a: jnp.flip(a, axis=1)
    h_f, end_f = mlstm_scan(q, k, v, li_f, lf_f, state_f)
    h_b, end_b = mlstm_scan(flip(q), flip(k), flip(v), flip(li_b), flip(lf_b), state_b)
    return h_f + flip(h_b), end_f, end_b


def even_mixer(h_lat, h_ctx, w_in, q_gain, k_gain, f_gain, w_fmix, w_out, cos, sin, need_ctx):
    def project(h):
        b, t = h.shape[:2]
        q, ga, k, v, u, gb = jnp.split(h @ w_in, EVEN_SPLITS, axis=-1)
        q = rms_norm(q.reshape(b, t, N_Q_HEADS, HEAD_DIM), q_gain)
        k = rms_norm(k.reshape(b, t, N_KV_HEADS, HEAD_DIM), k_gain)
        return q, ga, k, v.reshape(b, t, N_KV_HEADS, HEAD_DIM), u.reshape(b, t, N_FGROUPS, FGROUP_W), gb

    def merge(a, ga, f, gb):
        b, t = ga.shape[:2]
        y = jnp.concatenate([a * jax.nn.silu(ga), f.reshape(b, t, FNET_W) * jax.nn.silu(gb)], axis=-1)
        return y @ w_out

    qc, gac, kc, vc, uc, gbc = project(h_ctx)
    ql, gal, kl, vl, ul, gbl = project(h_lat)
    ql = apply_rope(ql, cos, sin)
    kl = apply_rope(kl, cos, sin)
    k_all = jnp.concatenate([kc, kl], axis=1)
    v_all = jnp.concatenate([vc, vl], axis=1)
    y_lat = merge(blocked_attention(ql, k_all, v_all), gal, fourier_mix(ul, f_gain, w_fmix), gbl)
    y_ctx = None
    if need_ctx:
        b, t = qc.shape[:2]
        a_ctx = attend(qc.reshape(b, t, N_KV_HEADS, Q_PER_KV, HEAD_DIM), kc, vc).reshape(b, t, ATTN_W)
        y_ctx = merge(a_ctx, gac, fourier_mix(uc, f_gain, w_fmix), gbc)
    return y_lat, y_ctx


def odd_mixer(h_lat, h_ctx, w_in, gate_bias, w_out, need_ctx):
    def project(h):
        b, t = h.shape[:2]
        q, k, v, o, z, g = jnp.split(h @ w_in, ODD_SPLITS, axis=-1)
        heads = lambda a: a.astype(jnp.float32).reshape(b, t, MLSTM_HEADS, MLSTM_HEAD_DIM)
        g = (g.astype(jnp.float32) + gate_bias.astype(jnp.float32)).reshape(b, t, 4, MLSTM_HEADS)
        gates = (g[:, :, 0], jax.nn.log_sigmoid(g[:, :, 1]), g[:, :, 2], jax.nn.log_sigmoid(g[:, :, 3]))
        return heads(q), heads(k) * (MLSTM_HEAD_DIM ** -0.5), heads(v), o, z, gates

    def merge(hsum, o, z):
        b, t = o.shape[:2]
        y = jax.nn.sigmoid(o) * hsum.reshape(b, t, MLSTM_W).astype(o.dtype) * jax.nn.silu(z)
        return y @ w_out

    b = h_lat.shape[0]
    qc, kc, vc, oc, zc, gc = project(h_ctx)
    hc, end_f, end_b = bidir_mlstm(qc, kc, vc, gc, zero_state(b), zero_state(b))
    ql, kl, vl, ol, zl, gl = project(h_lat)
    hl, _, _ = bidir_mlstm(ql, kl, vl, gl, end_f, end_b)
    y_lat = merge(hl, ol, zl)
    y_ctx = merge(hc, oc, zc) if need_ctx else None
    return y_lat, y_ctx


def setup_inputs(seed: int = 0) -> dict:
    key = jax.random.key(seed)
    ks = jax.random.split(key, 17)
    nrm = lambda k, shape, std: jax.random.normal(k, shape, jnp.float32) * std
    lin = jnp.linspace(3.0, 6.0, MLSTM_HEADS, dtype=jnp.float32)
    zer = jnp.zeros((MLSTM_HEADS,), jnp.float32)
    gate_base = jnp.concatenate([zer, lin, zer, lin])
    return {
        'x': nrm(ks[0], (BATCH, SEQ, D_MODEL), 1.0),
        'c': nrm(ks[1], (BATCH, D_MODEL), 1.0),
        'ctx': nrm(ks[2], (BATCH, CTX_LEN, D_MODEL), 1.0),
        'c_ctx': nrm(ks[3], (D_MODEL,), 1.0),
        'ada_w': nrm(ks[4], (DEPTH, D_MODEL, 3 * D_MODEL), 0.5 * D_MODEL ** -0.5),
        'ada_b': nrm(ks[5], (DEPTH, 3 * D_MODEL), 0.02),
        'post_ln_gain': 1.0 + nrm(ks[6], (DEPTH, D_MODEL), 0.02),
        'post_ln_bias': nrm(ks[7], (DEPTH, D_MODEL), 0.02),
        'even_w_in': nrm(ks[8], (N_EVEN, D_MODEL, EVEN_IN_W), D_MODEL ** -0.5),
        'even_q_gain': 1.0 + nrm(ks[9], (N_EVEN, HEAD_DIM), 0.02),
        'even_k_gain': 1.0 + nrm(ks[10], (N_EVEN, HEAD_DIM), 0.02),
        'even_f_gain': 1.0 + nrm(ks[11], (N_EVEN, N_FGROUPS, FGROUP_W), 0.02),
        'even_w_fmix': nrm(ks[12], (N_EVEN, N_FGROUPS, FGROUP_W, FGROUP_W), FGROUP_W ** -0.5),
        'even_w_out': nrm(ks[13], (N_EVEN, EVEN_MIX_W, D_MODEL), BETA * EVEN_MIX_W ** -0.5),
        'odd_w_in': nrm(ks[14], (N_ODD, D_MODEL, ODD_IN_W), D_MODEL ** -0.5),
        'odd_gate_bias': gate_base + nrm(ks[15], (N_ODD, N_GATES), 0.1),
        'odd_w_out': nrm(ks[16], (N_ODD, MLSTM_W, D_MODEL), BETA * MLSTM_W ** -0.5),
    }


def reference(x, c, ctx, c_ctx, ada_w, ada_b, post_ln_gain, post_ln_bias,
              even_w_in, even_q_gain, even_k_gain, even_f_gain, even_w_fmix, even_w_out,
              odd_w_in, odd_gate_bias, odd_w_out):
    n_tokens = x.shape[1]
    cos, sin = axial_rope_tables(n_tokens)
    silu_c = jax.nn.silu(c)
    silu_cc = jax.nn.silu(c_ctx)
    for i in range(DEPTH):
        last = i == DEPTH - 1
        sh_l, sc_l, g_l = jnp.split(silu_c @ ada_w[i] + ada_b[i], 3, axis=-1)
        sh_c, sc_c, g_c = jnp.split(silu_cc @ ada_w[i] + ada_b[i], 3, axis=-1)
        h_lat = layer_norm(x) * (1.0 + sc_l[:, None, :]) + sh_l[:, None, :]
        h_ctx = layer_norm(ctx) * (1.0 + sc_c) + sh_c
        if i % 2 == 0:
            j = i // 2
            y_lat, y_ctx = even_mixer(h_lat, h_ctx, even_w_in[j], even_q_gain[j], even_k_gain[j],
                                      even_f_gain[j], even_w_fmix[j], even_w_out[j], cos, sin, not last)
        else:
            j = i // 2
            y_lat, y_ctx = odd_mixer(h_lat, h_ctx, odd_w_in[j], odd_gate_bias[j], odd_w_out[j], not last)
        x = layer_norm(ALPHA * x + g_l[:, None, :] * y_lat) * post_ln_gain[i] + post_ln_bias[i]
        if not last:
            ctx = layer_norm(ALPHA * ctx + g_c * y_ctx) * post_ln_gain[i] + post_ln_bias[i]
    return x
```

```cpp
#include <hip/hip_runtime.h>
#include <hip/hip_bf16.h>
#include <cstdio>
#include <cstdint>
#include <cmath>
namespace pg8 {
#define PG8_LAS __attribute__((address_space(3)))
typedef unsigned short bf16_t;
typedef short bf16x8 __attribute__((ext_vector_type(8)));
typedef float f32x4 __attribute__((ext_vector_type(4)));
typedef unsigned u32x4 __attribute__((ext_vector_type(4)));
constexpr int BM = 256, BK = 64, HALF = 128, HTB = HALF * BK * 2  , STAGE_BYTES = 8 * HTB, NXCD = 8, WGM = 8;

__host__ __device__ __forceinline__ int lds_byte(int r, int c) { const int st = (r >> 4) * 2 + (c >> 5), rr = r & 15, cc = c & 31, ob = rr * 64 + cc * 2; return st * 1024 + (ob ^ (((ob >> 9) & 1) << 5)); }
__host__ __device__ __forceinline__ void stage_rc(int b, int& R, int& C) { const int st = b / 1024, sb = b % 1024, swz = sb ^ (((sb >> 9) & 1) << 5); R = (st >> 1) * 16 + swz / 64; C = (st & 1) * 32 + (swz % 64) / 2; }
__host__ __device__ __forceinline__ int perm32(int rho) { const int n = rho >> 4, i = rho & 15; return 8 * (i >> 2) + 4 * n + (i & 3); }

struct Unit { int pm, pn; };
struct Gemm { const bf16_t* A; const bf16_t* Bt; int M, N, K; };

struct StaticOrder {
    int nM, nN, nwg, G, c;
    __host__ __device__ void init(int M, int N, int G_, int c_) { nM = M / BM; nN = N / BM; nwg = nM * nN; G = G_; c = c_; }
    __host__ __device__ bool next(int i, Unit& u) const {
        const long L = (long)i * G + c; if (L >= nwg) return false;
        int wgid = (int)L; { const int q = nwg / NXCD, r = nwg % NXCD, xcd = wgid % NXCD, off = wgid / NXCD; wgid = (xcd < r ? xcd * (q + 1) : r * (q + 1) + (xcd - r) * q) + off; }
        const int nig = WGM * nN, gid = wgid / nig, fm = gid * WGM, gsz = (nM - fm) < WGM ? (nM - fm) : WGM;
        u.pm = fm + ((wgid % nig) % gsz); u.pn = (wgid % nig) / gsz; return true;
    }
    __device__ __forceinline__ void a_ready(const Unit&) const {}
    __device__ __forceinline__ void done(const Unit&) const {}
};


__device__ __forceinline__ unsigned cvt_pk_bf16(float lo, float hi) { unsigned r; asm volatile("v_cvt_pk_bf16_f32 %0, %1, %2" : "=v"(r) : "v"(lo), "v"(hi)); return r; }
template <class Epi, class Sched, bool ALIGN_EPI = false, bool SP2 = false>
__device__ __forceinline__ void gemm_phase(PG8_LAS unsigned char* lds, const Gemm g, const Sched& S, const Epi& E) {
    const int tid = threadIdx.x, wid = __builtin_amdgcn_readfirstlane(tid >> 6), lane = tid & 63, wr = wid >> 2, wc = wid & 3, fr = lane & 15, fq = lane >> 4;
    const int K = g.K, nt = K / BK;
    unsigned voffA[2], voffB[2];
#pragma unroll
    for (int i = 0; i < 2; ++i) { int R, C; stage_rc(tid * 16 + i * 8192, R, C); const int Rb = Epi::PERM ? ((R & ~31) + perm32(R & 31)) : R;
        voffA[i] = (unsigned)(R * K + C) * 2u; voffB[i] = (unsigned)(Rb * K + C) * 2u; }
    const size_t kstep = (size_t)(BK * 2);
    const size_t hstep = (size_t)HALF * K * 2;
    const size_t tstep = 2 * hstep;
    const unsigned ldsw = (unsigned)wid * 1024u;
    const int aoff = lds_byte(wr * 64 + fr, fq * 8), boff = lds_byte(wc * 32 + fr, fq * 8);
#define PG8_SA(b, h) (((b) * 2 + (h)) * HTB)
#define PG8_SB(b, h) ((4 + (b) * 2 + (h)) * HTB)
#define PG8_STAGE(bufoff, gbase, voff) do { _Pragma("unroll") for (int _i = 0; _i < 2; ++_i) \
        __builtin_amdgcn_global_load_lds((const unsigned*)((const char*)(gbase) + (voff)[_i]), (PG8_LAS unsigned*)(lds + (bufoff) + ldsw + _i * 8192), 16, 0, 0); } while (0)
#define PG8_LDA(dst, b, h) do { _Pragma("unroll") for (int m = 0; m < 4; ++m) _Pragma("unroll") for (int k = 0; k < 2; ++k) dst[m][k] = *(const PG8_LAS bf16x8*)(lds + PG8_SA(b, h) + aoff + m * 2048 + k * 1024); } while (0)
#define PG8_LDB(dst, b, h) do { _Pragma("unroll") for (int n = 0; n < 2; ++n) _Pragma("unroll") for (int k = 0; k < 2; ++k) dst[n][k] = *(const PG8_LAS bf16x8*)(lds + PG8_SB(b, h) + boff + n * 2048 + k * 1024); } while (0)
#define PG8_MMA(ai, bj, At, Bt) do { __builtin_amdgcn_s_setprio(1); _Pragma("unroll") for (int m = 0; m < 4; ++m) _Pragma("unroll") for (int n = 0; n < 2; ++n) _Pragma("unroll") for (int k = 0; k < 2; ++k) \
        acc[ai][bj][m][n] = __builtin_amdgcn_mfma_f32_16x16x32_bf16(Bt[n][k], At[m][k], acc[ai][bj][m][n], 0, 0, 0); __builtin_amdgcn_s_setprio(0); } while (0)
#define PG8_WAIT_V(n) asm volatile("s_waitcnt vmcnt(" #n ")" ::: "memory")
#define PG8_WAIT_L(n) asm volatile("s_waitcnt lgkmcnt(" #n ")" ::: "memory")
#define PG8_BAR __builtin_amdgcn_s_barrier()
#define PG8_SCHED __builtin_amdgcn_sched_barrier(0)
    Unit cur, nxt; int ui = 0;
    if (!S.next(0, cur)) return;
    f32x4 acc[2][2][4][2];
#pragma unroll
    for (int a = 0; a < 2; ++a)
#pragma unroll
        for (int b = 0; b < 2; ++b)
#pragma unroll
            for (int m = 0; m < 4; ++m)
#pragma unroll
                for (int n = 0; n < 2; ++n) acc[a][b][m][n] = (f32x4){0.f, 0.f, 0.f, 0.f};
    bf16x8 At[4][2], B0[2][2], B1[2][2];
    const char* cA = (const char*)g.A + (size_t)cur.pm * tstep; const char* cB = (const char*)g.Bt + (size_t)cur.pn * tstep;
    S.a_ready(cur);
    if constexpr (SP2) {
        PG8_STAGE(PG8_SB(0, 0), cB, voffB); PG8_STAGE(PG8_SB(0, 1), cB + hstep, voffB); PG8_STAGE(PG8_SA(0, 0), cA, voffA); PG8_STAGE(PG8_SA(0, 1), cA + hstep, voffA);
        if (wr == 1) PG8_BAR;
        PG8_WAIT_V(2); PG8_BAR;
        PG8_STAGE(PG8_SB(1, 0), cB + kstep, voffB); PG8_STAGE(PG8_SA(1, 0), cA + kstep, voffA); PG8_STAGE(PG8_SB(1, 1), cB + hstep + kstep, voffB);
        PG8_WAIT_V(6); PG8_BAR;
    } else {
        PG8_STAGE(PG8_SB(0, 0), cB, voffB); PG8_STAGE(PG8_SA(0, 0), cA, voffA); PG8_STAGE(PG8_SB(0, 1), cB + hstep, voffB); PG8_STAGE(PG8_SA(0, 1), cA + hstep, voffA);
        if (wr == 1) PG8_BAR;
        PG8_WAIT_V(4); PG8_BAR;
        PG8_STAGE(PG8_SB(1, 0), cB + kstep, voffB); PG8_STAGE(PG8_SA(1, 0), cA + kstep, voffA); PG8_STAGE(PG8_SB(1, 1), cB + hstep + kstep, voffB);
        PG8_WAIT_V(6); PG8_BAR;
    }
    for (;;) {
        const bool has_next = S.next(ui + 1, nxt);
        const char* nA = has_next ? (const char*)g.A + (size_t)nxt.pm * tstep : cA; const char* nB = has_next ? (const char*)g.Bt + (size_t)nxt.pn * tstep : cB;
        for (int t = 0; t < nt; t += 2) {
            const bool last = (t == nt - 2);
            const char* a1 = cA + (size_t)(t + 1) * kstep;
            const char* a2 = last ? nA : cA + (size_t)(t + 2) * kstep; const char* b2 = last ? nB : cB + (size_t)(t + 2) * kstep;
            const char* a3 = a2 + kstep; const char* b3 = b2 + kstep;
            if (last && has_next) S.a_ready(nxt);
            if constexpr (SP2) {
            PG8_LDB(B0, 0, 0); PG8_LDB(B1, 0, 1); PG8_SCHED; PG8_LDA(At, 0, 0); PG8_STAGE(PG8_SA(1, 1), a1 + hstep, voffA);
            PG8_WAIT_V(8); PG8_WAIT_L(0); PG8_BAR; PG8_MMA(0, 0, At, B0); PG8_MMA(0, 1, At, B1); PG8_BAR; PG8_SCHED;
            PG8_LDA(At, 0, 1); PG8_STAGE(PG8_SB(0, 0), b2, voffB); PG8_STAGE(PG8_SB(0, 1), b2 + hstep, voffB); PG8_STAGE(PG8_SA(0, 0), a2, voffA);
            PG8_WAIT_V(8); PG8_WAIT_L(0); PG8_BAR; PG8_MMA(1, 0, At, B0); PG8_MMA(1, 1, At, B1); PG8_BAR; PG8_SCHED;
            PG8_LDB(B0, 1, 0); PG8_LDB(B1, 1, 1); PG8_SCHED; PG8_LDA(At, 1, 0); PG8_STAGE(PG8_SA(0, 1), a2 + hstep, voffA);
            PG8_WAIT_V(8); PG8_WAIT_L(0); PG8_BAR; PG8_MMA(0, 0, At, B0); PG8_MMA(0, 1, At, B1); PG8_BAR; PG8_SCHED;
            PG8_LDA(At, 1, 1); PG8_STAGE(PG8_SB(1, 0), b3, voffB); PG8_STAGE(PG8_SB(1, 1), b3 + hstep, voffB); PG8_STAGE(PG8_SA(1, 0), a3, voffA);
            PG8_WAIT_V(8); PG8_WAIT_L(0); PG8_BAR; PG8_MMA(1, 0, At, B0); PG8_MMA(1, 1, At, B1); PG8_BAR; PG8_SCHED;
            } else {
            PG8_LDB(B0, 0, 0); PG8_SCHED; PG8_LDA(At, 0, 0); PG8_STAGE(PG8_SA(1, 1), a1 + hstep, voffA);
            PG8_WAIT_L(8); PG8_BAR; PG8_WAIT_L(0); PG8_MMA(0, 0, At, B0); PG8_BAR; PG8_SCHED;
            PG8_LDB(B1, 0, 1); PG8_STAGE(PG8_SB(0, 0), b2, voffB);
            PG8_BAR; PG8_WAIT_L(0); PG8_MMA(0, 1, At, B1); PG8_BAR;
            PG8_LDA(At, 0, 1); PG8_STAGE(PG8_SA(0, 0), a2, voffA);
            PG8_BAR; PG8_WAIT_L(0); PG8_MMA(1, 0, At, B0); PG8_BAR; PG8_SCHED;
            PG8_STAGE(PG8_SB(0, 1), b2 + hstep, voffB);
            PG8_WAIT_V(6); PG8_BAR; PG8_MMA(1, 1, At, B1); PG8_BAR;
            PG8_LDB(B0, 1, 0); PG8_SCHED; PG8_LDA(At, 1, 0); PG8_STAGE(PG8_SA(0, 1), a2 + hstep, voffA);
            PG8_WAIT_L(8); PG8_BAR; PG8_WAIT_L(0); PG8_MMA(0, 0, At, B0); PG8_BAR; PG8_SCHED;
            PG8_LDB(B1, 1, 1); PG8_STAGE(PG8_SB(1, 0), b3, voffB);
            PG8_BAR; PG8_WAIT_L(0); PG8_MMA(0, 1, At, B1); PG8_BAR;
            PG8_LDA(At, 1, 1); PG8_STAGE(PG8_SA(1, 0), a3, voffA);
            PG8_BAR; PG8_WAIT_L(0); PG8_MMA(1, 0, At, B0); PG8_BAR; PG8_SCHED;
            PG8_STAGE(PG8_SB(1, 1), b3 + hstep, voffB);
            PG8_WAIT_V(6); PG8_BAR; PG8_MMA(1, 1, At, B1); PG8_BAR;
            }
        }
        if constexpr (ALIGN_EPI) { if (wr == 0) PG8_BAR; }
        if constexpr (!Epi::AFTER_DRAIN) { E(acc, cur, wr, wc, fr, fq); S.done(cur); }
        if (!has_next) break;
#pragma unroll
        for (int a = 0; a < 2; ++a)
#pragma unroll
            for (int b = 0; b < 2; ++b)
#pragma unroll
                for (int m = 0; m < 4; ++m)
#pragma unroll
                    for (int n = 0; n < 2; ++n) acc[a][b][m][n] = (f32x4){0.f, 0.f, 0.f, 0.f};
        cur = nxt; cA = nA; cB = nB; ++ui;
        if constexpr (ALIGN_EPI) { if (wr == 1) PG8_BAR; }
    }
    PG8_WAIT_V(0);
    if constexpr (!ALIGN_EPI) { if (wr == 0) PG8_BAR; }
    PG8_BAR;
    if constexpr (Epi::AFTER_DRAIN) { E.fused(acc, cur, wr, wc, fr, fq, lds, wid, lane); S.done(cur); }
#undef PG8_SA
#undef PG8_SB
#undef PG8_STAGE
#undef PG8_LDA
#undef PG8_LDB
#undef PG8_MMA
#undef PG8_WAIT_V
#undef PG8_WAIT_L
#undef PG8_BAR
#undef PG8_SCHED
}
}


constexpr int BATCH = 4, SEQ = 8192, DM = 1024, CTXL = 256;
constexpr int MLAT = BATCH * SEQ, MCTX = BATCH * CTXL, MTOT = MLAT + MCTX;
constexpr int EVEN_N = 2560, ODD_N = 5120, ODD_IN_W = 5136;
constexpr int NKEYS = CTXL + SEQ;
constexpr int NSLOT = 66;
constexpr float LN_EPS = 1e-6f;
constexpr float ALPHA_RES = 1.4142135623730951f;
constexpr float QSCALE = 0.125f * 1.4426950408889634f;

namespace epi {
using pg8::f32x4; using pg8::u32x4; using pg8::bf16_t; using pg8::Unit;
__device__ __forceinline__ unsigned pk(float lo, float hi) { return pg8::cvt_pk_bf16(lo, hi); }
__device__ __forceinline__ float sigmoidf_(float v) { return 1.0f / (1.0f + __expf(-v)); }
__device__ __forceinline__ float siluf_(float v) { return v / (1.0f + __expf(-v)); }

struct EpiEven {
    static constexpr bool PERM = true, AFTER_DRAIN = false;
    bf16_t* Q0;
    static constexpr size_t oGA = (size_t)MTOT * 768, oKALL = oGA + (size_t)MTOT * 768, oVALL = oKALL + (size_t)BATCH * NKEYS * 256, oU = oVALL + (size_t)BATCH * NKEYS * 256, oGB = oU + (size_t)MTOT * 256;
    const float *qgain, *kgain, *fgain;
    const float* rope;
    __device__ __forceinline__ void operator()(const f32x4 (&acc)[2][2][4][2], const Unit& u, int wr, int wc, int fr, int fq) const {
        const int pm = u.pm, pn = u.pn;
        const bool lat = pm < 128;
        const int b = lat ? (pm >> 5) : (pm - 128);
        const int type = (pn < 3) ? 0 : (pn < 6) ? 1 : (pn - 4);
        const bool norm = (type == 0 || type == 2 || type == 4);
        const bool dorope = lat && (type == 0 || type == 2);
        f32x4 gn[2][2];
        if (norm) {
            const float* gp = (type == 0) ? qgain : (type == 2) ? kgain : (fgain + 64 * wc);
#pragma unroll
            for (int bj = 0; bj < 2; ++bj)
#pragma unroll
                for (int n = 0; n < 2; ++n) gn[bj][n] = *(const f32x4*)(gp + 32 * bj + 8 * fq + 4 * n);
        }
#pragma unroll
        for (int ai = 0; ai < 2; ++ai)
#pragma unroll
            for (int m = 0; m < 4; ++m) {
                const int rl = ai * 128 + wr * 64 + m * 16 + fr;
                const int mrow = pm * 256 + rl;
                const int t = lat ? ((pm & 31) * 256 + rl) : rl;
                f32x4 v[2][2];
#pragma unroll
                for (int bj = 0; bj < 2; ++bj)
#pragma unroll
                    for (int n = 0; n < 2; ++n) v[bj][n] = acc[ai][bj][m][n];
                if (norm) {
                    float ss = 0.f;
#pragma unroll
                    for (int bj = 0; bj < 2; ++bj)
#pragma unroll
                        for (int n = 0; n < 2; ++n) { const f32x4 x = v[bj][n]; ss += (x[0] * x[0] + x[1] * x[1]) + (x[2] * x[2] + x[3] * x[3]); }
                    ss += __shfl_xor(ss, 16); ss += __shfl_xor(ss, 32);
                    const float r = rsqrtf(ss * (1.0f / 64.0f) + LN_EPS);
#pragma unroll
                    for (int bj = 0; bj < 2; ++bj)
#pragma unroll
                        for (int n = 0; n < 2; ++n) v[bj][n] = v[bj][n] * r * gn[bj][n];
                }
                if (dorope) {
                    const float* cb = (fq < 2) ? (rope + (t >> 6) * 16) : (rope + 4096 + (t & 63) * 16);
                    const int so = (fq < 2) ? 2048 : 1024;
#pragma unroll
                    for (int n = 0; n < 2; ++n) {
                        const f32x4 c4 = *(const f32x4*)(cb + 8 * (fq & 1) + 4 * n), s4 = *(const f32x4*)(cb + so + 8 * (fq & 1) + 4 * n);
                        const f32x4 x1 = v[0][n], x2 = v[1][n];
                        v[0][n] = x1 * c4 - x2 * s4; v[1][n] = x1 * s4 + x2 * c4;
                    }
                }
                if (type == 0) {
#pragma unroll
                    for (int bj = 0; bj < 2; ++bj)
#pragma unroll
                        for (int n = 0; n < 2; ++n) v[bj][n] = v[bj][n] * QSCALE;
                } else if (type == 1 || type == 5) {
#pragma unroll
                    for (int bj = 0; bj < 2; ++bj)
#pragma unroll
                        for (int n = 0; n < 2; ++n) { f32x4 x = v[bj][n]; x[0] = siluf_(x[0]); x[1] = siluf_(x[1]); x[2] = siluf_(x[2]); x[3] = siluf_(x[3]); v[bj][n] = x; }
                }
                size_t doff;
                if (type == 0)      doff = (size_t)mrow * 768 + (4 * pn + wc) * 64;
                else if (type == 1) doff = oGA + (size_t)mrow * 768 + (pn - 3) * 256 + wc * 64;
                else if (type == 2) doff = oKALL + ((size_t)b * NKEYS + (lat ? 256 + t : t)) * 256 + wc * 64;
                else if (type == 3) doff = oVALL + ((size_t)b * NKEYS + (lat ? 256 + t : t)) * 256 + wc * 64;
                else if (type == 4) doff = oU + (size_t)mrow * 256 + wc * 64;
                else                doff = oGB + (size_t)mrow * 256 + wc * 64;
                bf16_t* dst = Q0 + doff;
#pragma unroll
                for (int bj = 0; bj < 2; ++bj) {
                    u32x4 w; w.x = pk(v[bj][0][0], v[bj][0][1]); w.y = pk(v[bj][0][2], v[bj][0][3]); w.z = pk(v[bj][1][0], v[bj][1][1]); w.w = pk(v[bj][1][2], v[bj][1][3]);
                    *(u32x4*)(dst + 32 * bj + 8 * fq) = w;
                }
            }
    }
};

struct EpiOdd {
    static constexpr bool PERM = true, AFTER_DRAIN = false;
    bf16_t *QB, *OG;
    __device__ __forceinline__ void operator()(const f32x4 (&acc)[2][2][4][2], const Unit& u, int wr, int wc, int fr, int fq) const {
        const int pm = u.pm, pn = u.pn;
        const bool lat = pm < 128;
        const int b = lat ? (pm >> 5) : (pm - 128);
#pragma unroll
        for (int ai = 0; ai < 2; ++ai)
#pragma unroll
            for (int m = 0; m < 4; ++m) {
                const int rl = ai * 128 + wr * 64 + m * 16 + fr;
                const int mrow = pm * 256 + rl;
                const int t = lat ? ((pm & 31) * 256 + rl) : rl;
                if (pn < 12) {
                    const int h = pn & 3;
                    bf16_t* base = QB + (size_t)(pn >> 2) * (size_t)(33 * 1024 * 1024);
                    const int slot = lat ? (2 + (t >> 7)) : (t >> 7);
                    bf16_t* dst = base + ((((size_t)(b * 4 + h) * NSLOT + slot) * 128 + (t & 127)) * 256) + wc * 32 + 8 * fq;
#pragma unroll
                    for (int bj = 0; bj < 2; ++bj) {
                        const f32x4 a0 = acc[ai][bj][m][0], a1 = acc[ai][bj][m][1];
                        u32x4 w; w.x = pk(a0[0], a0[1]); w.y = pk(a0[2], a0[3]); w.z = pk(a1[0], a1[1]); w.w = pk(a1[2], a1[3]);
                        *(u32x4*)(dst + 128 * bj) = w;
                    }
                } else {
                    float r[8];
#pragma unroll
                    for (int n = 0; n < 2; ++n)
#pragma unroll
                        for (int j = 0; j < 4; ++j) { const float o = acc[ai][0][m][n][j], z = acc[ai][1][m][n][j]; r[4 * n + j] = sigmoidf_(o) * siluf_(z); }
                    u32x4 w; w.x = pk(r[0], r[1]); w.y = pk(r[2], r[3]); w.z = pk(r[4], r[5]); w.w = pk(r[6], r[7]);
                    *(u32x4*)(OG + (size_t)mrow * 1024 + (pn - 12) * 128 + wc * 32 + 8 * fq) = w;
                }
            }
    }
};

struct EpiRes {
    static constexpr bool PERM = false, AFTER_DRAIN = false;
    const float* xlat; float* olat; const float* xctx; float* octx; const float* mod;
    __device__ __forceinline__ void operator()(const f32x4 (&acc)[2][2][4][2], const Unit& u, int wr, int wc, int fr, int fq) const {
        const int pm = u.pm, pn = u.pn;
        const bool lat = pm < 128;
        const int b = lat ? (pm >> 5) : (pm - 128);
        const float* gp = mod + (lat ? b : 4) * 3072 + 2048;
        const int col0 = pn * 256 + wc * 32 + 4 * fq;
        f32x4 gv[2][2];
#pragma unroll
        for (int bj = 0; bj < 2; ++bj)
#pragma unroll
            for (int n = 0; n < 2; ++n) gv[bj][n] = *(const f32x4*)(gp + col0 + bj * 128 + n * 16);
#pragma unroll
        for (int ai = 0; ai < 2; ++ai)
#pragma unroll
            for (int m = 0; m < 4; ++m) {
                const int rl = ai * 128 + wr * 64 + m * 16 + fr;
                const size_t roff = lat ? (size_t)(pm * 256 + rl) * 1024 : (size_t)((pm - 128) * 256 + rl) * 1024;
                const float* xr = (lat ? xlat : xctx) + roff + col0;
                float* orow = (lat ? olat : octx) + roff + col0;
#pragma unroll
                for (int bj = 0; bj < 2; ++bj)
#pragma unroll
                    for (int n = 0; n < 2; ++n) {
                        const f32x4 xv = *(const f32x4*)(xr + bj * 128 + n * 16);
                        *(f32x4*)(orow + bj * 128 + n * 16) = xv * ALPHA_RES + gv[bj][n] * acc[ai][bj][m][n];
                    }
            }
    }
};
}
#define GAS __attribute__((address_space(1)))
#define LAS __attribute__((address_space(3)))
typedef unsigned short bf16;
typedef unsigned v4u __attribute__((ext_vector_type(4)));
typedef float f32x4 __attribute__((ext_vector_type(4)));
typedef short bf16x8 __attribute__((ext_vector_type(8)));
typedef GAS unsigned gu32;
typedef GAS unsigned long long gu64;
#define RLX_AGENT __ATOMIC_RELAXED, __HIP_MEMORY_SCOPE_AGENT
#define LDS_WAIT() asm volatile("s_waitcnt lgkmcnt(0)" ::: "memory")
#define VM_WAIT() asm volatile("s_waitcnt vmcnt(0)" ::: "memory")
__device__ __forceinline__ unsigned long long rt() { return __builtin_amdgcn_s_memrealtime(); }
__device__ __forceinline__ unsigned f2bf(float f) { unsigned u = __builtin_bit_cast(unsigned, f); return (u + 0x7fffu + ((u >> 16) & 1u)) >> 16; }
__device__ __forceinline__ unsigned pk2(float lo, float hi) { return f2bf(lo) | (f2bf(hi) << 16); }

#define XB_TMO      128
#define XB_XCNT(j)  (256  + 64 * (j))
#define XB_XSUB(j)  (1280 + 64 * (j))
#define XB_XGEN(j)  (2304 + 64 * (j))
#define XB_TOP      3328
#define XB_TOPGEN   3392
#define XCD_BAR_WORDS 3456
#define XB_SPIN_CAP (1u << 18)

__device__ __forceinline__ unsigned xb_ld(unsigned* p)              { return __hip_atomic_load(p, __ATOMIC_RELAXED, __HIP_MEMORY_SCOPE_AGENT); }
__device__ __forceinline__ unsigned xb_add(unsigned* p, unsigned v) { return __hip_atomic_fetch_add(p, v, __ATOMIC_RELAXED, __HIP_MEMORY_SCOPE_AGENT); }
__device__ __forceinline__ unsigned xb_xcc_id() { return (unsigned)__builtin_amdgcn_s_getreg((3 << 11) | 20) & 0xFu; }
#define XB_SPIN(cond, bar) do { unsigned _sp = 0; while (cond) { __builtin_amdgcn_s_sleep(1); \
    if ((++_sp & 255u) == 0u) { if (xb_ld(&(bar)[XB_TMO])) break; if (_sp > XB_SPIN_CAP) { atomicAdd(&(bar)[XB_TMO], 1u); break; } } } } while (0)

struct XcdBarrier {
    unsigned* bar; unsigned x;
    volatile LAS unsigned* st;
};

__device__ __forceinline__ XcdBarrier xcd_barrier_post(unsigned* bar, volatile LAS unsigned* st) {
    XcdBarrier b; b.bar = bar; b.x = xb_xcc_id(); b.st = st;
    if (threadIdx.x == 0) (void)xb_add(&bar[XB_XCNT(b.x)], 1u);
    return b;
}
__device__ __forceinline__ void xcd_barrier_complete(unsigned* bar, unsigned x, unsigned& nloc, unsigned& nx) {
    const unsigned G = gridDim.x * gridDim.y * gridDim.z;
    unsigned sum, cnt, mine, sp = 0u;
    for (;;) {
        sum = 0u; cnt = 0u; mine = 0u;
#pragma unroll
        for (unsigned j = 0; j < 16; ++j) { const unsigned c = xb_ld(&bar[XB_XCNT(j)]); sum += c; cnt += (c > 0u) ? 1u : 0u; mine = (j == x) ? c : mine; }
        if (sum == G) break;
        __builtin_amdgcn_s_sleep(1);
        if ((++sp & 255u) == 0u) { if (xb_ld(&bar[XB_TMO])) break; if (sp > XB_SPIN_CAP) { atomicAdd(&bar[XB_TMO], 1u); break; } }
    }
    nloc = mine > 0u ? mine : 1u; nx = cnt > 0u ? cnt : 1u;
}

__device__ __forceinline__ void xcd_barrier(const XcdBarrier& b) {
    asm volatile("s_waitcnt vmcnt(0)" ::: "memory");
    __syncthreads();
    if (threadIdx.x == 0) {
        unsigned* bar = b.bar;
        __builtin_amdgcn_s_waitcnt(0);
        unsigned nloc = b.st[0], nx = b.st[1];
        if (nloc == 0u) { xcd_barrier_complete(bar, b.x, nloc, nx); b.st[0] = nloc; b.st[1] = nx; }
        const unsigned old = xb_add(&bar[XB_XSUB(b.x)], 1u);
        const unsigned gen = old / nloc;
        if (old + 1u == (gen + 1u) * nloc) {
            __builtin_amdgcn_fence(__ATOMIC_RELEASE, "agent");
            asm volatile("s_waitcnt vmcnt(0)" ::: "memory");
            const unsigned og = xb_add(&bar[XB_TOP], 1u);
            const unsigned tg = og / nx;
            if (og + 1u == (tg + 1u) * nx) xb_add(&bar[XB_TOPGEN], 1u);
            else XB_SPIN(xb_ld(&bar[XB_TOPGEN]) == tg, bar);
            __builtin_amdgcn_fence(__ATOMIC_ACQUIRE, "agent");
            xb_add(&bar[XB_XGEN(b.x)], 1u);
            asm volatile("s_waitcnt vmcnt(0)" ::: "memory");
        } else {
            XB_SPIN(xb_ld(&bar[XB_XGEN(b.x)]) == gen, bar);
            __builtin_amdgcn_fence(__ATOMIC_ACQUIRE, "agent");
            asm volatile("s_waitcnt vmcnt(0)" ::: "memory");
        }
    }
    __syncthreads();
}


constexpr int NWAVES = 8;
constexpr size_t MiB = 1u << 20, KiB = 1u << 10;
constexpr size_t WS_CTL = 0, CTL_ZERO_BYTES = 1 * MiB;
constexpr size_t WS_MOD = 1 * MiB;
constexpr size_t WS_ROPE = 1 * MiB + 128 * KiB;
constexpr size_t WS_MISCF = 1 * MiB + 160 * KiB;
constexpr size_t WS_WG = 1 * MiB + 192 * KiB;
constexpr size_t WS_FMT = 1 * MiB + 256 * KiB;
constexpr size_t WS_FMF = 1 * MiB + 320 * KiB;
constexpr size_t WS_A1 = 1 * MiB + 512 * KiB;
constexpr size_t WS_A2 = 1 * MiB + 640 * KiB;
constexpr size_t WS_TW = 1 * MiB + 704 * KiB;
constexpr size_t WS_CUM = 2 * MiB, WS_AA = 4 * MiB, WS_PM = 6 * MiB;
constexpr size_t WS_TOT = 8 * MiB, WS_AMAX = 8 * MiB + 16 * KiB;
constexpr size_t WS_W0T = 16 * MiB, WS_WO0T = 21 * MiB, WS_W1T = 23 * MiB, WS_WO1T = 33 * MiB;
constexpr size_t WS_H = 36 * MiB;
constexpr size_t WS_Q0 = 102 * MiB;
constexpr size_t WS_GA = WS_Q0 + (size_t)MTOT * 768 * 2;
constexpr size_t WS_KALL = WS_GA + (size_t)MTOT * 768 * 2;
constexpr size_t WS_VALL = WS_KALL + (size_t)BATCH * NKEYS * 256 * 2;
constexpr size_t WS_U = WS_VALL + (size_t)BATCH * NKEYS * 256 * 2;
constexpr size_t WS_GB = WS_U + (size_t)MTOT * 256 * 2;
constexpr size_t WS_Y = WS_GB + (size_t)MTOT * 256 * 2;
constexpr size_t WS_L0_END = WS_Y + (size_t)MTOT * 1024 * 2;
constexpr size_t WS_QB = 102 * MiB, WS_KB = 168 * MiB, WS_VB = 234 * MiB, WS_OG = 300 * MiB;
constexpr size_t WS_HF = 366 * MiB, WS_HB = 430 * MiB;
constexpr size_t WS_S = WS_H;
constexpr size_t WS_YMIX = WS_QB;
constexpr size_t WS_ZC = 494 * MiB;
constexpr size_t WS_END = 498 * MiB;
static_assert(WS_L0_END <= 366 * MiB && WS_W1T + (size_t)ODD_N * 1024 * 2 <= WS_WO1T && WS_H + (size_t)MTOT * 2048 <= WS_Q0, "d_ws map");

constexpr int CW_TMO = 0, CW_CODE = 1;
constexpr int CW_BAR = 4096;
constexpr int RING_OFF = 0, RING_BYTES = 131072;
constexpr int LDSCTL_OFF = RING_BYTES, MISC_OFF = LDSCTL_OFF + 320;
constexpr int LDS_BYTES = 147456;

struct Frame {
    LAS unsigned char* lds;
    volatile LAS unsigned* MISC;
    gu32* ctl;
    int tid, lane, wave;
    int vcu, G;
    unsigned char* ws;
    const float *x, *c, *ctx, *c_ctx, *ada_w, *ada_b, *pgain, *pbias, *w0, *qgain, *kgain, *fgain, *wfmix, *wo0, *w1, *gbias, *wo1;
    float* out;
};
__device__ __forceinline__ float wave_sum(float v) {
#pragma unroll
    for (int o = 1; o < 64; o <<= 1) v += __shfl_xor(v, o);
    return v;
}
__device__ __forceinline__ float silu_acc(float v) { return v / (1.0f + expf(-v)); }

constexpr int P0_ITEMS = 96 + 1 + 1 + 4 + 1 + 1;
__device__ __forceinline__ void p0_tables(Frame& F) {
    float* mod = (float*)(F.ws + WS_MOD);
    for (int it = blockIdx.x; it < P0_ITEMS; it += F.G) {
        __syncthreads();
        if (it < 96) {
            const int layer = it / 48, cb = it % 48;
            LAS float* sl = (LAS float*)(F.lds);
            LAS float* red = sl + 5 * 1024;
            for (int i = F.tid; i < 5 * 1024; i += NWAVES * 64) { const int r = i >> 10, k = i & 1023; const float v = (r < 4) ? F.c[r * 1024 + k] : F.c_ctx[k]; sl[i] = silu_acc(v); }
            __syncthreads();
            const int col = F.tid & 63, kg = F.tid >> 6;
            const float* W = F.ada_w + (size_t)layer * 1024 * 3072 + cb * 64 + col;
            float a[5] = {0.f, 0.f, 0.f, 0.f, 0.f};
            for (int k = kg * 128; k < kg * 128 + 128; ++k) { const float w = W[(size_t)k * 3072];
#pragma unroll
                for (int r = 0; r < 5; ++r) a[r] += sl[r * 1024 + k] * w; }
#pragma unroll
            for (int r = 0; r < 5; ++r) red[(kg * 5 + r) * 64 + col] = a[r];
            __syncthreads();
            if (F.tid < 320) { const int r = F.tid >> 6; float s = 0.f;
#pragma unroll
                for (int g = 0; g < 8; ++g) s += red[(g * 5 + r) * 64 + col];
                mod[(layer * 5 + r) * 3072 + cb * 64 + col] = s + F.ada_b[layer * 3072 + cb * 64 + col]; }
        } else if (it == 96) {
            float* rp = (float*)(F.ws + WS_ROPE);
            for (int i = F.tid; i < 3072; i += NWAVES * 64) {
                const int j = (i < 2048) ? i : (i - 2048); const int pos = j >> 4, fi = j & 15;
                const float invf = powf(10000.0f, -(float)fi / 16.0f); const float ang = (float)pos * invf;
                if (i < 2048) { rp[i] = cosf(ang); rp[2048 + i] = sinf(ang); } else { rp[4096 + j] = cosf(ang); rp[5120 + j] = sinf(ang); }
            }
        } else if (it == 97) {
            if (F.tid == 0) { float gq = 0.f, gk = 0.f; for (int i = 0; i < 64; ++i) { gq = fmaxf(gq, fabsf(F.qgain[i])); gk = fmaxf(gk, fabsf(F.kgain[i])); }
                ((float*)(F.ws + WS_MISCF))[0] = QSCALE * 64.0f * gq * gk * 1.001f; }
        } else if (it < 102) {
            const int g = it - 98;
            LAS float* cs = (LAS float*)(F.lds); LAS float* sn = cs + 64;
            if (F.tid < 64) { cs[F.tid] = cospif((float)F.tid / 32.0f); sn[F.tid] = sinpif((float)F.tid / 32.0f); }
            __syncthreads();
            bf16* fmt = (bf16*)(F.ws + WS_FMT) + (size_t)g * 128 * 64; float* fmf = (float*)(F.ws + WS_FMF) + (size_t)g * 64 * 64 * 2;
            const float* wm = F.wfmix + (size_t)g * 64 * 64;
            for (int i = F.tid; i < 64 * 64; i += NWAVES * 64) { const int cch = i >> 6, d = i & 63; float re = 0.f, im = 0.f;
                for (int kc = 0; kc < 64; ++kc) { const float w = wm[kc * 64 + d]; const int j = (kc * cch) & 63; re += cs[j] * w; im -= sn[j] * w; }
                re *= 0.0013810679320049757f; im *= 0.0013810679320049757f;
                fmf[(cch * 64 + d) * 2] = re; fmf[(cch * 64 + d) * 2 + 1] = im;
                fmt[(2 * d) * 64 + cch] = (bf16)f2bf(re); fmt[(2 * d + 1) * 64 + cch] = (bf16)f2bf(im); }
        } else if (it == 102) {
            LAS float* cs = (LAS float*)(F.lds); LAS float* sn = cs + 128;
            if (F.tid < 128) { cs[F.tid] = cospif((float)F.tid / 64.0f); sn[F.tid] = sinpif((float)F.tid / 64.0f); }
            __syncthreads();
            bf16* a1 = (bf16*)(F.ws + WS_A1);
            for (int i = F.tid; i < 256 * 256; i += NWAVES * 64) { const int row = i >> 8, col = i & 255; const int k1 = row >> 1, ro = row & 1, t1 = col >> 1, ri = col & 1; const int j = (k1 * t1) & 127;
                const float cv = cs[j], sv = sn[j]; const float v = (ro == 0) ? (ri == 0 ? cv : sv) : (ri == 0 ? -sv : cv); a1[i] = (bf16)f2bf(v); }
        } else {
            LAS float* cs = (LAS float*)(F.lds); LAS float* sn = cs + 64;
            if (F.tid < 64) { cs[F.tid] = cospif((float)F.tid / 32.0f); sn[F.tid] = sinpif((float)F.tid / 32.0f); }
            __syncthreads();
            bf16* a2 = (bf16*)(F.ws + WS_A2);
            for (int i = F.tid; i < 64 * 128; i += NWAVES * 64) { const int k2 = i >> 7, col = i & 127; const int t2 = col >> 1, ri = col & 1; const int j = (k2 * t2) & 63; a2[i] = (bf16)f2bf(ri == 0 ? cs[j] : sn[j]); }
            float* tw = (float*)(F.ws + WS_TW);
            for (int i = F.tid; i < 128 * 64; i += NWAVES * 64) { const int k1 = i >> 6, t2 = i & 63; const float a = (float)(k1 * t2) / 4096.0f; tw[2 * i] = cospif(a); tw[2 * i + 1] = sinpif(a); }
        }
    }
}

__device__ __forceinline__ void transpose_item(const float* W, int srcN, int n0, int kb, bf16* WT, int drow0, float scale, LAS float* scr, int lane) {
    const int k0 = 64 * kb;
#pragma unroll 8
    for (int i = 0; i < 32; ++i) { const int kk = 2 * i + (lane >> 5); scr[kk * 33 + (lane & 31)] = W[(size_t)(k0 + kk) * srcN + n0 + (lane & 31)] * scale; }
    LDS_WAIT(); asm volatile("" ::: "memory");
    const int c = lane & 7;
#pragma unroll
    for (int j = 0; j < 4; ++j) { const int n = (lane >> 3) + 8 * j; const LAS float* s = scr + (8 * c) * 33 + n;
        v4u o; o.x = pk2(s[0 * 33], s[1 * 33]); o.y = pk2(s[2 * 33], s[3 * 33]); o.z = pk2(s[4 * 33], s[5 * 33]); o.w = pk2(s[6 * 33], s[7 * 33]);
        *(GAS v4u*)(WT + (size_t)(drow0 + n) * 1024 + k0 + 8 * c) = o; }
    LDS_WAIT(); asm volatile("" ::: "memory");
}
__device__ __forceinline__ void ln_mod_row(const float* xrow, const float* sh, const float* sc, bf16* orow, int lane) {
    const GAS f32x4* xr = (const GAS f32x4*)xrow + lane;
    f32x4 v[4]; float s = 0.f;
#pragma unroll
    for (int j = 0; j < 4; ++j) { v[j] = xr[64 * j]; s += (v[j].x + v[j].y) + (v[j].z + v[j].w); }
    const float mean = wave_sum(s) * (1.f / 1024.f); float s2 = 0.f;
#pragma unroll
    for (int j = 0; j < 4; ++j) { v[j] = v[j] - mean; s2 += (v[j].x * v[j].x + v[j].y * v[j].y) + (v[j].z * v[j].z + v[j].w * v[j].w); }
    const float rstd = rsqrtf(wave_sum(s2) * (1.f / 1024.f) + LN_EPS);
    GAS unsigned long long* o8 = (GAS unsigned long long*)orow + lane;
#pragma unroll
    for (int j = 0; j < 4; ++j) { const f32x4 a = *((const f32x4*)sc + lane + 64 * j), bsh = *((const f32x4*)sh + lane + 64 * j);
        const f32x4 h = v[j] * rstd * (a + 1.0f) + bsh;
        o8[64 * j] = (unsigned long long)pk2(h.x, h.y) | ((unsigned long long)pk2(h.z, h.w) << 32); }
}
__device__ __forceinline__ void p1_weights_h0(Frame& F) {
    LAS float* scr = (LAS float*)(F.lds + RING_OFF + F.wave * 16384);
    const int gw = F.vcu * NWAVES + F.wave, NGW = F.G * NWAVES;
    constexpr int I_W0 = 16 * (EVEN_N / 32), I_WO = 16 * 32, I_W1 = 16 * (ODD_N / 32);
    constexpr int NITEMS = I_W0 + I_WO + I_W1 + I_WO;
    for (int it = gw; it < NITEMS; it += NGW) {
        int r = it;
        if (r < I_W0) { const int kb = r / (EVEN_N / 32), nb = r % (EVEN_N / 32), n0 = nb * 32; const int pn = n0 >> 8, L = n0 & 255, wc = L >> 6, bj = (L >> 5) & 1;
            transpose_item(F.w0, EVEN_N, n0, kb, (bf16*)(F.ws + WS_W0T), pn * 256 + bj * 128 + wc * 32, 1.0f, scr, F.lane); continue; } r -= I_W0;
        if (r < I_WO) { transpose_item(F.wo0, 1024, (r % 32) * 32, r / 32, (bf16*)(F.ws + WS_WO0T), (r % 32) * 32, 1.0f, scr, F.lane); continue; } r -= I_WO;
        if (r < I_W1) { const int kb = r / (ODD_N / 32), nb = r % (ODD_N / 32), n0 = nb * 32; int drow; float sc = 1.0f;
            if (n0 < 3072) { drow = n0; if (n0 >= 1024 && n0 < 2048) sc = 0.0625f; }
            else if (n0 < 4096) { const int fo = n0 - 3072; drow = 256 * (12 + (fo >> 7)) + (fo & 127); }
            else { const int fz = n0 - 4096; drow = 256 * (12 + (fz >> 7)) + 128 + (fz & 127); }
            transpose_item(F.w1, ODD_IN_W, n0, kb, (bf16*)(F.ws + WS_W1T), drow, sc, scr, F.lane); continue; } r -= I_W1;
        transpose_item(F.wo1, 1024, (r % 32) * 32, r / 32, (bf16*)(F.ws + WS_WO1T), (r % 32) * 32, 1.0f, scr, F.lane);
    }
    { float* wg = (float*)(F.ws + WS_WG);
        for (int i = gw * 64 + F.lane; i < 16 * 1024; i += NGW * 64) { const int j = i >> 10, k = i & 1023; wg[i] = F.w1[(size_t)k * ODD_IN_W + ODD_N + j]; } }
    const float* mod0 = (const float*)(F.ws + WS_MOD);
    for (int m = gw; m < MTOT; m += NGW) {
        const bool lat = m < MLAT; const int r = lat ? (m >> 13) : 4;
        const float* xrow = lat ? (F.x + (size_t)m * 1024) : (F.ctx + (size_t)(m - MLAT) * 1024);
        ln_mod_row(xrow, mod0 + r * 3072, mod0 + r * 3072 + 1024, (bf16*)(F.ws + WS_H) + (size_t)m * 1024, F.lane);
    }
}

__device__ __forceinline__ void p5_rowpass(Frame& F) {
    LAS float* gl = (LAS float*)(F.lds);
    const float* mod1 = (const float*)(F.ws + WS_MOD) + 5 * 3072;
    const float* wg = (const float*)(F.ws + WS_WG);
    float* zlat = F.out; float* zctx = (float*)(F.ws + WS_ZC);
    for (int u = F.vcu; u < 264; u += F.G) {
        const bool lat = u < 256; const int b = lat ? (u >> 6) : ((u - 256) >> 1); const int slot = lat ? (2 + (u & 63)) : ((u - 256) & 1);
        float* zbase = lat ? (zlat + (size_t)u * 128 * 1024) : (zctx + (size_t)(u - 256) * 128 * 1024);
        bf16* hbase = (bf16*)(F.ws + WS_H) + (size_t)(lat ? u * 128 : MLAT + (u - 256) * 128) * 1024;
        const float* sh = mod1 + (lat ? b : 4) * 3072; const float* sc = sh + 1024;
        __syncthreads();
        for (int rr = 0; rr < 16; ++rr) {
            const int row = F.wave * 16 + rr;
            GAS f32x4* zr = (GAS f32x4*)(zbase + (size_t)row * 1024) + F.lane;
            f32x4 v[4]; float s = 0.f;
#pragma unroll
            for (int j = 0; j < 4; ++j) { v[j] = zr[64 * j]; s += (v[j].x + v[j].y) + (v[j].z + v[j].w); }
            float mean = wave_sum(s) * (1.f / 1024.f); float s2 = 0.f;
#pragma unroll
            for (int j = 0; j < 4; ++j) { v[j] = v[j] - mean; s2 += (v[j].x * v[j].x + v[j].y * v[j].y) + (v[j].z * v[j].z + v[j].w * v[j].w); }
            float rstd = rsqrtf(wave_sum(s2) * (1.f / 1024.f) + LN_EPS);
            s = 0.f;
#pragma unroll
            for (int j = 0; j < 4; ++j) { const f32x4 g = *((const f32x4*)F.pgain + F.lane + 64 * j), bb = *((const f32x4*)F.pbias + F.lane + 64 * j);
                v[j] = v[j] * rstd * g + bb; zr[64 * j] = v[j]; s += (v[j].x + v[j].y) + (v[j].z + v[j].w); }
            mean = wave_sum(s) * (1.f / 1024.f); s2 = 0.f;
#pragma unroll
            for (int j = 0; j < 4; ++j) { v[j] = v[j] - mean; s2 += (v[j].x * v[j].x + v[j].y * v[j].y) + (v[j].z * v[j].z + v[j].w * v[j].w); }
            rstd = rsqrtf(wave_sum(s2) * (1.f / 1024.f) + LN_EPS);
            GAS unsigned long long* o8 = (GAS unsigned long long*)(hbase + (size_t)row * 1024) + F.lane;
#pragma unroll
            for (int j = 0; j < 4; ++j) { const f32x4 a = *((const f32x4*)sc + F.lane + 64 * j), bsh = *((const f32x4*)sh + F.lane + 64 * j);
                v[j] = v[j] * rstd * (a + 1.0f) + bsh;
                o8[64 * j] = (unsigned long long)pk2(v[j].x, v[j].y) | ((unsigned long long)pk2(v[j].z, v[j].w) << 32); }
            float mine = 0.f;
#pragma unroll 4
            for (int gi = 0; gi < 16; ++gi) { float d = 0.f;
#pragma unroll
                for (int j = 0; j < 4; ++j) { const f32x4 w = *((const f32x4*)(wg + gi * 1024) + F.lane + 64 * j); d += (v[j].x * w.x + v[j].y * w.y) + (v[j].z * w.z + v[j].w * w.w); }
                d = wave_sum(d); if (F.lane == gi) mine = d; }
            if (F.lane < 16) gl[row * 16 + F.lane] = mine + F.gbias[F.lane];
        }
        __syncthreads();
        if (F.tid < 8) {
            const int dir = F.tid >> 2, h = F.tid & 3; const int cd = dir * 16 + b * 4 + h;
            float* cum = (float*)(F.ws + WS_CUM) + ((size_t)cd * NSLOT + slot) * 128; float* aa = (float*)(F.ws + WS_AA) + ((size_t)cd * NSLOT + slot) * 128; float* pmx = (float*)(F.ws + WS_PM) + ((size_t)cd * NSLOT + slot) * 128;
            float run = 0.f, mx = -INFINITY;
            for (int i = 0; i < 128; ++i) { const int p = dir ? (127 - i) : i;
                const float li = gl[p * 16 + 8 * dir + h], fp = gl[p * 16 + 8 * dir + 4 + h];
                const float lf = fminf(fp, 0.f) - log1pf(expf(-fabsf(fp)));
                run += lf; const float a = li - run; mx = fmaxf(mx, a);
                cum[p] = run; aa[p] = a; pmx[p] = mx; }
            ((float*)(F.ws + WS_TOT))[cd * NSLOT + slot] = run; ((float*)(F.ws + WS_AMAX))[cd * NSLOT + slot] = mx;
        }
    }
}

__device__ __forceinline__ void p11_final_ln(Frame& F) {
    const int gw = F.vcu * NWAVES + F.wave, NGW = F.G * NWAVES;
    const float* gain = F.pgain + 1024; const float* bias = F.pbias + 1024;
    for (int m = gw; m < MLAT; m += NGW) {
        GAS f32x4* zr = (GAS f32x4*)(F.out + (size_t)m * 1024) + F.lane;
        f32x4 v[4]; float s = 0.f;
#pragma unroll
        for (int j = 0; j < 4; ++j) { v[j] = zr[64 * j]; s += (v[j].x + v[j].y) + (v[j].z + v[j].w); }
        const float mean = wave_sum(s) * (1.f / 1024.f); float s2 = 0.f;
#pragma unroll
        for (int j = 0; j < 4; ++j) { v[j] = v[j] - mean; s2 += (v[j].x * v[j].x + v[j].y * v[j].y) + (v[j].z * v[j].z + v[j].w * v[j].w); }
        const float rstd = rsqrtf(wave_sum(s2) * (1.f / 1024.f) + LN_EPS);
#pragma unroll
        for (int j = 0; j < 4; ++j) { const f32x4 g = *((const f32x4*)gain + F.lane + 64 * j), bb = *((const f32x4*)bias + F.lane + 64 * j); zr[64 * j] = v[j] * rstd * g + bb; }
    }
}
__device__ __forceinline__ void zero_fill16(Frame& F, void* p, size_t n16) {
    GAS v4u* q = (GAS v4u*)p; const size_t g0 = (size_t)(F.vcu * NWAVES * 64 + F.tid), gs = (size_t)F.G * NWAVES * 64;
    for (size_t i = g0; i < n16; i += gs) q[i] = (v4u){0u, 0u, 0u, 0u};
}

typedef float f32x16 __attribute__((ext_vector_type(16)));
typedef float f32x2v __attribute__((ext_vector_type(2)));
__device__ __forceinline__ float bf2f(unsigned short h) { return __builtin_bit_cast(float, (unsigned)h << 16); }
__device__ __forceinline__ void fourier_item(Frame& F, int item) {
    const int dsl = item & 31, g = (item >> 5) & 3, b = item >> 7;
    LAS unsigned char* L = F.lds + RING_OFF;
    LAS unsigned char* L2 = L + 65536;
    int lane = F.lane, w = F.wave; asm volatile("" : "+v"(lane), "+s"(w));
    const int tidq = w * 64 + lane;
    const bf16* U = (const bf16*)(F.ws + WS_U) + (size_t)b * SEQ * 256 + g * 64;
    const bf16* FMT = (const bf16*)(F.ws + WS_FMT) + (size_t)(g * 128 + 4 * dsl) * 64;
    __syncthreads();
    {
        const int row = lane & 15, kg = lane >> 4;
        bf16x8 af[2];
#pragma unroll
        for (int ks = 0; ks < 2; ++ks) af[ks] = (row < 4) ? *(const bf16x8*)(FMT + row * 64 + 32 * ks + 8 * kg) : (bf16x8){0, 0, 0, 0, 0, 0, 0, 0};
#pragma unroll 4
        for (int i = 0; i < 64; ++i) {
            const int tg = w + 8 * i; const int t = 16 * tg + row;
            const bf16x8 b0 = *(const bf16x8*)(U + (size_t)t * 256 + 8 * kg), b1 = *(const bf16x8*)(U + (size_t)t * 256 + 32 + 8 * kg);
            f32x4 acc = {0.f, 0.f, 0.f, 0.f};
            acc = __builtin_amdgcn_mfma_f32_16x16x32_bf16(af[0], b0, acc, 0, 0, 0);
            acc = __builtin_amdgcn_mfma_f32_16x16x32_bf16(af[1], b1, acc, 0, 0, 0);
            if (kg == 0) {
                const int t1 = t >> 6, t2 = t & 63;
#pragma unroll
                for (int p = 0; p < 2; ++p) { const int col = 2 * t2 + p; const int kidx = 2 * t1;
                    *(LAS unsigned*)(L + col * 512 + ((((kidx >> 3) ^ (col & 15))) << 4) + (kidx & 7) * 2) = pk2(acc[2 * p], acc[2 * p + 1]); }
            }
        }
    }
    __syncthreads();
    {
        const int r = lane & 31, h = lane >> 5; const int dl = r & 1;
        const bf16* A1 = (const bf16*)(F.ws + WS_A1) + (size_t)(32 * w + r) * 256 + 8 * h;
        const f32x2v* TW = (const f32x2v*)(F.ws + WS_TW);
        for (int nt = 0; nt < 4; ++nt) {
            f32x16 a = {0.f, 0.f, 0.f, 0.f, 0.f, 0.f, 0.f, 0.f, 0.f, 0.f, 0.f, 0.f, 0.f, 0.f, 0.f, 0.f};
            const int col = 32 * nt + r;
#pragma unroll 4
            for (int ks = 0; ks < 16; ++ks) {
                const bf16x8 af = *(const bf16x8*)(A1 + 16 * ks);
                const bf16x8 bfr = *(const LAS bf16x8*)(L + col * 512 + (((2 * ks + h) ^ (col & 15)) << 4));
                a = __builtin_amdgcn_mfma_f32_32x32x16_bf16(af, bfr, a, 0, 0, 0);
            }
            const int t2 = 16 * nt + (r >> 1);
#pragma unroll
            for (int q = 0; q < 8; ++q) {
                const int k1 = 16 * w + 4 * (q >> 1) + 2 * h + (q & 1);
                const f32x2v tw = TW[k1 * 64 + t2];
                const float yr = a[2 * q], yi = a[2 * q + 1];
                const float zr = yr * tw.x + yi * tw.y, zi = yi * tw.x - yr * tw.y;
                const int col2 = 2 * k1 + dl, kidx2 = 2 * t2;
                *(LAS unsigned*)(L2 + col2 * 256 + (((kidx2 >> 3) ^ (col2 & 15)) << 4) + (kidx2 & 7) * 2) = pk2(zr, zi);
            }
        }
    }
    __syncthreads();
    {
        const int r = lane & 31, h = lane >> 5;
        const bf16* A2 = (const bf16*)(F.ws + WS_A2) + (size_t)r * 128 + 8 * h;
        f32x16 acc2[2];
#pragma unroll
        for (int mt = 0; mt < 2; ++mt) acc2[mt] = (f32x16){0.f, 0.f, 0.f, 0.f, 0.f, 0.f, 0.f, 0.f, 0.f, 0.f, 0.f, 0.f, 0.f, 0.f, 0.f, 0.f};
        const int col2 = 32 * w + r;
#pragma unroll 2
        for (int ks = 0; ks < 8; ++ks) {
            const bf16x8 bfr = *(const LAS bf16x8*)(L2 + col2 * 256 + (((2 * ks + h) ^ (col2 & 15)) << 4));
#pragma unroll
            for (int mt = 0; mt < 2; ++mt) { const bf16x8 af = *(const bf16x8*)(A2 + mt * 32 * 128 + 16 * ks); acc2[mt] = __builtin_amdgcn_mfma_f32_32x32x16_bf16(af, bfr, acc2[mt], 0, 0, 0); }
        }
        const int k1 = col2 >> 1, dl = col2 & 1;
        LAS float* Ol = (LAS float*)L + (k1 * 2 + dl);
#pragma unroll
        for (int mt = 0; mt < 2; ++mt)
#pragma unroll
            for (int rg = 0; rg < 16; ++rg) { const int k2 = 32 * mt + (rg & 3) + 8 * (rg >> 2) + 4 * h; Ol[k2 * 256] = acc2[mt][rg]; }
    }
    __syncthreads();
    {
        const unsigned* GBs = (const unsigned*)((const bf16*)(F.ws + WS_GB) + (size_t)b * SEQ * 256 + g * 64 + 2 * dsl);
        unsigned* Yo = (unsigned*)((bf16*)(F.ws + WS_Y) + (size_t)b * SEQ * 1024 + 768 + g * 64 + 2 * dsl);
        const LAS f32x2v* Ol = (const LAS f32x2v*)L;
#pragma unroll 4
        for (int i = 0; i < 16; ++i) { const int t = tidq + 512 * i; const f32x2v o = Ol[t]; const unsigned gq = GBs[(size_t)t * 128];
            Yo[(size_t)t * 512] = pk2(o.x * __builtin_bit_cast(float, gq << 16), o.y * __builtin_bit_cast(float, gq & 0xffff0000u)); }
    }
    __syncthreads();
}
__device__ __forceinline__ void fourier_ctx_item(Frame& F, int item) {
    const int g = item & 3, b = item >> 2;
    LAS float* Zl = (LAS float*)(F.lds + RING_OFF);
    LAS float* ctab = (LAS float*)(F.lds + RING_BYTES + 1024); LAS float* stab = ctab + 256;
    const bf16* U = (const bf16*)(F.ws + WS_U) + (size_t)(MLAT + b * CTXL) * 256 + g * 64;
    const f32x2v* FMF = (const f32x2v*)(F.ws + WS_FMF) + (size_t)g * 64 * 64;
    __syncthreads();
    int tidq = F.tid; asm volatile("" : "+v"(tidq));
    if (tidq < 256) { ctab[tidq] = cospif((float)tidq / 128.0f); stab[tidq] = sinpif((float)tidq / 128.0f); }
    const int d = tidq & 63, q8 = tidq >> 6;
    for (int tq = 0; tq < 4; ++tq) {
        float zr[8], zi[8];
#pragma unroll
        for (int i = 0; i < 8; ++i) { zr[i] = 0.f; zi[i] = 0.f; }
        const bf16* Ur = U + (size_t)(q8 * 32 + tq * 8) * 256;
#pragma unroll 2
        for (int c = 0; c < 64; ++c) {
            const f32x2v m = FMF[c * 64 + d];
#pragma unroll
            for (int i = 0; i < 8; ++i) { const float u = bf2f(Ur[(size_t)i * 256 + c]); zr[i] += u * m.x; zi[i] += u * m.y; }
        }
#pragma unroll
        for (int i = 0; i < 8; ++i) { const int t = q8 * 32 + tq * 8 + i; Zl[(t * 64 + d) * 2] = zr[i] * 5.656854249492381f; Zl[(t * 64 + d) * 2 + 1] = zi[i] * 5.656854249492381f; }
    }
    __syncthreads();
    for (int kq = 0; kq < 2; ++kq) {
        float acc[16];
#pragma unroll
        for (int i = 0; i < 16; ++i) acc[i] = 0.f;
        const int kt0 = q8 * 32 + kq * 16;
#pragma unroll 2
        for (int t = 0; t < 256; ++t) {
            const float zr = Zl[(t * 64 + d) * 2], zi = Zl[(t * 64 + d) * 2 + 1];
#pragma unroll
            for (int i = 0; i < 16; ++i) { const int idx = ((kt0 + i) * t) & 255; acc[i] += ctab[idx] * zr + stab[idx] * zi; }
        }
        const bf16* GBs = (const bf16*)(F.ws + WS_GB) + (size_t)(MLAT + b * CTXL) * 256 + g * 64 + d;
        bf16* Yo = (bf16*)(F.ws + WS_Y) + (size_t)(MLAT + b * CTXL) * 1024 + 768 + g * 64 + d;
#pragma unroll
        for (int i = 0; i < 16; ++i) { const int kt = kt0 + i; Yo[(size_t)kt * 1024] = (bf16)f2bf(acc[i] * bf2f(GBs[(size_t)kt * 256])); }
    }
    __syncthreads();
}

namespace attn_body {
using bf16=__hip_bfloat16;
using bf16x8=__attribute__((ext_vector_type(8)))short;
using s16x4=__attribute__((ext_vector_type(4)))short;
using f32x16=__attribute__((ext_vector_type(16)))float;
using u32x4=__attribute__((ext_vector_type(4)))unsigned;
constexpr int NW=8,QBLK=32,QB=QBLK*NW,KVBLK=64;
constexpr int QP=768,KP=256,OP=1024,GP=768;
__device__ __forceinline__ int crow(int r,int hi){return (r&3)+8*(r>>2)+4*hi;}
#define SBAR() __builtin_amdgcn_sched_barrier(0)
constexpr int NSLOT=3, SLOTB=8192;
constexpr int LDS_K=0, LDS_V=NSLOT*SLOTB, LDS_WS=2*NSLOT*SLOTB, LDS_OST=LDS_WS+NW*64*4, LDS_BYTES=LDS_OST+NW*4096;
__device__ __forceinline__ void glds16(const void*gsrc,unsigned lds_dst){unsigned keep;
  asm volatile("s_mov_b32 %0, m0\n\ts_mov_b32 m0, %2\n\ts_nop 0\n\tglobal_load_lds_dwordx4 %1, off\n\ts_mov_b32 m0, %0":"=&s"(keep):"v"(gsrc),"s"(lds_dst):"memory");}
typedef float f32x2_t __attribute__((ext_vector_type(2))); typedef __bf16 bf16x2_t __attribute__((ext_vector_type(2)));
__device__ __forceinline__ unsigned cvtpk_s(float lo,float hi){f32x2_t v={lo,hi};bf16x2_t b=__builtin_convertvector(v,bf16x2_t);return __builtin_bit_cast(unsigned,b);}
#define WAIT_BAR(N) asm volatile("s_waitcnt vmcnt(" #N ") lgkmcnt(0)\n\ts_barrier":::"memory")

__device__ __forceinline__ void qkt(f32x16&p0,f32x16&p1,const char*Kslot,const bf16x8*qr,const f32x16&negm,int r32,int hi){
  const char*kb=Kslot+hi*1024+r32*16;
  #pragma unroll
  for(int d0=0;d0<4;++d0){
    const bf16x8 b0=*reinterpret_cast<const bf16x8*>(kb+d0*2048);
    const bf16x8 b1=*reinterpret_cast<const bf16x8*>(kb+d0*2048+512);
    if(d0==0){p0=__builtin_amdgcn_mfma_f32_32x32x16_bf16(b0,qr[0],negm,0,0,0);p1=__builtin_amdgcn_mfma_f32_32x32x16_bf16(b1,qr[0],negm,0,0,0);}
    else{p0=__builtin_amdgcn_mfma_f32_32x32x16_bf16(b0,qr[d0],p0,0,0,0);p1=__builtin_amdgcn_mfma_f32_32x32x16_bf16(b1,qr[d0],p1,0,0,0);}}
}
typedef __attribute__((address_space(3))) const char* lds_cptr;
typedef short v4i16_t __attribute__((ext_vector_type(4)));
__device__ __forceinline__ void kload8(bf16x8*kf,lds_cptr kp){
  kf[0]=*(const __attribute__((address_space(3))) bf16x8*)(kp);      kf[1]=*(const __attribute__((address_space(3))) bf16x8*)(kp+512);
  kf[2]=*(const __attribute__((address_space(3))) bf16x8*)(kp+2048); kf[3]=*(const __attribute__((address_space(3))) bf16x8*)(kp+2560);
  kf[4]=*(const __attribute__((address_space(3))) bf16x8*)(kp+4096); kf[5]=*(const __attribute__((address_space(3))) bf16x8*)(kp+4608);
  kf[6]=*(const __attribute__((address_space(3))) bf16x8*)(kp+6144); kf[7]=*(const __attribute__((address_space(3))) bf16x8*)(kp+6656);
}
__device__ __forceinline__ void kload2(bf16x8*kf,lds_cptr kp,int j){ kf[2*j]=*(const __attribute__((address_space(3))) bf16x8*)(kp+j*2048); kf[2*j+1]=*(const __attribute__((address_space(3))) bf16x8*)(kp+j*2048+512); }
__device__ __forceinline__ s16x4 vtr(lds_cptr p){ return __builtin_bit_cast(s16x4,__builtin_amdgcn_ds_read_tr16_b64_v4i16((__attribute__((address_space(3))) v4i16_t*)p)); }
__device__ __forceinline__ void pv(f32x16*o,int vb,bf16x8 pa0,bf16x8 pa1,bf16x8 pa2,bf16x8 pa3){
  #pragma unroll
  for(int d0=0;d0<2;++d0){s16x4 lo[4],hi[4];
    #pragma unroll
    for(int ks=0;ks<4;++ks){
      asm volatile("ds_read_b64_tr_b16 %0,%1 offset:%c2":"=&v"(lo[ks]):"v"(vb),"i"(d0*4096+ks*1024):"memory");
      asm volatile("ds_read_b64_tr_b16 %0,%1 offset:%c2":"=&v"(hi[ks]):"v"(vb),"i"(d0*4096+ks*1024+512):"memory");}
    asm volatile("s_waitcnt lgkmcnt(0)":::"memory");SBAR();
    #define PK(k) (bf16x8){lo[k][0],lo[k][1],lo[k][2],lo[k][3],hi[k][0],hi[k][1],hi[k][2],hi[k][3]}
    o[d0]=__builtin_amdgcn_mfma_f32_32x32x16_bf16(pa0,PK(0),o[d0],0,0,0);
    o[d0]=__builtin_amdgcn_mfma_f32_32x32x16_bf16(pa1,PK(1),o[d0],0,0,0);
    o[d0]=__builtin_amdgcn_mfma_f32_32x32x16_bf16(pa2,PK(2),o[d0],0,0,0);
    o[d0]=__builtin_amdgcn_mfma_f32_32x32x16_bf16(pa3,PK(3),o[d0],0,0,0);
    #undef PK
  }
}
__device__ __forceinline__ float bfbits2f(unsigned short h){ return __builtin_bit_cast(float,(unsigned)h<<16); }

__device__ __forceinline__ void attn_unit(const bf16*Qu,const bf16*__restrict__ Kh,const bf16*__restrict__ Vh,const int NT,bf16*Ou,const bf16*Gu,const float shift,char*shm){
  const int tid=threadIdx.x,lane=tid&63,r32=lane&31,hi=lane>>5; const int wid=__builtin_amdgcn_readfirstlane(tid>>6);
  const bf16*Qw=Qu+(long)(wid*QBLK)*QP;
  const unsigned lds0=(unsigned)(uintptr_t)shm;
  float*wsf=(float*)(shm+LDS_WS)+wid*64;
  const bf16*ksrc=Kh+(long)lane*KP+wid*8;
  const bf16*vsrc=Vh+(long)(16*(wid&3)+(lane>>2))*KP+(wid>>2)*32+(lane&3)*8;
  const unsigned kdst=lds0+LDS_K+wid*1024, vdst=lds0+LDS_V+wid*1024;
  #define DMA_K(t,slot) glds16(ksrc+(long)(t)*KVBLK*KP,(unsigned)__builtin_amdgcn_readfirstlane(kdst+(slot)))
  #define DMA_V(t,slot) glds16(vsrc+(long)(t)*KVBLK*KP,(unsigned)__builtin_amdgcn_readfirstlane(vdst+(slot)))
  const int vb0=(int)(lds0+LDS_V)+((lane>>4)&1)*32+(lane&3)*8+(4*hi+((lane&15)>>2))*64;
  const char*Kbase=shm+LDS_K; bf16x8 kf[8];
  const lds_cptr shm3=(lds_cptr)shm; const lds_cptr kp0=shm3+LDS_K+hi*1024+r32*16; const lds_cptr vp0=shm3+LDS_V+((lane>>4)&1)*32+(lane&3)*8+(4*hi+((lane&15)>>2))*64;
  DMA_K(0,0);DMA_V(0,0);DMA_K(1,SLOTB);
  bf16x8 qr[4];
  #pragma unroll
  for(int d0=0;d0<4;++d0)qr[d0]=*reinterpret_cast<const bf16x8*>(&Qw[(long)r32*QP+d0*16+hi*8]);
  float l_reg=0.f;f32x16 o[2];o[0]=f32x16{};o[1]=f32x16{};f32x16 negm;
  #pragma unroll
  for(int r=0;r<16;++r)negm[r]=-shift;
  asm volatile("":"+v"(negm));
  f32x16 pA0,pA1,pB0,pB1;
  int sl_prev=0,sl_cur=0,sl_next=SLOTB;
  #define ROT() do{sl_prev=sl_cur;sl_cur=sl_next;sl_next=(sl_next==(NSLOT-1)*SLOTB)?0:sl_next+SLOTB;}while(0)
  DMA_K(2,2*SLOTB);
  WAIT_BAR(3);
  qkt(pA0,pA1,Kbase,qr,negm,r32,hi);asm volatile("s_nop 15\n\ts_nop 7":"+v"(pA0),"+v"(pA1));
  _Pragma("unroll") for(int r=0;r<16;++r)pA0[r]=__builtin_amdgcn_exp2f(pA0[r]);
  _Pragma("unroll") for(int r=0;r<16;++r)pA1[r]=__builtin_amdgcn_exp2f(pA1[r]);
  WAIT_BAR(0);
  DMA_K(3,0);DMA_V(1,SLOTB);
  ROT();
  kload8(kf,kp0+sl_cur);
  WAIT_BAR(2);
  s16x4 vlo[8],vhi[8]; u32x4 pw0,pw1,pw2,pw3;
  #define PKW(P,B) cvtpk_s(P[B],P[B+1])
  #define PAF(k) __builtin_bit_cast(bf16x8,pw##k)
  #define VFR(i) (bf16x8){vlo[i][0],vlo[i][1],vlo[i][2],vlo[i][3],vhi[i][0],vhi[i][1],vhi[i][2],vhi[i][3]}
  #define PIN(x) asm volatile("":"+v"(x))
  #define GAPA(MF,A0,A1,A2,A3,W0,W1,PW) do{ MF; sacc+=A0; sacc+=A1; sacc+=A2; sacc+=A3; PIN(sacc); W0; W1; PIN(PW); SBAR(); }while(0)
  #define EX(v) __builtin_amdgcn_exp2f(v)
  #define GAPB(MF,X,B) do{ MF; X[B]=EX(X[B]); X[B+1]=EX(X[B+1]); X[B+2]=EX(X[B+2]); X[B+3]=EX(X[B+3]); PIN(X); SBAR(); }while(0)
  #define VRD(i) do{ vlo[i]=vtr(vp_+(((i)>>2)*4096+((i)&3)*1024)); vhi[i]=vtr(vp_+(((i)>>2)*4096+((i)&3)*1024+512)); }while(0)
  #define KRD(G,j) do{ if(G){ kload2(kf,kp0+sl_next,j); SBAR(); } }while(0)
  #define STEP(C0,C1,P0,P1,t,GK,GV,GL) do{ SBAR(); \
    const lds_cptr vp_=vp0+sl_prev; \
    VRD(0); SBAR(); float sacc=(P0[0]+P0[1]); \
    GAPA(C0=__builtin_amdgcn_mfma_f32_32x32x16_bf16(kf[0],qr[0],negm,0,0,0), P0[2],P0[3],P0[4],P0[5],     pw0[0]=PKW(P0,0), pw0[1]=PKW(P0,2), pw0); \
    VRD(4); SBAR(); GAPA(C1=__builtin_amdgcn_mfma_f32_32x32x16_bf16(kf[1],qr[0],negm,0,0,0), P0[6],P0[7],P0[8],P0[9],     pw0[2]=PKW(P0,4), pw0[3]=PKW(P0,6), pw0); \
    VRD(1); SBAR(); GAPA(C0=__builtin_amdgcn_mfma_f32_32x32x16_bf16(kf[2],qr[1],C0,0,0,0),   P0[10],P0[11],P0[12],P0[13], pw1[0]=PKW(P0,8), pw1[1]=PKW(P0,10), pw1); \
    VRD(5); SBAR(); GAPA(C1=__builtin_amdgcn_mfma_f32_32x32x16_bf16(kf[3],qr[1],C1,0,0,0),   P0[14],P0[15],P1[0],P1[1],   pw1[2]=PKW(P0,12),pw1[3]=PKW(P0,14), pw1); \
    VRD(2); SBAR(); GAPA(C0=__builtin_amdgcn_mfma_f32_32x32x16_bf16(kf[4],qr[2],C0,0,0,0),   P1[2],P1[3],P1[4],P1[5],     pw2[0]=PKW(P1,0), pw2[1]=PKW(P1,2), pw2); \
    VRD(6); SBAR(); GAPA(C1=__builtin_amdgcn_mfma_f32_32x32x16_bf16(kf[5],qr[2],C1,0,0,0),   P1[6],P1[7],P1[8],P1[9],     pw2[2]=PKW(P1,4), pw2[3]=PKW(P1,6), pw2); \
    VRD(3); SBAR(); GAPA(C0=__builtin_amdgcn_mfma_f32_32x32x16_bf16(kf[6],qr[3],C0,0,0,0),   P1[10],P1[11],P1[12],P1[13], pw3[0]=PKW(P1,8), pw3[1]=PKW(P1,10), pw3); \
    VRD(7); SBAR(); GAPA(C1=__builtin_amdgcn_mfma_f32_32x32x16_bf16(kf[7],qr[3],C1,0,0,0),   P1[14],P1[15],0.f,0.f,       pw3[2]=PKW(P1,12),pw3[3]=PKW(P1,14), pw3); \
    l_reg+=sacc; \
    if(GK){DMA_K((t)+3,sl_cur);} if(GV){DMA_V((t)+1,sl_next);} \
    SBAR(); \
    GAPB(o[0]=__builtin_amdgcn_mfma_f32_32x32x16_bf16(PAF(0),VFR(0),o[0],0,0,0), C0,0); \
    GAPB(o[1]=__builtin_amdgcn_mfma_f32_32x32x16_bf16(PAF(0),VFR(4),o[1],0,0,0), C0,4); \
    KRD(GL,0); GAPB(o[0]=__builtin_amdgcn_mfma_f32_32x32x16_bf16(PAF(1),VFR(1),o[0],0,0,0), C0,8); \
    KRD(GL,1); GAPB(o[1]=__builtin_amdgcn_mfma_f32_32x32x16_bf16(PAF(1),VFR(5),o[1],0,0,0), C0,12); \
    KRD(GL,2); GAPB(o[0]=__builtin_amdgcn_mfma_f32_32x32x16_bf16(PAF(2),VFR(2),o[0],0,0,0), C1,0); \
    KRD(GL,3); GAPB(o[1]=__builtin_amdgcn_mfma_f32_32x32x16_bf16(PAF(2),VFR(6),o[1],0,0,0), C1,4); \
    GAPB(o[0]=__builtin_amdgcn_mfma_f32_32x32x16_bf16(PAF(3),VFR(3),o[0],0,0,0), C1,8); \
    GAPB(o[1]=__builtin_amdgcn_mfma_f32_32x32x16_bf16(PAF(3),VFR(7),o[1],0,0,0), C1,12); \
    }while(0)
  int t=1;
  for(;t+5<NT;t+=2){
    STEP(pB0,pB1,pA0,pA1,t,true,true,true);     WAIT_BAR(2); ROT();
    STEP(pA0,pA1,pB0,pB1,t+1,true,true,true);   WAIT_BAR(2); ROT();
  }
  #define ENDW(tt) do{ if((tt)+3<NT){WAIT_BAR(2);} else if((tt)+2<NT){WAIT_BAR(1);} else {WAIT_BAR(0);} }while(0)
  for(;t+1<NT;t+=2){
    STEP(pB0,pB1,pA0,pA1,t,(t+3<NT),(t+1<NT),(t+1<NT));       ENDW(t);   ROT();
    STEP(pA0,pA1,pB0,pB1,t+1,(t+4<NT),(t+2<NT),(t+2<NT));     ENDW(t+1); ROT();
  }
  STEP(pB0,pB1,pA0,pA1,NT-1,false,false,false);
  { float sacc=pB0[0]+pB0[1]; _Pragma("unroll") for(int r=2;r<16;++r)sacc+=pB0[r]; _Pragma("unroll") for(int r=0;r<16;++r)sacc+=pB1[r]; l_reg+=sacc;
    pw0=(u32x4){PKW(pB0,0),PKW(pB0,2),PKW(pB0,4),PKW(pB0,6)};pw1=(u32x4){PKW(pB0,8),PKW(pB0,10),PKW(pB0,12),PKW(pB0,14)};pw2=(u32x4){PKW(pB1,0),PKW(pB1,2),PKW(pB1,4),PKW(pB1,6)};pw3=(u32x4){PKW(pB1,8),PKW(pB1,10),PKW(pB1,12),PKW(pB1,14)};
    SBAR(); pv(o,vb0+sl_cur,PAF(0),PAF(1),PAF(2),PAF(3)); }
  #undef PKW
  #undef PAF
  #undef VFR
  #undef PIN
  #undef GAPA
  #undef GAPB
  #undef EX
  #undef VRD
  #undef KRD
  #undef STEP
  #undef ENDW
  {auto rr=__builtin_amdgcn_permlane32_swap(__float_as_uint(l_reg),__float_as_uint(l_reg),false,false);l_reg=__uint_as_float(rr[0])+__uint_as_float(rr[1]);}
  if(hi==0)wsf[32+r32]=l_reg;asm volatile("s_waitcnt lgkmcnt(0)":::"memory");
  float rli[16];
  #pragma unroll
  for(int r=0;r<16;++r)rli[r]=__builtin_amdgcn_rcpf(wsf[32+crow(r,hi)]);
  bf16*Ow=Ou+(long)(wid*QBLK)*OP; const bf16*Gw=Gu+(long)(wid*QBLK)*GP;
  { bf16*stg=(bf16*)(shm+LDS_OST)+wid*2048;
    #pragma unroll
    for(int r=0;r<16;++r){const int orow=crow(r,hi);
      #pragma unroll
      for(int d0=0;d0<2;++d0)stg[orow*64+d0*32+r32]=__float2bfloat16(o[d0][r]*rli[r]);}
    asm volatile("s_waitcnt lgkmcnt(0)":::"memory");
    #pragma unroll
    for(int i=0;i<4;++i){const int row=i*8+(lane>>3),ch=lane&7; const u32x4 v=*(const u32x4*)(stg+row*64+ch*8); const u32x4 gq=*(const u32x4*)(Gw+(long)row*GP+ch*8);
      u32x4 w;
      #pragma unroll
      for(int e=0;e<4;++e){ const float a0=bfbits2f((unsigned short)(v[e]&0xffffu))*bfbits2f((unsigned short)(gq[e]&0xffffu)), a1=bfbits2f((unsigned short)(v[e]>>16))*bfbits2f((unsigned short)(gq[e]>>16)); w[e]=cvtpk_s(a0,a1); }
      *(u32x4*)(Ow+(long)row*OP+ch*8)=w;} }
  asm volatile("s_waitcnt lgkmcnt(0)\n\ts_barrier":::"memory");
  #undef DMA_K
  #undef DMA_V
  #undef ROT
}
constexpr int ATTN_LDS_BYTES=LDS_BYTES;
#undef SBAR
#undef WAIT_BAR
}

__device__ __forceinline__ void p3_even_mixers(Frame& F) {
    using abf = attn_body::bf16;
    const abf* Q0 = (const abf*)(F.ws + WS_Q0); const abf* KA = (const abf*)(F.ws + WS_KALL); const abf* VA = (const abf*)(F.ws + WS_VALL);
    const abf* GA = (const abf*)(F.ws + WS_GA); abf* Y = (abf*)(F.ws + WS_Y);
    const float shift = ((const float*)(F.ws + WS_MISCF))[0];
    char* shm = (char*)(F.lds + RING_OFF);
    for (int v = F.vcu; v < 256; v += F.G) {
        const int pair = v >> 4, b = pair >> 2, hk = pair & 3;
        for (int i = 0; i < 6; ++i) {
            const int j = (v & 15) * 6 + i; const int hq = hk * 3 + (j >> 5), qb = j & 31;
            const size_t row0 = (size_t)b * SEQ + (size_t)qb * 256;
            attn_body::attn_unit(Q0 + row0 * 768 + hq * 64, KA + (size_t)b * NKEYS * 256 + hk * 64, VA + (size_t)b * NKEYS * 256 + hk * 64, NKEYS / 64,
                                 Y + row0 * 1024 + hq * 64, GA + row0 * 768 + hq * 64, shift, shm);
        }
        if (v < 48) {
            const int b2 = v / 12, hq = v % 12, hk2 = hq / 3; const size_t row0 = (size_t)MLAT + (size_t)b2 * CTXL;
            attn_body::attn_unit(Q0 + row0 * 768 + hq * 64, KA + (size_t)b2 * NKEYS * 256 + hk2 * 64, VA + (size_t)b2 * NKEYS * 256 + hk2 * 64, CTXL / 64,
                                 Y + row0 * 1024 + hq * 64, GA + row0 * 768 + hq * 64, shift, shm);
        }
        __syncthreads();
        for (int k = 0; k < 2; ++k) fourier_item(F, v + 256 * k);
        if (v >= 48 && v < 64) fourier_ctx_item(F, v - 48);
    }
}

__device__ __forceinline__ int chain_slot(int dir, int step) { return dir == 0 ? step : (step == 0 ? 1 : (step == 1 ? 0 : 67 - step)); }

__device__ __forceinline__ void p7_mlstm_prep(Frame& F) {
    LAS unsigned char* L = F.lds + RING_OFF;
    LAS float* msh = (LAS float*)(F.lds + RING_BYTES + 1024);
    const int lane = F.lane, w = F.wave;
    const float* TOT = (const float*)(F.ws + WS_TOT); const float* AMAX = (const float*)(F.ws + WS_AMAX);
    for (int it = F.vcu; it < 16 * NSLOT; it += F.G) {
        const int bh = it / NSLOT, slot = it % NSLOT;
        bf16* kblk = (bf16*)(F.ws + WS_KB) + (size_t)it * 32768; bf16* vblk = (bf16*)(F.ws + WS_VB) + (size_t)it * 32768;
        const bf16* qblk = (const bf16*)(F.ws + WS_QB) + (size_t)it * 32768;
        __syncthreads();
#pragma unroll
        for (int i = 0; i < 8; ++i) { const int p = F.tid + 512 * i; const int tok = p >> 5, ch = p & 31;
            const v4u kv = *(const GAS v4u*)(kblk + tok * 256 + ch * 8), vv = *(const GAS v4u*)(vblk + tok * 256 + ch * 8);
            *(LAS v4u*)(L + tok * 512 + ((ch ^ (tok & 15)) << 4)) = kv; *(LAS v4u*)(L + 65536 + tok * 512 + ((ch ^ (tok & 15)) << 4)) = vv; }
        if (F.tid < 2) { const int dir = F.tid, cd = dir * 16 + bh; float m = 0.f;
            for (int st = 0; st < NSLOT; ++st) { const int s = chain_slot(dir, st); if (s == slot) break; const float M = fmaxf(m, AMAX[cd * NSLOT + s]); m = TOT[cd * NSLOT + s] + M; }
            msh[dir] = m; }
        __syncthreads();
        if (slot >= 2) {
            const int chunk = slot - 2; const int c = lane & 15, g4 = lane >> 4;
            const int tl = 16 * w + c;
            bf16x8 qf[8];
#pragma unroll
            for (int ks = 0; ks < 8; ++ks) qf[ks] = *(const bf16x8*)(qblk + tl * 256 + 32 * ks + 8 * g4);
            float Mt[2];
#pragma unroll
            for (int dir = 0; dir < 2; ++dir) { const int cd = dir * 16 + bh; Mt[dir] = fmaxf(msh[dir], ((const float*)(F.ws + WS_PM))[((size_t)cd * NSLOT + slot) * 128 + tl]); }
#pragma unroll 2
            for (int nt = 0; nt < 8; ++nt) {
                f32x4 acc = {0.f, 0.f, 0.f, 0.f};
                const int srow = 16 * nt + c;
#pragma unroll
                for (int ks = 0; ks < 8; ++ks) { const bf16x8 kf = *(const LAS bf16x8*)(L + srow * 512 + (((4 * ks + g4) ^ (srow & 15)) << 4)); acc = __builtin_amdgcn_mfma_f32_16x16x32_bf16(kf, qf[ks], acc, 0, 0, 0); }
                const int s0 = 16 * nt + 4 * g4;
#pragma unroll
                for (int dir = 0; dir < 2; ++dir) { const int cd = dir * 16 + bh;
                    const f32x4 a4 = *(const f32x4*)((const float*)(F.ws + WS_AA) + ((size_t)cd * NSLOT + slot) * 128 + s0);
                    float v[4];
#pragma unroll
                    for (int r = 0; r < 4; ++r) { const int s = s0 + r; const bool on = dir ? (s >= tl) : (s <= tl); v[r] = on ? acc[r] * __expf(a4[r] - Mt[dir]) : 0.f; }
                    unsigned long long pk8 = (unsigned long long)pk2(v[0], v[1]) | ((unsigned long long)pk2(v[2], v[3]) << 32);
                    *(GAS unsigned long long*)((bf16*)(F.ws + WS_S) + ((((size_t)(dir * 16 + bh) * 64 + chunk) * 128 + tl) * 128 + s0)) = pk8; }
            }
        }
        { const int col = F.tid & 255, half = F.tid >> 8;
#pragma unroll
            for (int tg = 0; tg < 8; ++tg) { const int t0 = (half * 8 + tg) * 8; unsigned short e[8], f[8];
#pragma unroll
                for (int i = 0; i < 8; ++i) { const int tok = t0 + i; const int off = tok * 512 + ((((col >> 3) ^ (tok & 15))) << 4) + (col & 7) * 2; e[i] = *(const LAS unsigned short*)(L + off); f[i] = *(const LAS unsigned short*)(L + 65536 + off); }
                v4u ko, vo; ko.x = e[0] | ((unsigned)e[1] << 16); ko.y = e[2] | ((unsigned)e[3] << 16); ko.z = e[4] | ((unsigned)e[5] << 16); ko.w = e[6] | ((unsigned)e[7] << 16);
                vo.x = f[0] | ((unsigned)f[1] << 16); vo.y = f[2] | ((unsigned)f[3] << 16); vo.z = f[4] | ((unsigned)f[5] << 16); vo.w = f[6] | ((unsigned)f[7] << 16);
                *(GAS v4u*)(kblk + col * 128 + t0) = ko; *(GAS v4u*)(vblk + col * 128 + t0) = vo; }
        }
    }
}

__device__ __forceinline__ void p8_mlstm_scan(Frame& F) {
    LAS unsigned char* CB = F.lds + RING_OFF;
    LAS float* msh = (LAS float*)(F.lds + RING_BYTES + 1024);
    const int lane = F.lane, w = F.wave, c = lane & 15, g4 = lane >> 4;
    const float* TOT = (const float*)(F.ws + WS_TOT); const float* AMAX = (const float*)(F.ws + WS_AMAX);
    for (int v = F.vcu; v < 256; v += F.G) {
        const int sl = v & 7, cd = v >> 3, dir = cd >> 4, bh = cd & 15, b = bh >> 2, h = bh & 3;
        __syncthreads();
        if (F.tid == 0) { float m = 0.f; for (int st = 0; st < NSLOT; ++st) { const int s = chain_slot(dir, st); msh[s] = m; const float M = fmaxf(m, AMAX[cd * NSLOT + s]); m = TOT[cd * NSLOT + s] + M; } }
        __syncthreads();
        f32x4 C[2][3];
#pragma unroll
        for (int mt = 0; mt < 2; ++mt)
#pragma unroll
            for (int nt = 0; nt < 3; ++nt) C[mt][nt] = (f32x4){0.f, 0.f, 0.f, 0.f};
        bf16* Hout = (bf16*)(F.ws + (dir ? WS_HB : WS_HF));
        for (int st = 0; st < NSLOT; ++st) {
            const int slot = chain_slot(dir, st); const int it = bh * NSLOT + slot;
            const bf16* kT = (const bf16*)(F.ws + WS_KB) + (size_t)it * 32768; const bf16* vT = (const bf16*)(F.ws + WS_VB) + (size_t)it * 32768;
            const float* cumv = (const float*)(F.ws + WS_CUM) + ((size_t)cd * NSLOT + slot) * 128; const float* aav = (const float*)(F.ws + WS_AA) + ((size_t)cd * NSLOT + slot) * 128; const float* pmv = (const float*)(F.ws + WS_PM) + ((size_t)cd * NSLOT + slot) * 128;
            const float m_in = msh[slot]; const float M = fmaxf(m_in, AMAX[cd * NSLOT + slot]); const float decay = __expf(m_in - M);
            bf16x8 vf[2][4];
#pragma unroll
            for (int nt = 0; nt < 2; ++nt)
#pragma unroll
                for (int ks = 0; ks < 4; ++ks) vf[nt][ks] = *(const bf16x8*)(vT + (size_t)(32 * sl + 16 * nt + c) * 128 + 32 * ks + 8 * g4);
            if (slot >= 2) {
                const int chunk = slot - 2;
                const bf16* qblk = (const bf16*)(F.ws + WS_QB) + (size_t)it * 32768;
#pragma unroll
                for (int nt = 0; nt < 3; ++nt) { v4u f; f.x = pk2(C[0][nt][0], C[0][nt][1]); f.y = pk2(C[0][nt][2], C[0][nt][3]); f.z = pk2(C[1][nt][0], C[1][nt][1]); f.w = pk2(C[1][nt][2], C[1][nt][3]);
                    *(LAS v4u*)(CB + ((w * 3 + nt) * 64 + lane) * 16) = f; }
                __syncthreads();
                f32x4 acc[3] = {{0.f, 0.f, 0.f, 0.f}, {0.f, 0.f, 0.f, 0.f}, {0.f, 0.f, 0.f, 0.f}};
                const bf16* qrow = qblk + (size_t)(16 * w + c) * 256;
#pragma unroll
                for (int ks = 0; ks < 8; ++ks) {
                    const unsigned long long lo = *(const GAS unsigned long long*)(qrow + 32 * ks + 4 * g4), hi8 = *(const GAS unsigned long long*)(qrow + 32 * ks + 16 + 4 * g4);
                    v4u qa; qa.x = (unsigned)lo; qa.y = (unsigned)(lo >> 32); qa.z = (unsigned)hi8; qa.w = (unsigned)(hi8 >> 32);
                    const bf16x8 qf = __builtin_bit_cast(bf16x8, qa);
#pragma unroll
                    for (int nt = 0; nt < 3; ++nt) { const bf16x8 bfr = *(const LAS bf16x8*)(CB + ((ks * 3 + nt) * 64 + lane) * 16); acc[nt] = __builtin_amdgcn_mfma_f32_16x16x32_bf16(qf, bfr, acc[nt], 0, 0, 0); }
                }
                float Mt[4], iw[4];
                { const f32x4 p4 = *(const f32x4*)(pmv + 16 * w + 4 * g4);
#pragma unroll
                    for (int r = 0; r < 4; ++r) { Mt[r] = fmaxf(m_in, p4[r]); iw[r] = __expf(m_in - Mt[r]); } }
#pragma unroll
                for (int nt = 0; nt < 3; ++nt)
#pragma unroll
                    for (int r = 0; r < 4; ++r) acc[nt][r] *= iw[r];
                const bf16* Srow = (const bf16*)(F.ws + WS_S) + ((((size_t)(dir * 16 + bh) * 64 + chunk) * 128 + 16 * w + c) * 128);
                const bf16x8 ones = (c == 0) ? (bf16x8){0x3F80, 0x3F80, 0x3F80, 0x3F80, 0x3F80, 0x3F80, 0x3F80, 0x3F80} : (bf16x8){0, 0, 0, 0, 0, 0, 0, 0};
#pragma unroll
                for (int ks = 0; ks < 4; ++ks) { const bf16x8 sf = *(const bf16x8*)(Srow + 32 * ks + 8 * g4);
                    acc[0] = __builtin_amdgcn_mfma_f32_16x16x32_bf16(sf, vf[0][ks], acc[0], 0, 0, 0);
                    acc[1] = __builtin_amdgcn_mfma_f32_16x16x32_bf16(sf, vf[1][ks], acc[1], 0, 0, 0);
                    acc[2] = __builtin_amdgcn_mfma_f32_16x16x32_bf16(sf, ones, acc[2], 0, 0, 0); }
                { const f32x4 c4 = *(const f32x4*)(cumv + 16 * w + 4 * g4);
                    bf16* hrow = Hout + ((size_t)b * SEQ + (size_t)chunk * 128 + 16 * w + 4 * g4) * 1024 + h * 256 + 32 * sl + c;
#pragma unroll
                    for (int r = 0; r < 4; ++r) { const float den = __shfl(acc[2][r], g4 * 16); const float dn = fmaxf(fabsf(den), __expf(-c4[r] - Mt[r])); const float inv = 1.0f / dn;
                        hrow[(size_t)r * 1024] = (bf16)f2bf(acc[0][r] * inv); hrow[(size_t)r * 1024 + 16] = (bf16)f2bf(acc[1][r] * inv); } }
            }
#pragma unroll
            for (int mt = 0; mt < 2; ++mt)
#pragma unroll
                for (int nt = 0; nt < 3; ++nt) C[mt][nt] = C[mt][nt] * decay;
#pragma unroll
            for (int ks = 0; ks < 4; ++ks) {
                const f32x4 a0 = *(const f32x4*)(aav + 32 * ks + 8 * g4), a1 = *(const f32x4*)(aav + 32 * ks + 8 * g4 + 4);
                float wv[8];
#pragma unroll
                for (int j = 0; j < 4; ++j) { wv[j] = __expf(a0[j] - M); wv[4 + j] = __expf(a1[j] - M); }
                bf16x8 bw[3];
#pragma unroll
                for (int nt = 0; nt < 2; ++nt) { const v4u raw = __builtin_bit_cast(v4u, vf[nt][ks]); v4u o;
#pragma unroll
                    for (int e = 0; e < 4; ++e) { const float lo = __builtin_bit_cast(float, raw[e] << 16) * wv[2 * e], hi2 = __builtin_bit_cast(float, raw[e] & 0xffff0000u) * wv[2 * e + 1]; o[e] = pk2(lo, hi2); }
                    bw[nt] = __builtin_bit_cast(bf16x8, o); }
                { v4u o; o.x = (c == 0) ? pk2(wv[0], wv[1]) : 0u; o.y = (c == 0) ? pk2(wv[2], wv[3]) : 0u; o.z = (c == 0) ? pk2(wv[4], wv[5]) : 0u; o.w = (c == 0) ? pk2(wv[6], wv[7]) : 0u; bw[2] = __builtin_bit_cast(bf16x8, o); }
#pragma unroll
                for (int mt = 0; mt < 2; ++mt) { const bf16x8 kf = *(const bf16x8*)(kT + (size_t)(32 * w + 16 * mt + c) * 128 + 32 * ks + 8 * g4);
#pragma unroll
                    for (int nt = 0; nt < 3; ++nt) C[mt][nt] = __builtin_amdgcn_mfma_f32_16x16x32_bf16(kf, bw[nt], C[mt][nt], 0, 0, 0); }
            }
            __syncthreads();
        }
    }
}

__device__ __forceinline__ void p9_mlstm_merge(Frame& F) {
    const GAS v4u* og = (const GAS v4u*)(F.ws + WS_OG); const GAS v4u* hf = (const GAS v4u*)(F.ws + WS_HF); const GAS v4u* hb = (const GAS v4u*)(F.ws + WS_HB); GAS v4u* y = (GAS v4u*)(F.ws + WS_YMIX);
    const size_t n16 = (size_t)MLAT * 1024 * 2 / 16; const size_t g0 = (size_t)(F.vcu * NWAVES * 64 + F.tid), gs = (size_t)F.G * NWAVES * 64;
    for (size_t i = g0; i < n16; i += gs) { const v4u a = og[i], p = hf[i], q = hb[i]; v4u o;
#pragma unroll
        for (int e = 0; e < 4; ++e) { const float lo = __builtin_bit_cast(float, a[e] << 16) * (__builtin_bit_cast(float, p[e] << 16) + __builtin_bit_cast(float, q[e] << 16));
            const float hi2 = __builtin_bit_cast(float, a[e] & 0xffff0000u) * (__builtin_bit_cast(float, p[e] & 0xffff0000u) + __builtin_bit_cast(float, q[e] & 0xffff0000u)); o[e] = pk2(lo, hi2); }
        y[i] = o; }
}

constexpr int N_PHASES = 12;
#ifndef MK_N_LAUNCHES
#define MK_N_LAUNCHES 1
#endif
struct Args { const float* in[17]; float* out; unsigned char* ws; int ph_lo, ph_hi, li, pad; };
__global__ void __launch_bounds__(NWAVES * 64, 2) hyb_fwd(Args args) {
    extern __shared__ __attribute__((aligned(16))) unsigned char lds[];
    Frame F;
    F.lds = (LAS unsigned char*)lds;
    F.MISC = (volatile LAS unsigned*)(F.lds + MISC_OFF);
    F.tid = threadIdx.x; F.lane = F.tid & 63; F.wave = __builtin_amdgcn_readfirstlane(F.tid >> 6);
    F.G = gridDim.x; { const int bx = blockIdx.x; F.vcu = (F.G % 8 == 0) ? (bx % 8) * (F.G / 8) + bx / 8 : bx; }
    F.ws = args.ws; F.ctl = (gu32*)(args.ws + WS_CTL);
    F.x = args.in[0]; F.c = args.in[1]; F.ctx = args.in[2]; F.c_ctx = args.in[3]; F.ada_w = args.in[4]; F.ada_b = args.in[5]; F.pgain = args.in[6]; F.pbias = args.in[7];
    F.w0 = args.in[8]; F.qgain = args.in[9]; F.kgain = args.in[10]; F.fgain = args.in[11]; F.wfmix = args.in[12]; F.wo0 = args.in[13]; F.w1 = args.in[14]; F.gbias = args.in[15]; F.wo1 = args.in[16];
    F.out = args.out;
    for (int u = F.tid; u < (LDS_BYTES - LDSCTL_OFF) / 4; u += NWAVES * 64) ((LAS unsigned*)(F.lds + LDSCTL_OFF))[u] = 0u;
    __syncthreads();
    XcdBarrier bar = xcd_barrier_post((unsigned*)(F.ctl + CW_BAR) + args.li * XCD_BAR_WORDS, F.MISC + 8);
    const int lo = args.ph_lo, hi = args.ph_hi;
#define IN(k) (lo <= (k) && (k) < hi)
#define SEAM(k) do { if (IN(k) && IN((k) + 1)) xcd_barrier(bar); } while (0)
    unsigned char* ws = args.ws;
    const float* mod = (const float*)(ws + WS_MOD);

    if (IN(0)) { p0_tables(F); } SEAM(0);
    if (IN(1)) { p1_weights_h0(F); } SEAM(1);
    if (IN(2)) {
        pg8::Gemm g{(const pg8::bf16_t*)(ws + WS_H), (const pg8::bf16_t*)(ws + WS_W0T), MTOT, EVEN_N, 1024}; pg8::StaticOrder S; S.init(MTOT, EVEN_N, F.G, (int)blockIdx.x);
        epi::EpiEven E{(pg8::bf16_t*)(ws + WS_Q0),
                       F.qgain, F.kgain, F.fgain, (const float*)(ws + WS_ROPE)};
        pg8::gemm_phase<epi::EpiEven, pg8::StaticOrder, true, true>(F.lds + RING_OFF, g, S, E);
    } SEAM(2);
    if (IN(3)) { p3_even_mixers(F); } SEAM(3);
    if (IN(4)) {
        pg8::Gemm g{(const pg8::bf16_t*)(ws + WS_Y), (const pg8::bf16_t*)(ws + WS_WO0T), MTOT, 1024, 1024}; pg8::StaticOrder S; S.init(MTOT, 1024, F.G, (int)blockIdx.x);
        epi::EpiRes E{F.x, F.out, F.ctx, (float*)(ws + WS_ZC), mod};
        pg8::gemm_phase<epi::EpiRes, pg8::StaticOrder, true, true>(F.lds + RING_OFF, g, S, E);
    } SEAM(4);
    if (IN(5)) { p5_rowpass(F); } SEAM(5);
    if (IN(6)) {
        pg8::Gemm g{(const pg8::bf16_t*)(ws + WS_H), (const pg8::bf16_t*)(ws + WS_W1T), MTOT, ODD_N, 1024}; pg8::StaticOrder S; S.init(MTOT, ODD_N, F.G, (int)blockIdx.x);
        epi::EpiOdd E{(pg8::bf16_t*)(ws + WS_QB), (pg8::bf16_t*)(ws + WS_OG)};
        pg8::gemm_phase<epi::EpiOdd, pg8::StaticOrder, true, true>(F.lds + RING_OFF, g, S, E);
    } SEAM(6);
    if (IN(7)) { p7_mlstm_prep(F); } SEAM(7);
    if (IN(8)) { p8_mlstm_scan(F); } SEAM(8);
    if (IN(9)) { p9_mlstm_merge(F); } SEAM(9);
    if (IN(10)) {
        pg8::Gemm g{(const pg8::bf16_t*)(ws + WS_YMIX), (const pg8::bf16_t*)(ws + WS_WO1T), MLAT, 1024, 1024}; pg8::StaticOrder S; S.init(MLAT, 1024, F.G, (int)blockIdx.x);
        epi::EpiRes E{F.out, F.out, F.ctx, (float*)(ws + WS_ZC), mod + 5 * 3072};
        pg8::gemm_phase<epi::EpiRes, pg8::StaticOrder, true, true>(F.lds + RING_OFF, g, S, E);
    } SEAM(10);
    if (IN(11)) { p11_final_ln(F); }
#undef IN
#undef SEAM
}

extern "C" void kernel_launch(void* const* d_in, const int* in_sizes, int n_in, void* d_out, int out_size, void* d_ws, size_t ws_size, hipStream_t stream) {
    static int grid = 0;
    if (grid == 0) {
        if (n_in != 17 || in_sizes[0] != MLAT * 1024 || out_size != MLAT * 1024 || ws_size < WS_END) {
            fprintf(stderr, "kernel_launch: unexpected problem (n_in %d, in0 %d, out %d, ws %zu; need ws >= %zu); nothing launched\n", n_in, n_in > 0 ? in_sizes[0] : -1, out_size, ws_size, (size_t)WS_END); grid = -1; return; }
        int dev = 0, cus = 0, per_cu = 0;
        if (hipGetDevice(&dev) != hipSuccess || hipDeviceGetAttribute(&cus, hipDeviceAttributeMultiprocessorCount, dev) != hipSuccess) { fprintf(stderr, "kernel_launch: device query failed\n"); grid = -1; return; }
        if (hipFuncSetAttribute((const void*)hyb_fwd, hipFuncAttributeMaxDynamicSharedMemorySize, LDS_BYTES) != hipSuccess) { fprintf(stderr, "kernel_launch: hipFuncSetAttribute failed\n"); grid = -1; return; }
        if (hipOccupancyMaxActiveBlocksPerMultiprocessor(&per_cu, (const void*)hyb_fwd, NWAVES * 64, LDS_BYTES) != hipSuccess || per_cu < 1)
            fprintf(stderr, "kernel_launch: note: occupancy query reports %d workgroups per CU\n", per_cu);
        (void)hipGetLastError();
        grid = cus;
    }
    if (grid < 0) return;
    if (hipMemsetAsync((char*)d_ws + WS_CTL, 0, CTL_ZERO_BYTES, stream) != hipSuccess) { fprintf(stderr, "kernel_launch: hipMemsetAsync failed\n"); return; }
    Args a{};
    for (int i = 0; i < 17; ++i) a.in[i] = (const float*)d_in[i];
    a.out = (float*)d_out; a.ws = (unsigned char*)d_ws;
    constexpr int NL = MK_N_LAUNCHES;
    static_assert(NL == 1 || NL == N_PHASES, "MK_N_LAUNCHES: 1 (one launch) or 12 (one launch per phase)");
    for (int li = 0; li < NL; ++li) {
        a.ph_lo = (NL == 1) ? 0 : li; a.ph_hi = (NL == 1) ? N_PHASES : li + 1; a.li = (NL == 1) ? 0 : 1 + li;
        hipLaunchKernelGGL(hyb_fwd, dim3(grid), dim3(NWAVES * 64), LDS_BYTES, stream, a);
        const hipError_t le = hipPeekAtLastError();
        if (le != hipSuccess) { fprintf(stderr, "kernel_launch: launch %d failed: %s\n", li, hipGetErrorName(le)); break; }
    }
}
```

```cpp
#include <hip/hip_runtime.h>
#include <hip/hip_bf16.h>
#include <cstdio>
#include <cstdint>
#include <cmath>
namespace pg8 {
#define PG8_LAS __attribute__((address_space(3)))
typedef unsigned short bf16_t;
typedef short bf16x8 __attribute__((ext_vector_type(8)));
typedef float f32x4 __attribute__((ext_vector_type(4)));
typedef unsigned u32x4 __attribute__((ext_vector_type(4)));
constexpr int BM = 256, BK = 64, HALF = 128, HTB = HALF * BK * 2  , STAGE_BYTES = 8 * HTB, NXCD = 8, WGM = 8;

__host__ __device__ __forceinline__ int lds_byte(int r, int c) { const int st = (r >> 4) * 2 + (c >> 5), rr = r & 15, cc = c & 31, ob = rr * 64 + cc * 2; return st * 1024 + (ob ^ (((ob >> 9) & 1) << 5)); }
__host__ __device__ __forceinline__ void stage_rc(int b, int& R, int& C) { const int st = b / 1024, sb = b % 1024, swz = sb ^ (((sb >> 9) & 1) << 5); R = (st >> 1) * 16 + swz / 64; C = (st & 1) * 32 + (swz % 64) / 2; }
__host__ __device__ __forceinline__ int perm32(int rho) { const int n = rho >> 4, i = rho & 15; return 8 * (i >> 2) + 4 * n + (i & 3); }

struct Unit { int pm, pn; };
struct Gemm { const bf16_t* A; const bf16_t* Bt; int M, N, K; };

struct StaticOrder {
    int nM, nN, nwg, G, c; bool revn = false;
    __host__ __device__ void init(int M, int N, int G_, int c_) { nM = M / BM; nN = N / BM; nwg = nM * nN; G = G_; c = c_; }
    __host__ __device__ bool next(int i, Unit& u) const {
        const long L = (long)i * G + c; if (L >= nwg) return false;
        int wgid = (int)L; { const int q = nwg / NXCD, r = nwg % NXCD, xcd = wgid % NXCD, off = wgid / NXCD; wgid = (xcd < r ? xcd * (q + 1) : r * (q + 1) + (xcd - r) * q) + off; }
        const int nig = WGM * nN, gid = wgid / nig, fm = gid * WGM, gsz = (nM - fm) < WGM ? (nM - fm) : WGM;
        u.pm = fm + ((wgid % nig) % gsz); u.pn = (wgid % nig) / gsz; if (revn) u.pn = nN - 1 - u.pn; return true;
    }
    __device__ __forceinline__ void a_ready(const Unit&) const {}
    __device__ __forceinline__ void done(const Unit&) const {}
};


typedef float cvf2_t __attribute__((ext_vector_type(2))); typedef __bf16 cvb2_t __attribute__((ext_vector_type(2)));
__device__ __forceinline__ unsigned cvt_pk_bf16(float lo, float hi) { const cvf2_t v = {lo, hi}; return __builtin_bit_cast(unsigned, __builtin_convertvector(v, cvb2_t)); }
template <class Epi> __device__ __forceinline__ const char* unit_a(const Gemm& g, const Epi& E, const Unit& u, size_t tstep) {
    if constexpr (Epi::SWAP_AB) { if (E.swap_ab(u)) return (const char*)g.Bt + (size_t)u.pn * tstep; }
    return (const char*)g.A + (size_t)u.pm * tstep; }
template <class Epi> __device__ __forceinline__ const char* unit_b(const Gemm& g, const Epi& E, const Unit& u, size_t tstep) {
    if constexpr (Epi::SWAP_AB) { if (E.swap_ab(u)) return (const char*)g.A + (size_t)u.pm * tstep; }
    return (const char*)g.Bt + (size_t)u.pn * tstep; }
template <class Epi, class Sched, bool ALIGN_EPI = false, bool SP2 = false>
__device__ __forceinline__ void gemm_phase(PG8_LAS unsigned char* lds, const Gemm g, const Sched& S, const Epi& E) {
    const int tid = threadIdx.x, wid = __builtin_amdgcn_readfirstlane(tid >> 6), lane = tid & 63, wr = wid >> 2, wc = wid & 3, fr = lane & 15, fq = lane >> 4;
    const int K = g.K, nt = K / BK;
    unsigned voffA[2], voffB[2];
#pragma unroll
    for (int i = 0; i < 2; ++i) { int R, C; stage_rc(tid * 16 + i * 8192, R, C); const int Rb = Epi::PERM ? ((R & ~31) + perm32(R & 31)) : R;
        voffA[i] = (unsigned)(R * K + C) * 2u; voffB[i] = (unsigned)(Rb * K + C) * 2u; }
    const size_t kstep = (size_t)(BK * 2);
    const size_t hstep = (size_t)HALF * K * 2;
    const size_t tstep = 2 * hstep;
    const unsigned ldsw = (unsigned)wid * 1024u;
    const int aoff = lds_byte(wr * 64 + fr, fq * 8), boff = lds_byte(wc * 32 + fr, fq * 8);
#define PG8_SA(b, h) (((b) * 2 + (h)) * HTB)
#define PG8_SB(b, h) ((4 + (b) * 2 + (h)) * HTB)
#define PG8_STAGE(bufoff, gbase, voff) do { _Pragma("unroll") for (int _i = 0; _i < 2; ++_i) \
        __builtin_amdgcn_global_load_lds((const unsigned*)((const char*)(gbase) + (voff)[_i]), (PG8_LAS unsigned*)(lds + (bufoff) + ldsw + _i * 8192), 16, 0, 0); } while (0)
#define PG8_LDA(dst, b, h) do { _Pragma("unroll") for (int m = 0; m < 4; ++m) _Pragma("unroll") for (int k = 0; k < 2; ++k) dst[m][k] = *(const PG8_LAS bf16x8*)(lds + PG8_SA(b, h) + aoff + m * 2048 + k * 1024); } while (0)
#define PG8_LDB(dst, b, h) do { _Pragma("unroll") for (int n = 0; n < 2; ++n) _Pragma("unroll") for (int k = 0; k < 2; ++k) dst[n][k] = *(const PG8_LAS bf16x8*)(lds + PG8_SB(b, h) + boff + n * 2048 + k * 1024); } while (0)
#define PG8_MMA(ai, bj, At, Bt) do { __builtin_amdgcn_s_setprio(1); _Pragma("unroll") for (int m = 0; m < 4; ++m) _Pragma("unroll") for (int n = 0; n < 2; ++n) _Pragma("unroll") for (int k = 0; k < 2; ++k) \
        acc[ai][bj][m][n] = __builtin_amdgcn_mfma_f32_16x16x32_bf16(Bt[n][k], At[m][k], acc[ai][bj][m][n], 0, 0, 0); __builtin_amdgcn_s_setprio(0); } while (0)
#define PG8_WAIT_V(n) asm volatile("s_waitcnt vmcnt(" #n ")" ::: "memory")
#define PG8_WAIT_L(n) asm volatile("s_waitcnt lgkmcnt(" #n ")" ::: "memory")
#define PG8_BAR __builtin_amdgcn_s_barrier()
#define PG8_SCHED __builtin_amdgcn_sched_barrier(0)
    Unit cur, nxt; int ui = 0;
    if (!S.next(0, cur)) return;
    f32x4 acc[2][2][4][2];
#pragma unroll
    for (int a = 0; a < 2; ++a)
#pragma unroll
        for (int b = 0; b < 2; ++b)
#pragma unroll
            for (int m = 0; m < 4; ++m)
#pragma unroll
                for (int n = 0; n < 2; ++n) acc[a][b][m][n] = (f32x4){0.f, 0.f, 0.f, 0.f};
    bf16x8 At[4][2], B0[2][2], B1[2][2];
    const char* cA = unit_a(g, E, cur, tstep); const char* cB = unit_b(g, E, cur, tstep);
    S.a_ready(cur);
    if constexpr (SP2) {
        PG8_STAGE(PG8_SB(0, 0), cB, voffB); PG8_STAGE(PG8_SB(0, 1), cB + hstep, voffB); PG8_STAGE(PG8_SA(0, 0), cA, voffA); PG8_STAGE(PG8_SA(0, 1), cA + hstep, voffA);
        if (wr == 1) PG8_BAR;
        PG8_WAIT_V(2); PG8_BAR;
        PG8_STAGE(PG8_SB(1, 0), cB + kstep, voffB); PG8_STAGE(PG8_SA(1, 0), cA + kstep, voffA); PG8_STAGE(PG8_SB(1, 1), cB + hstep + kstep, voffB);
        PG8_WAIT_V(6); PG8_BAR;
    } else {
        PG8_STAGE(PG8_SB(0, 0), cB, voffB); PG8_STAGE(PG8_SA(0, 0), cA, voffA); PG8_STAGE(PG8_SB(0, 1), cB + hstep, voffB); PG8_STAGE(PG8_SA(0, 1), cA + hstep, voffA);
        if (wr == 1) PG8_BAR;
        PG8_WAIT_V(4); PG8_BAR;
        PG8_STAGE(PG8_SB(1, 0), cB + kstep, voffB); PG8_STAGE(PG8_SA(1, 0), cA + kstep, voffA); PG8_STAGE(PG8_SB(1, 1), cB + hstep + kstep, voffB);
        PG8_WAIT_V(6); PG8_BAR;
    }
    for (;;) {
        const bool has_next = S.next(ui + 1, nxt);
        const char* nA = has_next ? unit_a(g, E, nxt, tstep) : cA; const char* nB = has_next ? unit_b(g, E, nxt, tstep) : cB;
        for (int t = 0; t < nt; t += 2) {
            const bool last = (t == nt - 2);
            const char* a1 = cA + (size_t)(t + 1) * kstep;
            const char* a2 = last ? nA : cA + (size_t)(t + 2) * kstep; const char* b2 = last ? nB : cB + (size_t)(t + 2) * kstep;
            const char* a3 = a2 + kstep; const char* b3 = b2 + kstep;
            if (last && has_next) S.a_ready(nxt);
            if constexpr (SP2) {
            PG8_LDB(B0, 0, 0); PG8_LDB(B1, 0, 1); PG8_SCHED; PG8_LDA(At, 0, 0); PG8_STAGE(PG8_SA(1, 1), a1 + hstep, voffA);
            PG8_WAIT_V(8); PG8_WAIT_L(0); PG8_BAR; PG8_MMA(0, 0, At, B0); PG8_MMA(0, 1, At, B1); PG8_BAR; PG8_SCHED;
            PG8_LDA(At, 0, 1); PG8_STAGE(PG8_SB(0, 0), b2, voffB); PG8_STAGE(PG8_SB(0, 1), b2 + hstep, voffB); PG8_STAGE(PG8_SA(0, 0), a2, voffA);
            PG8_WAIT_V(8); PG8_WAIT_L(0); PG8_BAR; PG8_MMA(1, 0, At, B0); PG8_MMA(1, 1, At, B1); PG8_BAR; PG8_SCHED;
            PG8_LDB(B0, 1, 0); PG8_LDB(B1, 1, 1); PG8_SCHED; PG8_LDA(At, 1, 0); PG8_STAGE(PG8_SA(0, 1), a2 + hstep, voffA);
            PG8_WAIT_V(8); PG8_WAIT_L(0); PG8_BAR; PG8_MMA(0, 0, At, B0); PG8_MMA(0, 1, At, B1); PG8_BAR; PG8_SCHED;
            PG8_LDA(At, 1, 1); PG8_STAGE(PG8_SB(1, 0), b3, voffB); PG8_STAGE(PG8_SB(1, 1), b3 + hstep, voffB); PG8_STAGE(PG8_SA(1, 0), a3, voffA);
            PG8_WAIT_V(8); PG8_WAIT_L(0); PG8_BAR; PG8_MMA(1, 0, At, B0); PG8_MMA(1, 1, At, B1); PG8_BAR; PG8_SCHED;
            } else {
            PG8_LDB(B0, 0, 0); PG8_SCHED; PG8_LDA(At, 0, 0); PG8_STAGE(PG8_SA(1, 1), a1 + hstep, voffA);
            PG8_WAIT_L(8); PG8_BAR; PG8_WAIT_L(0); PG8_MMA(0, 0, At, B0); PG8_BAR; PG8_SCHED;
            PG8_LDB(B1, 0, 1); PG8_STAGE(PG8_SB(0, 0), b2, voffB);
            PG8_BAR; PG8_WAIT_L(0); PG8_MMA(0, 1, At, B1); PG8_BAR;
            PG8_LDA(At, 0, 1); PG8_STAGE(PG8_SA(0, 0), a2, voffA);
            PG8_BAR; PG8_WAIT_L(0); PG8_MMA(1, 0, At, B0); PG8_BAR; PG8_SCHED;
            PG8_STAGE(PG8_SB(0, 1), b2 + hstep, voffB);
            PG8_WAIT_V(6); PG8_BAR; PG8_MMA(1, 1, At, B1); PG8_BAR;
            PG8_LDB(B0, 1, 0); PG8_SCHED; PG8_LDA(At, 1, 0); PG8_STAGE(PG8_SA(0, 1), a2 + hstep, voffA);
            PG8_WAIT_L(8); PG8_BAR; PG8_WAIT_L(0); PG8_MMA(0, 0, At, B0); PG8_BAR; PG8_SCHED;
            PG8_LDB(B1, 1, 1); PG8_STAGE(PG8_SB(1, 0), b3, voffB);
            PG8_BAR; PG8_WAIT_L(0); PG8_MMA(0, 1, At, B1); PG8_BAR;
            PG8_LDA(At, 1, 1); PG8_STAGE(PG8_SA(1, 0), a3, voffA);
            PG8_BAR; PG8_WAIT_L(0); PG8_MMA(1, 0, At, B0); PG8_BAR; PG8_SCHED;
            PG8_STAGE(PG8_SB(1, 1), b3 + hstep, voffB);
            PG8_WAIT_V(6); PG8_BAR; PG8_MMA(1, 1, At, B1); PG8_BAR;
            }
        }
        if constexpr (ALIGN_EPI) { if (wr == 0) PG8_BAR; }
        if constexpr (!Epi::AFTER_DRAIN) { E(acc, cur, wr, wc, fr, fq); S.done(cur); }
        if (!has_next) break;
#pragma unroll
        for (int a = 0; a < 2; ++a)
#pragma unroll
            for (int b = 0; b < 2; ++b)
#pragma unroll
                for (int m = 0; m < 4; ++m)
#pragma unroll
                    for (int n = 0; n < 2; ++n) acc[a][b][m][n] = (f32x4){0.f, 0.f, 0.f, 0.f};
        cur = nxt; cA = nA; cB = nB; ++ui;
        if constexpr (ALIGN_EPI) { if (wr == 1) PG8_BAR; }
    }
    PG8_WAIT_V(0);
    if constexpr (!ALIGN_EPI) { if (wr == 0) PG8_BAR; }
    PG8_BAR;
    if constexpr (Epi::AFTER_DRAIN) { E.fused(acc, cur, wr, wc, fr, fq, lds, wid, lane); S.done(cur); }
#undef PG8_SA
#undef PG8_SB
#undef PG8_STAGE
#undef PG8_LDA
#undef PG8_LDB
#undef PG8_MMA
#undef PG8_WAIT_V
#undef PG8_WAIT_L
#undef PG8_BAR
#undef PG8_SCHED
}
}


constexpr int BATCH = 4, SEQ = 8192, DM = 1024, CTXL = 256;
constexpr int MLAT = BATCH * SEQ, MCTX = BATCH * CTXL, MTOT = MLAT + MCTX;
constexpr int EVEN_N = 2560, ODD_N = 5120, ODD_IN_W = 5136;
constexpr int NKEYS = CTXL + SEQ;
constexpr int NSLOT = 66;
constexpr float LN_EPS = 1e-6f;
constexpr float ALPHA_RES = 1.4142135623730951f;
constexpr float QSCALE = 0.125f * 1.4426950408889634f;

namespace epi {
using pg8::f32x4; using pg8::u32x4; using pg8::bf16_t; using pg8::Unit;
__device__ __forceinline__ unsigned pk(float lo, float hi) { return pg8::cvt_pk_bf16(lo, hi); }
__device__ __forceinline__ float sigmoidf_(float v) { return __builtin_amdgcn_rcpf(1.0f + __expf(-v)); }
__device__ __forceinline__ float siluf_(float v) { return v * __builtin_amdgcn_rcpf(1.0f + __expf(-v)); }

struct EpiEven {
    static constexpr bool PERM = true, AFTER_DRAIN = false, SWAP_AB = false;
    bf16_t* Q0;
    static constexpr size_t oGA = (size_t)MTOT * 768, oKALL = oGA + (size_t)MTOT * 768, oVALL = oKALL + (size_t)BATCH * NKEYS * 256, oU = oVALL + (size_t)BATCH * NKEYS * 256, oGB = oU + (size_t)MTOT * 256;
    const float *qgain, *kgain, *fgain;
    const float* rope;
    __device__ __forceinline__ void operator()(const f32x4 (&acc)[2][2][4][2], const Unit& u, int wr, int wc, int fr, int fq) const {
        const int pm = u.pm, pn = u.pn;
        const bool lat = pm < 128;
        const int b = lat ? (pm >> 5) : (pm - 128);
        const int type = (pn < 3) ? 0 : (pn < 6) ? 1 : (pn - 4);
        const bool norm = (type == 0 || type == 2 || type == 4);
        const bool dorope = lat && (type == 0 || type == 2);
        f32x4 gn[2][2];
        if (norm) {
            const float* gp = (type == 0) ? qgain : (type == 2) ? kgain : (fgain + 64 * wc);
#pragma unroll
            for (int bj = 0; bj < 2; ++bj)
#pragma unroll
                for (int n = 0; n < 2; ++n) gn[bj][n] = *(const f32x4*)(gp + 32 * bj + 8 * fq + 4 * n);
        }
#pragma unroll
        for (int ai = 0; ai < 2; ++ai)
#pragma unroll
            for (int m = 0; m < 4; ++m) {
                const int rl = ai * 128 + wr * 64 + m * 16 + fr;
                const int mrow = pm * 256 + rl;
                const int t = lat ? ((pm & 31) * 256 + rl) : rl;
                f32x4 v[2][2];
#pragma unroll
                for (int bj = 0; bj < 2; ++bj)
#pragma unroll
                    for (int n = 0; n < 2; ++n) v[bj][n] = acc[ai][bj][m][n];
                if (norm) {
                    float ss = 0.f;
#pragma unroll
                    for (int bj = 0; bj < 2; ++bj)
#pragma unroll
                        for (int n = 0; n < 2; ++n) { const f32x4 x = v[bj][n]; ss += (x[0] * x[0] + x[1] * x[1]) + (x[2] * x[2] + x[3] * x[3]); }
                    ss += __shfl_xor(ss, 16); ss += __shfl_xor(ss, 32);
                    const float r = rsqrtf(ss * (1.0f / 64.0f) + LN_EPS);
#pragma unroll
                    for (int bj = 0; bj < 2; ++bj)
#pragma unroll
                        for (int n = 0; n < 2; ++n) v[bj][n] = v[bj][n] * r * gn[bj][n];
                }
                if (dorope) {
                    const float* cb = (fq < 2) ? (rope + (t >> 6) * 16) : (rope + 4096 + (t & 63) * 16);
                    const int so = (fq < 2) ? 2048 : 1024;
#pragma unroll
                    for (int n = 0; n < 2; ++n) {
                        const f32x4 c4 = *(const f32x4*)(cb + 8 * (fq & 1) + 4 * n), s4 = *(const f32x4*)(cb + so + 8 * (fq & 1) + 4 * n);
                        const f32x4 x1 = v[0][n], x2 = v[1][n];
                        v[0][n] = x1 * c4 - x2 * s4; v[1][n] = x1 * s4 + x2 * c4;
                    }
                }
                if (type == 0) {
#pragma unroll
                    for (int bj = 0; bj < 2; ++bj)
#pragma unroll
                        for (int n = 0; n < 2; ++n) v[bj][n] = v[bj][n] * QSCALE;
                } else if (type == 1 || type == 5) {
#pragma unroll
                    for (int bj = 0; bj < 2; ++bj)
#pragma unroll
                        for (int n = 0; n < 2; ++n) { f32x4 x = v[bj][n]; x[0] = siluf_(x[0]); x[1] = siluf_(x[1]); x[2] = siluf_(x[2]); x[3] = siluf_(x[3]); v[bj][n] = x; }
                }
                size_t doff;
                if (type == 0)      doff = (size_t)mrow * 768 + (4 * pn + wc) * 64;
                else if (type == 1) doff = oGA + (size_t)mrow * 768 + (pn - 3) * 256 + wc * 64;
                else if (type == 2) doff = oKALL + ((size_t)b * NKEYS + (lat ? 256 + t : t)) * 256 + wc * 64;
                else if (type == 3) doff = oVALL + ((size_t)b * NKEYS + (lat ? 256 + t : t)) * 256 + wc * 64;
                else if (type == 4) doff = oU + (size_t)mrow * 256 + wc * 64;
                else                doff = oGB + (size_t)mrow * 256 + wc * 64;
                bf16_t* dst = Q0 + doff;
#pragma unroll
                for (int bj = 0; bj < 2; ++bj) {
                    u32x4 w; w.x = pk(v[bj][0][0], v[bj][0][1]); w.y = pk(v[bj][0][2], v[bj][0][3]); w.z = pk(v[bj][1][0], v[bj][1][1]); w.w = pk(v[bj][1][2], v[bj][1][3]);
                    *(u32x4*)(dst + 32 * bj + 8 * fq) = w;
                }
            }
    }
};

struct EpiOdd {
    static constexpr bool PERM = true, AFTER_DRAIN = false, SWAP_AB = true;
    bf16_t *QB, *OG;
    __device__ __forceinline__ bool swap_ab(const Unit& u) const { return u.pn >= 4 && u.pn < 12; }
    __device__ __forceinline__ void operator()(const f32x4 (&acc)[2][2][4][2], const Unit& u, int wr, int wc, int fr, int fq) const {
        asm volatile("" : "+v"(fr), "+v"(fq));
        const int pm = u.pm, pn = u.pn;
        const bool lat = pm < 128;
        const int b = lat ? (pm >> 5) : (pm - 128);
        if (pn < 4) {
            const int h = pn;
#pragma unroll
            for (int ai = 0; ai < 2; ++ai) {
                const int slot = lat ? (2 + 2 * (pm & 31) + ai) : ai;
                bf16_t* blk = QB + ((size_t)(b * 4 + h) * NSLOT + slot) * 32768;
#pragma unroll
                for (int m = 0; m < 4; ++m)
#pragma unroll
                    for (int bj = 0; bj < 2; ++bj)
#pragma unroll
                        for (int n = 0; n < 2; ++n) {
                            const f32x4 a = acc[ai][bj][m][n];
                            const unsigned long long w = (unsigned long long)pk(a[0], a[1]) | ((unsigned long long)pk(a[2], a[3]) << 32);
                            *(unsigned long long*)(blk + ((((4 * wr + m) * 8 + 4 * bj + wc) * 64 + ((2 * fq + n) & 3) * 16 + fr) * 8) + 4 * (fq >> 1)) = w;
                        }
            }
        } else if (pn < 12) {
            const int h = pn & 3;
            bf16_t* base = QB + (size_t)(pn >> 2) * (size_t)(33 * 1024 * 1024);
#pragma unroll
            for (int bj = 0; bj < 2; ++bj) {
                const int slot = lat ? (2 + 2 * (pm & 31) + bj) : bj;
                bf16_t* blk = base + ((size_t)(b * 4 + h) * NSLOT + slot) * 32768 + (size_t)(wc * 64 + fq * 16 + fr) * 8;
#pragma unroll
                for (int ai = 0; ai < 2; ++ai)
#pragma unroll
                    for (int m = 0; m < 4; ++m) {
                        const f32x4 a0 = acc[ai][bj][m][0], a1 = acc[ai][bj][m][1];
                        u32x4 w; w.x = pk(a0[0], a0[1]); w.y = pk(a0[2], a0[3]); w.z = pk(a1[0], a1[1]); w.w = pk(a1[2], a1[3]);
                        *(u32x4*)(blk + (((4 * ai + 2 * wr + (m >> 1)) * 2 + (m & 1)) * 4) * 512) = w;
                    }
            }
        } else {
#pragma unroll
            for (int ai = 0; ai < 2; ++ai)
#pragma unroll
                for (int m = 0; m < 4; ++m) {
                    const int mrow = pm * 256 + ai * 128 + wr * 64 + m * 16 + fr;
                    float r[8];
#pragma unroll
                    for (int n = 0; n < 2; ++n)
#pragma unroll
                        for (int j = 0; j < 4; ++j) { const float o = acc[ai][0][m][n][j], z = acc[ai][1][m][n][j]; r[4 * n + j] = z * __builtin_amdgcn_rcpf((1.0f + __expf(-o)) * (1.0f + __expf(-z))); }
                    u32x4 w; w.x = pk(r[0], r[1]); w.y = pk(r[2], r[3]); w.z = pk(r[4], r[5]); w.w = pk(r[6], r[7]);
                    *(u32x4*)(OG + (size_t)mrow * 1024 + (pn - 12) * 128 + wc * 32 + 8 * fq) = w;
                }
        }
    }
};

struct EpiGate {
    static constexpr bool PERM = true, AFTER_DRAIN = false, SWAP_AB = false;
    bf16_t* GY; const float* mod;
    __device__ __forceinline__ void operator()(const f32x4 (&acc)[2][2][4][2], const Unit& u, int wr, int wc, int fr, int fq) const {
        const int pm = u.pm, pn = u.pn;
        const bool lat = pm < 128;
        const int b = lat ? (pm >> 5) : (pm - 128);
        const float* gp = mod + (lat ? b : 4) * 3072 + 2048;
        const int col0 = pn * 256 + wc * 32 + 8 * fq;
        f32x4 gv[2][2];
#pragma unroll
        for (int bj = 0; bj < 2; ++bj)
#pragma unroll
            for (int n = 0; n < 2; ++n) gv[bj][n] = *(const f32x4*)(gp + col0 + bj * 128 + n * 4);
#pragma unroll
        for (int ai = 0; ai < 2; ++ai)
#pragma unroll
            for (int m = 0; m < 4; ++m) {
                const int rl = ai * 128 + wr * 64 + m * 16 + fr;
                bf16_t* dst = GY + (size_t)(pm * 256 + rl) * 1024 + col0;
#pragma unroll
                for (int bj = 0; bj < 2; ++bj) { const f32x4 a0 = acc[ai][bj][m][0] * gv[bj][0], a1 = acc[ai][bj][m][1] * gv[bj][1];
                    u32x4 w; w.x = pk(a0[0], a0[1]); w.y = pk(a0[2], a0[3]); w.z = pk(a1[0], a1[1]); w.w = pk(a1[2], a1[3]);
                    *(u32x4*)(dst + bj * 128) = w; }
            }
    }
};

}
#define GAS __attribute__((address_space(1)))
#define LAS __attribute__((address_space(3)))
typedef unsigned short bf16;
typedef unsigned v4u __attribute__((ext_vector_type(4)));
typedef float f32x4 __attribute__((ext_vector_type(4)));
typedef float f32x2v __attribute__((ext_vector_type(2)));
typedef short bf16x8 __attribute__((ext_vector_type(8)));
typedef GAS unsigned gu32;
typedef GAS unsigned long long gu64;
#define RLX_AGENT __ATOMIC_RELAXED, __HIP_MEMORY_SCOPE_AGENT
#define LDS_WAIT() asm volatile("s_waitcnt lgkmcnt(0)" ::: "memory")
#define VM_WAIT() asm volatile("s_waitcnt vmcnt(0)" ::: "memory")
__device__ __forceinline__ unsigned long long rt() { return __builtin_amdgcn_s_memrealtime(); }
__device__ __forceinline__ unsigned pk2(float lo, float hi) { unsigned r; asm("v_cvt_pk_bf16_f32 %0, %1, %2" : "=v"(r) : "v"(lo), "v"(hi)); return r; }
__device__ __forceinline__ unsigned pk2m(float lo, float hi) { return pg8::cvt_pk_bf16(lo, hi); }
__device__ __forceinline__ unsigned f2bf(float f) { return pk2(f, f) & 0xffffu; }

#define XB_TMO      128
#define XB_XCNT(j)  (256  + 64 * (j))
#define XB_XSUB(j)  (1280 + 64 * (j))
#define XB_XGEN(j)  (2304 + 64 * (j))
#define XB_TOP      3328
#define XB_TOPGEN   3392
#define XCD_BAR_WORDS 3456
#define XB_SPIN_CAP (1u << 18)

__device__ __forceinline__ unsigned xb_ld(unsigned* p)              { return __hip_atomic_load(p, __ATOMIC_RELAXED, __HIP_MEMORY_SCOPE_AGENT); }
__device__ __forceinline__ unsigned xb_add(unsigned* p, unsigned v) { return __hip_atomic_fetch_add(p, v, __ATOMIC_RELAXED, __HIP_MEMORY_SCOPE_AGENT); }
__device__ __forceinline__ unsigned xb_xcc_id() { return (unsigned)__builtin_amdgcn_s_getreg((3 << 11) | 20) & 0xFu; }
#define XB_SPIN(cond, bar) do { unsigned _sp = 0; while (cond) { __builtin_amdgcn_s_sleep(1); \
    if ((++_sp & 255u) == 0u) { if (xb_ld(&(bar)[XB_TMO])) break; if (_sp > XB_SPIN_CAP) { atomicAdd(&(bar)[XB_TMO], 1u); break; } } } } while (0)

struct XcdBarrier {
    unsigned* bar; unsigned x;
    volatile LAS unsigned* st;
};

__device__ __forceinline__ XcdBarrier xcd_barrier_post(unsigned* bar, volatile LAS unsigned* st) {
    XcdBarrier b; b.bar = bar; b.x = xb_xcc_id(); b.st = st;
    if (threadIdx.x == 0) (void)xb_add(&bar[XB_XCNT(b.x)], 1u);
    return b;
}
__device__ __forceinline__ void xcd_barrier_complete(unsigned* bar, unsigned x, unsigned& nloc, unsigned& nx) {
    const unsigned G = gridDim.x * gridDim.y * gridDim.z;
    unsigned sum, cnt, mine, sp = 0u;
    for (;;) {
        sum = 0u; cnt = 0u; mine = 0u;
#pragma unroll
        for (unsigned j = 0; j < 16; ++j) { const unsigned c = xb_ld(&bar[XB_XCNT(j)]); sum += c; cnt += (c > 0u) ? 1u : 0u; mine = (j == x) ? c : mine; }
        if (sum == G) break;
        __builtin_amdgcn_s_sleep(1);
        if ((++sp & 255u) == 0u) { if (xb_ld(&bar[XB_TMO])) break; if (sp > XB_SPIN_CAP) { atomicAdd(&bar[XB_TMO], 1u); break; } }
    }
    nloc = mine > 0u ? mine : 1u; nx = cnt > 0u ? cnt : 1u;
}

__device__ __forceinline__ void xcd_barrier(const XcdBarrier& b) {
    asm volatile("s_waitcnt vmcnt(0)" ::: "memory");
    __syncthreads();
    if (threadIdx.x == 0) {
        unsigned* bar = b.bar;
        __builtin_amdgcn_s_waitcnt(0);
        unsigned nloc = b.st[0], nx = b.st[1];
        if (nloc == 0u) { xcd_barrier_complete(bar, b.x, nloc, nx); b.st[0] = nloc; b.st[1] = nx; }
        const unsigned old = xb_add(&bar[XB_XSUB(b.x)], 1u);
        const unsigned gen = old / nloc;
        if (old + 1u == (gen + 1u) * nloc) {
            __builtin_amdgcn_fence(__ATOMIC_RELEASE, "agent");
            asm volatile("s_waitcnt vmcnt(0)" ::: "memory");
            const unsigned og = xb_add(&bar[XB_TOP], 1u);
            const unsigned tg = og / nx;
            if (og + 1u == (tg + 1u) * nx) xb_add(&bar[XB_TOPGEN], 1u);
            else XB_SPIN(xb_ld(&bar[XB_TOPGEN]) == tg, bar);
            __builtin_amdgcn_fence(__ATOMIC_ACQUIRE, "agent");
            xb_add(&bar[XB_XGEN(b.x)], 1u);
            asm volatile("s_waitcnt vmcnt(0)" ::: "memory");
        } else {
            XB_SPIN(xb_ld(&bar[XB_XGEN(b.x)]) == gen, bar);
            __builtin_amdgcn_fence(__ATOMIC_ACQUIRE, "agent");
            asm volatile("s_waitcnt vmcnt(0)" ::: "memory");
        }
    }
    __syncthreads();
}


constexpr int NWAVES = 8;
constexpr size_t MiB = 1u << 20, KiB = 1u << 10;
constexpr size_t WS_CTL = 0, CTL_ZERO_BYTES = 1 * MiB;
constexpr size_t WS_MOD = 1 * MiB;
constexpr size_t WS_ROPE = 1 * MiB + 128 * KiB;
constexpr size_t WS_MISCF = 1 * MiB + 160 * KiB;
constexpr size_t WS_WG = 1 * MiB + 192 * KiB;
constexpr size_t WS_FMT = 1 * MiB + 256 * KiB;
constexpr size_t WS_FMF = 1 * MiB + 320 * KiB;
constexpr size_t WS_A1 = 1 * MiB + 512 * KiB;
constexpr size_t WS_A2 = 1 * MiB + 640 * KiB;
constexpr size_t WS_TW = 1 * MiB + 704 * KiB;
constexpr size_t WS_ACTX = 1 * MiB + 768 * KiB;
constexpr size_t WS_CUM = 2 * MiB, WS_AA = 4 * MiB, WS_PM = 6 * MiB;
constexpr size_t WS_TOT = 8 * MiB, WS_AMAX = 8 * MiB + 16 * KiB;
constexpr size_t WS_GRAW = 10 * MiB;
constexpr size_t WS_W0T = 16 * MiB, WS_WO0T = 21 * MiB, WS_W1T = 23 * MiB, WS_WO1T = 33 * MiB;
constexpr size_t WS_H = 36 * MiB;
constexpr size_t WS_Q0 = 102 * MiB;
constexpr size_t WS_GA = WS_Q0 + (size_t)MTOT * 768 * 2;
constexpr size_t WS_KALL = WS_GA + (size_t)MTOT * 768 * 2;
constexpr size_t WS_VALL = WS_KALL + (size_t)BATCH * NKEYS * 256 * 2;
constexpr size_t WS_U = WS_VALL + (size_t)BATCH * NKEYS * 256 * 2;
constexpr size_t WS_GB = WS_U + (size_t)MTOT * 256 * 2;
constexpr size_t WS_Y = WS_GB + (size_t)MTOT * 256 * 2;
constexpr size_t WS_L0_END = WS_Y + (size_t)MTOT * 1024 * 2;
constexpr size_t WS_QB = 102 * MiB, WS_KB = 168 * MiB, WS_VB = 234 * MiB, WS_OG = 300 * MiB;
constexpr size_t WS_HF = 366 * MiB, WS_HB = 430 * MiB;
constexpr size_t WS_YG = 366 * MiB;
constexpr size_t WS_GY = WS_H;
constexpr size_t WS_S = WS_H;
constexpr size_t WS_YMIX = WS_QB;
constexpr size_t WS_ZC = 494 * MiB;
constexpr size_t WS_END = 498 * MiB;
static_assert(WS_L0_END <= 366 * MiB && WS_W1T + (size_t)ODD_N * 1024 * 2 <= WS_WO1T && WS_H + (size_t)MTOT * 2048 <= WS_Q0, "d_ws map");

constexpr int CW_TMO = 0, CW_CODE = 1;
constexpr int CW_BAR = 4096;
constexpr int RING_OFF = 0, RING_BYTES = 131072;
constexpr int LDSCTL_OFF = RING_BYTES, MISC_OFF = LDSCTL_OFF + 320;
constexpr int LDS_BYTES = 147456;

struct Frame {
    LAS unsigned char* lds;
    volatile LAS unsigned* MISC;
    gu32* ctl;
    int tid, lane, wave;
    int vcu, G;
    unsigned char* ws;
    const float *x, *c, *ctx, *c_ctx, *ada_w, *ada_b, *pgain, *pbias, *w0, *qgain, *kgain, *fgain, *wfmix, *wo0, *w1, *gbias, *wo1;
    float* out;
};
__device__ __forceinline__ float wave_sum(float v) {
#pragma unroll
    for (int o = 1; o < 64; o <<= 1) v += __shfl_xor(v, o);
    return v;
}
__device__ __forceinline__ float silu_acc(float v) { return v / (1.0f + expf(-v)); }

constexpr int P0_ITEMS = 96 + 1 + 1 + 4 + 1 + 1 + 1;
__device__ __forceinline__ void weights_pass(Frame& F, const int gw, const int NGW);
__device__ __forceinline__ void p0_tables(Frame& F) {
    float* mod = (float*)(F.ws + WS_MOD);
    for (int it = blockIdx.x; it < P0_ITEMS; it += F.G) {
        __syncthreads();
        if (it < 96) {
            const int layer = it / 48, cb = it % 48;
            LAS float* sl = (LAS float*)(F.lds);
            LAS float* red = sl + 5 * 1024;
            for (int i = F.tid; i < 5 * 1024; i += NWAVES * 64) { const int r = i >> 10, k = i & 1023; const float v = (r < 4) ? F.c[r * 1024 + k] : F.c_ctx[k]; sl[i] = silu_acc(v); }
            __syncthreads();
            const int col = F.tid & 63, kg = F.tid >> 6;
            const float* W = F.ada_w + (size_t)layer * 1024 * 3072 + cb * 64 + col;
            float a[5] = {0.f, 0.f, 0.f, 0.f, 0.f};
            for (int k0 = kg * 128; k0 < kg * 128 + 128; k0 += 16) {
                float wv[16];
#pragma unroll
                for (int u = 0; u < 16; ++u) wv[u] = W[(size_t)(k0 + u) * 3072];
#pragma unroll
                for (int u = 0; u < 16; ++u)
#pragma unroll
                    for (int r = 0; r < 5; ++r) a[r] += sl[r * 1024 + k0 + u] * wv[u]; }
#pragma unroll
            for (int r = 0; r < 5; ++r) red[(kg * 5 + r) * 64 + col] = a[r];
            __syncthreads();
            if (F.tid < 320) { const int r = F.tid >> 6; float s = 0.f;
#pragma unroll
                for (int g = 0; g < 8; ++g) s += red[(g * 5 + r) * 64 + col];
                mod[(layer * 5 + r) * 3072 + cb * 64 + col] = s + F.ada_b[layer * 3072 + cb * 64 + col]; }
        } else if (it == 96) {
            float* rp = (float*)(F.ws + WS_ROPE);
            for (int i = F.tid; i < 3072; i += NWAVES * 64) {
                const int j = (i < 2048) ? i : (i - 2048); const int pos = j >> 4, fi = j & 15;
                const float invf = powf(10000.0f, -(float)fi / 16.0f); const float ang = (float)pos * invf;
                if (i < 2048) { rp[i] = cosf(ang); rp[2048 + i] = sinf(ang); } else { rp[4096 + j] = cosf(ang); rp[5120 + j] = sinf(ang); }
            }
        } else if (it == 97) {
            if (F.tid == 0) { float gq = 0.f, gk = 0.f; for (int i = 0; i < 64; ++i) { gq = fmaxf(gq, fabsf(F.qgain[i])); gk = fmaxf(gk, fabsf(F.kgain[i])); }
                ((float*)(F.ws + WS_MISCF))[0] = QSCALE * 64.0f * gq * gk * 1.001f; }
        } else if (it < 102) {
            const int g = it - 98;
            LAS float* cs = (LAS float*)(F.lds); LAS float* sn = cs + 64;
            if (F.tid < 64) { cs[F.tid] = cospif((float)F.tid / 32.0f); sn[F.tid] = sinpif((float)F.tid / 32.0f); }
            __syncthreads();
            bf16* fmt = (bf16*)(F.ws + WS_FMT) + (size_t)g * 128 * 64; float* fmf = (float*)(F.ws + WS_FMF) + (size_t)g * 64 * 64 * 2;
            const float* wm = F.wfmix + (size_t)g * 64 * 64;
            for (int i = F.tid; i < 64 * 64; i += NWAVES * 64) { const int cch = i >> 6, d = i & 63; float re = 0.f, im = 0.f;
                for (int kc = 0; kc < 64; ++kc) { const float w = wm[kc * 64 + d]; const int j = (kc * cch) & 63; re += cs[j] * w; im -= sn[j] * w; }
                re *= 0.0013810679320049757f; im *= 0.0013810679320049757f;
                fmf[(cch * 64 + d) * 2] = re; fmf[(cch * 64 + d) * 2 + 1] = im;
                fmt[(2 * d) * 64 + cch] = (bf16)f2bf(re); fmt[(2 * d + 1) * 64 + cch] = (bf16)f2bf(im); }
        } else if (it == 102) {
            LAS float* cs = (LAS float*)(F.lds); LAS float* sn = cs + 128;
            if (F.tid < 128) { cs[F.tid] = cospif((float)F.tid / 64.0f); sn[F.tid] = sinpif((float)F.tid / 64.0f); }
            __syncthreads();
            bf16* a1 = (bf16*)(F.ws + WS_A1);
            for (int i = F.tid; i < 256 * 256; i += NWAVES * 64) { const int row = i >> 8, col = i & 255; const int k1 = row >> 1, ro = row & 1, t1 = col >> 1, ri = col & 1; const int j = (k1 * t1) & 127;
                const float cv = cs[j], sv = sn[j]; const float v = (ro == 0) ? (ri == 0 ? cv : sv) : (ri == 0 ? -sv : cv); a1[i] = (bf16)f2bf(v); }
        } else if (it == 104) {
            LAS float* cs = (LAS float*)(F.lds); LAS float* sn = cs + 256;
            if (F.tid < 256) { cs[F.tid] = cospif((float)F.tid / 128.0f); sn[F.tid] = sinpif((float)F.tid / 128.0f); }
            __syncthreads();
            bf16* ac = (bf16*)(F.ws + WS_ACTX);
            for (int i = F.tid; i < 256 * 512; i += NWAVES * 64) { const int kt = i >> 9, col = i & 511; const int t = col >> 1, ri = col & 1; const int j = (kt * t) & 255; ac[i] = (bf16)f2bf(ri == 0 ? cs[j] : sn[j]); }
        } else {
            LAS float* cs = (LAS float*)(F.lds); LAS float* sn = cs + 64;
            if (F.tid < 64) { cs[F.tid] = cospif((float)F.tid / 32.0f); sn[F.tid] = sinpif((float)F.tid / 32.0f); }
            __syncthreads();
            bf16* a2 = (bf16*)(F.ws + WS_A2);
            for (int i = F.tid; i < 64 * 128; i += NWAVES * 64) { const int k2 = i >> 7, col = i & 127; const int t2 = col >> 1, ri = col & 1; const int j = (k2 * t2) & 63; a2[i] = (bf16)f2bf(ri == 0 ? cs[j] : sn[j]); }
            float* tw = (float*)(F.ws + WS_TW);
            for (int i = F.tid; i < 128 * 64; i += NWAVES * 64) { const int k1 = i >> 6, t2 = i & 63; const float a = (float)(k1 * t2) / 4096.0f; tw[2 * i] = cospif(a); tw[2 * i + 1] = sinpif(a); }
        }
    }
    __syncthreads();
    if (F.G >= P0_ITEMS + 64) { if ((int)blockIdx.x >= P0_ITEMS) weights_pass(F, ((int)blockIdx.x - P0_ITEMS) * NWAVES + F.wave, (F.G - P0_ITEMS) * NWAVES); }
    else weights_pass(F, (int)blockIdx.x * NWAVES + F.wave, F.G * NWAVES);
}

__device__ __forceinline__ void transpose_item(const float* W, int srcN, int n0, int kb, bf16* WT, int drow0, float scale, LAS float* scr, int lane) {
    const int k0 = 64 * kb;
#pragma unroll 8
    for (int i = 0; i < 32; ++i) { const int kk = 2 * i + (lane >> 5); scr[kk * 33 + (lane & 31)] = W[(size_t)(k0 + kk) * srcN + n0 + (lane & 31)] * scale; }
    LDS_WAIT(); asm volatile("" ::: "memory");
    const int c = lane & 7;
#pragma unroll
    for (int j = 0; j < 4; ++j) { const int n = (lane >> 3) + 8 * j; const LAS float* s = scr + (8 * c) * 33 + n;
        v4u o; o.x = pk2(s[0 * 33], s[1 * 33]); o.y = pk2(s[2 * 33], s[3 * 33]); o.z = pk2(s[4 * 33], s[5 * 33]); o.w = pk2(s[6 * 33], s[7 * 33]);
        *(GAS v4u*)(WT + (size_t)(drow0 + n) * 1024 + k0 + 8 * c) = o; }
    LDS_WAIT(); asm volatile("" ::: "memory");
}
__device__ __forceinline__ void weights_pass(Frame& F, const int gw, const int NGW) {
    LAS float* scr = (LAS float*)(F.lds + RING_OFF + F.wave * 16384);
    constexpr int I_W0 = 16 * (EVEN_N / 32), I_WO = 16 * 32, I_W1 = 16 * (ODD_N / 32);
    constexpr int NITEMS = I_W0 + I_WO + I_W1 + I_WO;
    for (int it = gw; it < NITEMS; it += NGW) {
        int r = it;
        if (r < I_W0) { const int kb = r / (EVEN_N / 32), nb = r % (EVEN_N / 32), n0 = nb * 32; const int pn = n0 >> 8, L = n0 & 255, wc = L >> 6, bj = (L >> 5) & 1;
            transpose_item(F.w0, EVEN_N, n0, kb, (bf16*)(F.ws + WS_W0T), pn * 256 + bj * 128 + wc * 32, 1.0f, scr, F.lane); continue; } r -= I_W0;
        if (r < I_WO) { transpose_item(F.wo0, 1024, (r % 32) * 32, r / 32, (bf16*)(F.ws + WS_WO0T), (r % 32) * 32, 1.0f, scr, F.lane); continue; } r -= I_WO;
        if (r < I_W1) { const int kb = r / (ODD_N / 32), nb = r % (ODD_N / 32), n0 = nb * 32; int drow; float sc = 1.0f;
            if (n0 < 3072) { drow = n0; if (n0 >= 1024 && n0 < 2048) sc = 0.0625f; }
            else if (n0 < 4096) { const int fo = n0 - 3072; drow = 256 * (12 + (fo >> 7)) + (fo & 127); }
            else { const int fz = n0 - 4096; drow = 256 * (12 + (fz >> 7)) + 128 + (fz & 127); }
            transpose_item(F.w1, ODD_IN_W, n0, kb, (bf16*)(F.ws + WS_W1T), drow, sc, scr, F.lane); continue; } r -= I_W1;
        transpose_item(F.wo1, 1024, (r % 32) * 32, r / 32, (bf16*)(F.ws + WS_WO1T), (r % 32) * 32, 1.0f, scr, F.lane);
    }
    { float* wg = (float*)(F.ws + WS_WG);
        for (int i = gw * 64 + F.lane; i < 16 * 1024; i += NGW * 64) { const int j = i >> 10, k = i & 1023; wg[i] = F.w1[(size_t)k * ODD_IN_W + ODD_N + j]; } }
}
__device__ __forceinline__ void p1_h0_rows(Frame& F) {
    const int gw = F.vcu * NWAVES + F.wave;
    {
        const float* mod0 = (const float*)(F.ws + WS_MOD);
        int lane = F.lane; asm volatile("" : "+v"(lane));
        const int rpw = (MTOT + F.G * NWAVES - 1) / (F.G * NWAVES);
        const int m0 = gw * rpw, m1 = (m0 + rpw < MTOT) ? (m0 + rpw) : MTOT;
        if (m0 < m1) {
            f32x4 vn[4], sc[4], sh[4]; int rcur = -1;
            { const float* xr = (m0 < MLAT) ? (F.x + (size_t)m0 * 1024) : (F.ctx + (size_t)(m0 - MLAT) * 1024);
#pragma unroll
              for (int j = 0; j < 4; ++j) vn[j] = *((const GAS f32x4*)xr + lane + 64 * j); }
            for (int m = m0; m < m1; ++m) {
                f32x4 v[4];
#pragma unroll
                for (int j = 0; j < 4; ++j) v[j] = vn[j];
                if (m + 1 < m1) { const int m2 = m + 1; const float* xr = (m2 < MLAT) ? (F.x + (size_t)m2 * 1024) : (F.ctx + (size_t)(m2 - MLAT) * 1024);
#pragma unroll
                    for (int j = 0; j < 4; ++j) vn[j] = *((const GAS f32x4*)xr + lane + 64 * j); }
                const int r = (m < MLAT) ? (m >> 13) : 4;
                if (r != rcur) { rcur = r;
#pragma unroll
                    for (int j = 0; j < 4; ++j) { sh[j] = *((const f32x4*)(mod0 + r * 3072) + lane + 64 * j); sc[j] = *((const f32x4*)(mod0 + r * 3072 + 1024) + lane + 64 * j) + 1.0f; } }
                float s = 0.f;
#pragma unroll
                for (int j = 0; j < 4; ++j) s += (v[j].x + v[j].y) + (v[j].z + v[j].w);
                const float mean = wave_sum(s) * (1.f / 1024.f); float s2 = 0.f;
#pragma unroll
                for (int j = 0; j < 4; ++j) { v[j] = v[j] - mean; s2 += (v[j].x * v[j].x + v[j].y * v[j].y) + (v[j].z * v[j].z + v[j].w * v[j].w); }
                const float rstd = rsqrtf(wave_sum(s2) * (1.f / 1024.f) + LN_EPS);
                GAS unsigned long long* o8 = (GAS unsigned long long*)((bf16*)(F.ws + WS_H) + (size_t)m * 1024) + lane;
#pragma unroll
                for (int j = 0; j < 4; ++j) { const f32x4 h = v[j] * rstd * sc[j] + sh[j]; o8[64 * j] = (unsigned long long)pk2(h.x, h.y) | ((unsigned long long)pk2(h.z, h.w) << 32); }
            }
        }
    }
}

__device__ __forceinline__ void p5_rowpass(Frame& F) {
    const float* mod1 = (const float*)(F.ws + WS_MOD) + 5 * 3072;
    const float* wg = (const float*)(F.ws + WS_WG);
    float* zlat = F.out; float* graw = (float*)(F.ws + WS_GRAW);
    int lane = F.lane, wv = F.wave; asm volatile("" : "+v"(lane), "+s"(wv));
    const int gw = F.vcu * NWAVES + wv;
    LAS f32x4* wgl = (LAS f32x4*)(F.lds);
    __syncthreads();
    for (int i = wv * 64 + lane; i < 16 * 256; i += NWAVES * 64) wgl[i] = *((const f32x4*)wg + i);
    __syncthreads();
    const int rpw = (MTOT + F.G * NWAVES - 1) / (F.G * NWAVES);
    const int m0 = gw * rpw, m1 = (m0 + rpw < MTOT) ? (m0 + rpw) : MTOT;
    if (m0 < m1) {
        f32x4 vn[4], sc[4], sh[4], pg[4], pb[4]; int rcur = -1;
#pragma unroll
        for (int j = 0; j < 4; ++j) { pg[j] = *((const f32x4*)F.pgain + lane + 64 * j); pb[j] = *((const f32x4*)F.pbias + lane + 64 * j); }
        const unsigned long long* gyb = (const unsigned long long*)(F.ws + WS_GY);
        unsigned long long gn[4];
        { const float* xr0 = (m0 < MLAT) ? (F.x + (size_t)m0 * 1024) : (F.ctx + (size_t)(m0 - MLAT) * 1024);
#pragma unroll
          for (int j = 0; j < 4; ++j) { vn[j] = *((const GAS f32x4*)xr0 + lane + 64 * j); gn[j] = gyb[(size_t)m0 * 256 + lane + 64 * j]; } }
        const float gb = (lane < 16) ? F.gbias[lane] : 0.f;
        for (int m = m0; m < m1; ++m) {
            f32x4 v[4];
#pragma unroll
            for (int j = 0; j < 4; ++j) { const unsigned lo = (unsigned)gn[j], hi = (unsigned)(gn[j] >> 32);
                v[j].x = vn[j].x * ALPHA_RES + __builtin_bit_cast(float, lo << 16); v[j].y = vn[j].y * ALPHA_RES + __builtin_bit_cast(float, lo & 0xffff0000u);
                v[j].z = vn[j].z * ALPHA_RES + __builtin_bit_cast(float, hi << 16); v[j].w = vn[j].w * ALPHA_RES + __builtin_bit_cast(float, hi & 0xffff0000u); }
            GAS unsigned long long* zr = (GAS unsigned long long*)(zlat + (size_t)m * 1024) + lane;
            if (m + 1 < m1) { const int m2 = m + 1; const float* x2 = (m2 < MLAT) ? (F.x + (size_t)m2 * 1024) : (F.ctx + (size_t)(m2 - MLAT) * 1024);
#pragma unroll
                for (int j = 0; j < 4; ++j) { vn[j] = *((const GAS f32x4*)x2 + lane + 64 * j); gn[j] = gyb[(size_t)m2 * 256 + lane + 64 * j]; } }
            const int r = (m < MLAT) ? (m >> 13) : 4;
            if (r != rcur) { rcur = r;
#pragma unroll
                for (int j = 0; j < 4; ++j) { sh[j] = *((const f32x4*)(mod1 + r * 3072) + lane + 64 * j); sc[j] = *((const f32x4*)(mod1 + r * 3072 + 1024) + lane + 64 * j) + 1.0f; } }
            float s = 0.f;
#pragma unroll
            for (int j = 0; j < 4; ++j) s += (v[j].x + v[j].y) + (v[j].z + v[j].w);
            float mean = wave_sum(s) * (1.f / 1024.f); float s2 = 0.f;
#pragma unroll
            for (int j = 0; j < 4; ++j) { v[j] = v[j] - mean; s2 += (v[j].x * v[j].x + v[j].y * v[j].y) + (v[j].z * v[j].z + v[j].w * v[j].w); }
            float rstd = rsqrtf(wave_sum(s2) * (1.f / 1024.f) + LN_EPS);
            s = 0.f;
#pragma unroll
            for (int j = 0; j < 4; ++j) { v[j] = v[j] * rstd * pg[j] + pb[j]; if (m < MLAT) zr[64 * j] = (unsigned long long)pk2(v[j].x, v[j].y) | ((unsigned long long)pk2(v[j].z, v[j].w) << 32); s += (v[j].x + v[j].y) + (v[j].z + v[j].w); }
            mean = wave_sum(s) * (1.f / 1024.f); s2 = 0.f;
#pragma unroll
            for (int j = 0; j < 4; ++j) { v[j] = v[j] - mean; s2 += (v[j].x * v[j].x + v[j].y * v[j].y) + (v[j].z * v[j].z + v[j].w * v[j].w); }
            rstd = rsqrtf(wave_sum(s2) * (1.f / 1024.f) + LN_EPS);
            GAS unsigned long long* o8 = (GAS unsigned long long*)((bf16*)(F.ws + WS_H) + (size_t)m * 1024) + lane;
#pragma unroll
            for (int j = 0; j < 4; ++j) { v[j] = v[j] * rstd * sc[j] + sh[j]; o8[64 * j] = (unsigned long long)pk2(v[j].x, v[j].y) | ((unsigned long long)pk2(v[j].z, v[j].w) << 32); }
            float d[16];
#pragma unroll
            for (int gi = 0; gi < 16; ++gi) { float a = 0.f;
#pragma unroll
                for (int j = 0; j < 4; ++j) { const f32x4 w = wgl[gi * 256 + lane + 64 * j]; a += (v[j].x * w.x + v[j].y * w.y) + (v[j].z * w.z + v[j].w * w.w); }
                d[gi] = a; if ((gi & 3) == 3) __builtin_amdgcn_sched_barrier(0); }
            { const bool b5 = (lane & 32) != 0, b4 = (lane & 16) != 0, b3 = (lane & 8) != 0, b2 = (lane & 4) != 0;
              float e[8], g4v[4], h2[2];
#pragma unroll
              for (int i = 0; i < 8; ++i) { const float send = b5 ? d[i] : d[8 + i], own = b5 ? d[8 + i] : d[i]; e[i] = own + __shfl_xor(send, 32); }
#pragma unroll
              for (int i = 0; i < 4; ++i) { const float send = b4 ? e[i] : e[4 + i], own = b4 ? e[4 + i] : e[i]; g4v[i] = own + __shfl_xor(send, 16); }
#pragma unroll
              for (int i = 0; i < 2; ++i) { const float send = b3 ? g4v[i] : g4v[2 + i], own = b3 ? g4v[2 + i] : g4v[i]; h2[i] = own + __shfl_xor(send, 8); }
              float t1 = (b2 ? h2[1] : h2[0]) + __shfl_xor(b2 ? h2[0] : h2[1], 4);
              t1 += __shfl_xor(t1, 2); t1 += __shfl_xor(t1, 1);
              const int gidx = ((lane >> 5) & 1) * 8 + ((lane >> 4) & 1) * 4 + ((lane >> 3) & 1) * 2 + ((lane >> 2) & 1);
              const float gbv = __shfl(gb, gidx);
              if ((lane & 3) == 0) graw[(size_t)m * 16 + gidx] = t1 + gbv; }
        }
    }
    __syncthreads();
}
__device__ __forceinline__ void gate_scans(Frame& F) {
    LAS float* gl = (LAS float*)(F.lds);
    const float* graw = (const float*)(F.ws + WS_GRAW);
    int lane = F.lane, wv = F.wave; asm volatile("" : "+v"(lane), "+s"(wv));
    for (int u = F.vcu; u < 264; u += F.G) {
        const bool lat = u < 256; const int b = lat ? (u >> 6) : ((u - 256) >> 1); const int slot = lat ? (2 + (u & 63)) : ((u - 256) & 1);
        const size_t row0 = lat ? (size_t)u * 128 : (size_t)MLAT + (size_t)(u - 256) * 128;
        __syncthreads();
        *(LAS f32x4*)(gl + F.tid * 4) = *(const f32x4*)(graw + row0 * 16 + F.tid * 4);
        __syncthreads();
        const int dir = wv >> 2, h = wv & 3; const int cd = dir * 16 + b * 4 + h;
        const int p0 = dir ? (127 - 2 * lane) : (2 * lane), p1 = dir ? (126 - 2 * lane) : (2 * lane + 1);
        const float li0 = gl[p0 * 16 + 8 * dir + h], fp0 = gl[p0 * 16 + 8 * dir + 4 + h], li1 = gl[p1 * 16 + 8 * dir + h], fp1 = gl[p1 * 16 + 8 * dir + 4 + h];
        const float lf0 = fminf(fp0, 0.f) - log1pf(expf(-fabsf(fp0))), lf1 = fminf(fp1, 0.f) - log1pf(expf(-fabsf(fp1)));
        float ps = lf0 + lf1;
#pragma unroll
        for (int d = 1; d < 64; d <<= 1) { const float t = __shfl_up(ps, d); if (lane >= d) ps += t; }
        const float ex = ps - (lf0 + lf1);
        const float run0 = ex + lf0, run1 = run0 + lf1;
        const float a0 = li0 - run0, a1 = li1 - run1;
        float pm = fmaxf(a0, a1);
#pragma unroll
        for (int d = 1; d < 64; d <<= 1) { const float t = __shfl_up(pm, d); if (lane >= d) pm = fmaxf(pm, t); }
        float em = __shfl_up(pm, 1); if (lane == 0) em = -INFINITY;
        const float mx0 = fmaxf(em, a0), mx1 = fmaxf(mx0, a1);
        float* cum = (float*)(F.ws + WS_CUM) + ((size_t)cd * NSLOT + slot) * 128; float* aa = (float*)(F.ws + WS_AA) + ((size_t)cd * NSLOT + slot) * 128; float* pmx = (float*)(F.ws + WS_PM) + ((size_t)cd * NSLOT + slot) * 128;
        const int pl = dir ? p1 : p0;
        f32x2v cv, av, mv;
        cv.x = dir ? run1 : run0; cv.y = dir ? run0 : run1; av.x = dir ? a1 : a0; av.y = dir ? a0 : a1; mv.x = dir ? mx1 : mx0; mv.y = dir ? mx0 : mx1;
        *(f32x2v*)(cum + pl) = cv; *(f32x2v*)(aa + pl) = av; *(f32x2v*)(pmx + pl) = mv;
        if (lane == 63) { ((float*)(F.ws + WS_TOT))[cd * NSLOT + slot] = run1; ((float*)(F.ws + WS_AMAX))[cd * NSLOT + slot] = mx1; }
    }
    __syncthreads();
}

__device__ __forceinline__ void p11_final_ln(Frame& F) {
    int lane = F.lane, wv = F.wave; asm volatile("" : "+v"(lane), "+s"(wv));
    const int gw = F.vcu * NWAVES + wv;
    const int rpw = (MLAT + F.G * NWAVES - 1) / (F.G * NWAVES);
    const int m0 = gw * rpw, m1 = (m0 + rpw < MLAT) ? (m0 + rpw) : MLAT;
    if (m0 < m1) {
        f32x4 pg[4], pb[4]; unsigned long long xn[4];
#pragma unroll
        for (int j = 0; j < 4; ++j) { pg[j] = *((const f32x4*)(F.pgain + 1024) + lane + 64 * j); pb[j] = *((const f32x4*)(F.pbias + 1024) + lane + 64 * j); }
        const unsigned long long* gyb = (const unsigned long long*)(F.ws + WS_GY); unsigned long long gn[4];
#pragma unroll
        for (int j = 0; j < 4; ++j) { xn[j] = *((const GAS unsigned long long*)(F.out + (size_t)m0 * 1024) + lane + 64 * j); gn[j] = gyb[(size_t)m0 * 256 + lane + 64 * j]; }
        for (int m = m0; m < m1; ++m) {
            f32x4 v[4];
#pragma unroll
            for (int j = 0; j < 4; ++j) { const unsigned lo = (unsigned)gn[j], hi = (unsigned)(gn[j] >> 32), xl = (unsigned)xn[j], xh = (unsigned)(xn[j] >> 32);
                v[j].x = __builtin_bit_cast(float, xl << 16) * ALPHA_RES + __builtin_bit_cast(float, lo << 16); v[j].y = __builtin_bit_cast(float, xl & 0xffff0000u) * ALPHA_RES + __builtin_bit_cast(float, lo & 0xffff0000u);
                v[j].z = __builtin_bit_cast(float, xh << 16) * ALPHA_RES + __builtin_bit_cast(float, hi << 16); v[j].w = __builtin_bit_cast(float, xh & 0xffff0000u) * ALPHA_RES + __builtin_bit_cast(float, hi & 0xffff0000u); }
            GAS f32x4* zr = (GAS f32x4*)(F.out + (size_t)m * 1024) + lane;
            if (m + 1 < m1) {
#pragma unroll
                for (int j = 0; j < 4; ++j) { xn[j] = *((const GAS unsigned long long*)(F.out + (size_t)(m + 1) * 1024) + lane + 64 * j); gn[j] = gyb[(size_t)(m + 1) * 256 + lane + 64 * j]; } }
            float s = 0.f;
#pragma unroll
            for (int j = 0; j < 4; ++j) s += (v[j].x + v[j].y) + (v[j].z + v[j].w);
            const float mean = wave_sum(s) * (1.f / 1024.f); float s2 = 0.f;
#pragma unroll
            for (int j = 0; j < 4; ++j) { v[j] = v[j] - mean; s2 += (v[j].x * v[j].x + v[j].y * v[j].y) + (v[j].z * v[j].z + v[j].w * v[j].w); }
            const float rstd = rsqrtf(wave_sum(s2) * (1.f / 1024.f) + LN_EPS);
#pragma unroll
            for (int j = 0; j < 4; ++j) zr[64 * j] = v[j] * rstd * pg[j] + pb[j];
        }
    }
}

typedef float f32x16 __attribute__((ext_vector_type(16)));

__device__ __forceinline__ float bf2f(unsigned short h) { return __builtin_bit_cast(float, (unsigned)h << 16); }

__device__ __forceinline__ void fourier_s1_f1(Frame& F, int item, LAS unsigned char* L, int lane, int w) {
    const int tp = item & 31, g = (item >> 5) & 3, b = item >> 7;
    const int r = lane & 31, h = lane >> 5;
    const int t2l = w >> 2, t1 = 32 * (w & 3) + r; const int t = 64 * t1 + 2 * tp + t2l;
    const bf16* Ur = (const bf16*)(F.ws + WS_U) + ((size_t)b * SEQ + t) * 256 + g * 64 + 8 * h;
    bf16x8 bu[4];
#pragma unroll
    for (int ks = 0; ks < 4; ++ks) bu[ks] = *(const bf16x8*)(Ur + 16 * ks);
    const bf16* FMT = (const bf16*)(F.ws + WS_FMT) + (size_t)(g * 128 + r) * 64 + 8 * h;
#pragma unroll
    for (int mt = 0; mt < 4; ++mt) {
        f32x16 a = {0.f, 0.f, 0.f, 0.f, 0.f, 0.f, 0.f, 0.f, 0.f, 0.f, 0.f, 0.f, 0.f, 0.f, 0.f, 0.f};
#pragma unroll
        for (int ks = 0; ks < 4; ++ks) { const bf16x8 af = *(const bf16x8*)(FMT + mt * 32 * 64 + 16 * ks); a = __builtin_amdgcn_mfma_f32_32x32x16_bf16(af, bu[ks], a, 0, 0, 0); }
#pragma unroll
        for (int q = 0; q < 8; ++q) { const int d = 16 * mt + 4 * (q >> 1) + 2 * h + (q & 1); const int col = t2l * 64 + d;
            *(LAS unsigned*)(L + col * 512 + (((t1 >> 2) ^ (col & 15)) << 4) + (t1 & 3) * 4) = pk2m(a[2 * q], a[2 * q + 1]); }
    }
}
__device__ __forceinline__ void fourier_s1_dft(Frame& F, int item, const LAS unsigned char* L, const bf16x8 (&a1)[16], int lane, int w) {
    const int tp = item & 31;
    const int r = lane & 31, h = lane >> 5;
    const f32x2v* TW = (const f32x2v*)(F.ws + WS_TW);
    unsigned long long* YG = (unsigned long long*)(F.ws + WS_YG) + (size_t)item * 128 * 64;
#pragma unroll
    for (int np = 0; np < 2; ++np) {
        f32x16 a0 = {0.f, 0.f, 0.f, 0.f, 0.f, 0.f, 0.f, 0.f, 0.f, 0.f, 0.f, 0.f, 0.f, 0.f, 0.f, 0.f}, a2 = a0;
        const int c0 = 32 * np + r, c2 = 64 + 32 * np + r;
#pragma unroll
        for (int ks = 0; ks < 16; ++ks) {
            const bf16x8 b0 = *(const LAS bf16x8*)(L + c0 * 512 + (((2 * ks + h) ^ (c0 & 15)) << 4)), b2 = *(const LAS bf16x8*)(L + c2 * 512 + (((2 * ks + h) ^ (c2 & 15)) << 4));
            a0 = __builtin_amdgcn_mfma_f32_32x32x16_bf16(a1[ks], b0, a0, 0, 0, 0); a2 = __builtin_amdgcn_mfma_f32_32x32x16_bf16(a1[ks], b2, a2, 0, 0, 0);
        }
        const int d = 32 * np + r;
#pragma unroll
        for (int q = 0; q < 8; ++q) {
            const int k1 = 16 * w + 4 * (q >> 1) + 2 * h + (q & 1);
            const f32x2v tw0 = TW[k1 * 64 + 2 * tp], tw1 = TW[k1 * 64 + 2 * tp + 1];
            const float zr0 = a0[2 * q] * tw0.x + a0[2 * q + 1] * tw0.y, zi0 = a0[2 * q + 1] * tw0.x - a0[2 * q] * tw0.y;
            const float zr1 = a2[2 * q] * tw1.x + a2[2 * q + 1] * tw1.y, zi1 = a2[2 * q + 1] * tw1.x - a2[2 * q] * tw1.y;
            YG[k1 * 64 + d] = (unsigned long long)pk2(zr0, zi0) | ((unsigned long long)pk2(zr1, zi1) << 32);
        }
    }
}
__device__ __forceinline__ void fourier_s1_pair(Frame& F, int item0, int item1) {
    LAS unsigned char* L = F.lds + RING_OFF;
    int lane = F.lane, w = F.wave; asm volatile("" : "+v"(lane), "+s"(w));
    __syncthreads();
    fourier_s1_f1(F, item0, L, lane, w);
    fourier_s1_f1(F, item1, L + 65536, lane, w);
    bf16x8 a1[16];
    { const bf16* A1 = (const bf16*)(F.ws + WS_A1) + (size_t)(32 * w + (lane & 31)) * 256 + 8 * (lane >> 5);
#pragma unroll
      for (int ks = 0; ks < 16; ++ks) a1[ks] = *(const bf16x8*)(A1 + 16 * ks); }
    __syncthreads();
    fourier_s1_dft(F, item0, L, a1, lane, w);
    fourier_s1_dft(F, item1, L + 65536, a1, lane, w);
}
__device__ __forceinline__ void fourier_s2_item(Frame& F, int item) {
    const int kp = item & 63, g = (item >> 6) & 3, b = item >> 8;
    int lane = F.lane, w = F.wave; asm volatile("" : "+v"(lane), "+s"(w));
    const int r = lane & 31, h = lane >> 5, nt = w & 3, mt = w >> 2;
    const int k1 = 2 * kp + (nt >> 1), d = 32 * (nt & 1) + r;
    const unsigned long long* YG = (const unsigned long long*)(F.ws + WS_YG) + ((size_t)(b * 4 + g) * 32 * 128 + k1) * 64 + d;
    const bf16* A2 = (const bf16*)(F.ws + WS_A2) + (size_t)(32 * mt + r) * 128 + 8 * h;
    f32x16 acc = {0.f, 0.f, 0.f, 0.f, 0.f, 0.f, 0.f, 0.f, 0.f, 0.f, 0.f, 0.f, 0.f, 0.f, 0.f, 0.f};
    unsigned long long yb[8][2];
#pragma unroll
    for (int ks = 0; ks < 8; ++ks) { yb[ks][0] = YG[(size_t)(4 * ks + 2 * h) * 128 * 64]; yb[ks][1] = YG[(size_t)(4 * ks + 2 * h + 1) * 128 * 64]; }
#pragma unroll
    for (int ks = 0; ks < 8; ++ks) {
        const bf16x8 af = *(const bf16x8*)(A2 + 16 * ks);
        v4u bq; bq.x = (unsigned)yb[ks][0]; bq.y = (unsigned)(yb[ks][0] >> 32); bq.z = (unsigned)yb[ks][1]; bq.w = (unsigned)(yb[ks][1] >> 32);
        acc = __builtin_amdgcn_mfma_f32_32x32x16_bf16(af, __builtin_bit_cast(bf16x8, bq), acc, 0, 0, 0);
    }
    LAS float* stg = (LAS float*)(F.lds + RING_OFF + 86016) + w * 1152;
#pragma unroll
    for (int rg = 0; rg < 16; ++rg) stg[((rg & 3) + 8 * (rg >> 2) + 4 * h) * 36 + r] = acc[rg];
    asm volatile("s_waitcnt lgkmcnt(0)" ::: "memory");
    const int q4 = lane & 3;
#pragma unroll
    for (int ps = 0; ps < 2; ++ps) {
        const int row = 16 * ps + (lane >> 2); const int t = k1 + 128 * (32 * mt + row);
        const f32x4 x0 = *(const LAS f32x4*)(stg + row * 36 + 8 * q4), x1 = *(const LAS f32x4*)(stg + row * 36 + 8 * q4 + 4);
        const v4u gq = *(const GAS v4u*)((const bf16*)(F.ws + WS_GB) + ((size_t)b * SEQ + t) * 256 + g * 64 + 32 * (nt & 1) + 8 * q4);
        v4u o;
        o.x = pk2(x0[0] * __builtin_bit_cast(float, gq.x << 16), x0[1] * __builtin_bit_cast(float, gq.x & 0xffff0000u));
        o.y = pk2(x0[2] * __builtin_bit_cast(float, gq.y << 16), x0[3] * __builtin_bit_cast(float, gq.y & 0xffff0000u));
        o.z = pk2(x1[0] * __builtin_bit_cast(float, gq.z << 16), x1[1] * __builtin_bit_cast(float, gq.z & 0xffff0000u));
        o.w = pk2(x1[2] * __builtin_bit_cast(float, gq.w << 16), x1[3] * __builtin_bit_cast(float, gq.w & 0xffff0000u));
        *(GAS v4u*)((bf16*)(F.ws + WS_Y) + ((size_t)b * SEQ + t) * 1024 + 768 + g * 64 + 32 * (nt & 1) + 8 * q4) = o;
    }
    asm volatile("s_waitcnt lgkmcnt(0)" ::: "memory");
}
__device__ __forceinline__ void fourier_ctx_item(Frame& F, int item) {
    const int g = item & 3, b = item >> 2;
    LAS unsigned char* L = F.lds + RING_OFF;
    int lane = F.lane, w = F.wave; asm volatile("" : "+v"(lane), "+s"(w));
    const int r = lane & 31, h = lane >> 5;
    __syncthreads();
    {
        const int t = 32 * w + r;
        const bf16* Ur = (const bf16*)(F.ws + WS_U) + ((size_t)MLAT + b * CTXL + t) * 256 + g * 64 + 8 * h;
        bf16x8 bu[4];
#pragma unroll
        for (int ks = 0; ks < 4; ++ks) bu[ks] = *(const bf16x8*)(Ur + 16 * ks);
        const bf16* FMT = (const bf16*)(F.ws + WS_FMT) + (size_t)(g * 128 + r) * 64 + 8 * h;
#pragma unroll
        for (int mt = 0; mt < 4; ++mt) {
            f32x16 a = {0.f, 0.f, 0.f, 0.f, 0.f, 0.f, 0.f, 0.f, 0.f, 0.f, 0.f, 0.f, 0.f, 0.f, 0.f, 0.f};
#pragma unroll
            for (int ks = 0; ks < 4; ++ks) { const bf16x8 af = *(const bf16x8*)(FMT + mt * 32 * 64 + 16 * ks); a = __builtin_amdgcn_mfma_f32_32x32x16_bf16(af, bu[ks], a, 0, 0, 0); }
#pragma unroll
            for (int q = 0; q < 8; ++q) { const int d = 16 * mt + 4 * (q >> 1) + 2 * h + (q & 1);
                *(LAS unsigned*)(L + d * 1024 + (((t >> 2) ^ (d & 15)) << 4) + (t & 3) * 4) = pk2(a[2 * q] * 5.656854249492381f, a[2 * q + 1] * 5.656854249492381f); }
        }
    }
    __syncthreads();
    {
        const bf16* AC = (const bf16*)(F.ws + WS_ACTX) + (size_t)(32 * w + r) * 512 + 8 * h;
        f32x16 acc[2];
#pragma unroll
        for (int nt = 0; nt < 2; ++nt) acc[nt] = (f32x16){0.f, 0.f, 0.f, 0.f, 0.f, 0.f, 0.f, 0.f, 0.f, 0.f, 0.f, 0.f, 0.f, 0.f, 0.f, 0.f};
#pragma unroll 4
        for (int ks = 0; ks < 32; ++ks) { const bf16x8 af = *(const bf16x8*)(AC + 16 * ks);
#pragma unroll
            for (int nt = 0; nt < 2; ++nt) { const int d = 32 * nt + r; const bf16x8 bfr = *(const LAS bf16x8*)(L + d * 1024 + (((2 * ks + h) ^ (d & 15)) << 4)); acc[nt] = __builtin_amdgcn_mfma_f32_32x32x16_bf16(af, bfr, acc[nt], 0, 0, 0); } }
        __syncthreads();
        LAS float* stg = (LAS float*)L + w * 2176;
#pragma unroll
        for (int nt = 0; nt < 2; ++nt)
#pragma unroll
            for (int rg = 0; rg < 16; ++rg) stg[((rg & 3) + 8 * (rg >> 2) + 4 * h) * 68 + 32 * nt + r] = acc[nt][rg];
        asm volatile("s_waitcnt lgkmcnt(0)" ::: "memory");
        const int q8 = lane & 7;
#pragma unroll
        for (int ps = 0; ps < 4; ++ps) {
            const int row = 8 * ps + (lane >> 3); const size_t tok = (size_t)MLAT + b * CTXL + 32 * w + row;
            const f32x4 x0 = *(const LAS f32x4*)(stg + row * 68 + 8 * q8), x1 = *(const LAS f32x4*)(stg + row * 68 + 8 * q8 + 4);
            const v4u gq = *(const GAS v4u*)((const bf16*)(F.ws + WS_GB) + tok * 256 + g * 64 + 8 * q8);
            v4u o;
            o.x = pk2(x0[0] * __builtin_bit_cast(float, gq.x << 16), x0[1] * __builtin_bit_cast(float, gq.x & 0xffff0000u));
            o.y = pk2(x0[2] * __builtin_bit_cast(float, gq.y << 16), x0[3] * __builtin_bit_cast(float, gq.y & 0xffff0000u));
            o.z = pk2(x1[0] * __builtin_bit_cast(float, gq.z << 16), x1[1] * __builtin_bit_cast(float, gq.z & 0xffff0000u));
            o.w = pk2(x1[2] * __builtin_bit_cast(float, gq.w << 16), x1[3] * __builtin_bit_cast(float, gq.w & 0xffff0000u));
            *(GAS v4u*)((bf16*)(F.ws + WS_Y) + tok * 1024 + 768 + g * 64 + 8 * q8) = o;
        }
    }
    __syncthreads();
}

namespace attn_body {
using bf16=__hip_bfloat16;
using bf16x8=__attribute__((ext_vector_type(8)))short;
using s16x4=__attribute__((ext_vector_type(4)))short;
using f32x16=__attribute__((ext_vector_type(16)))float;
using u32x4=__attribute__((ext_vector_type(4)))unsigned;
constexpr int NW=8,QBLK=32,QB=QBLK*NW,KVBLK=64;
constexpr int QP=768,KP=256,OP=1024,GP=768;
__device__ __forceinline__ int crow(int r,int hi){return (r&3)+8*(r>>2)+4*hi;}
#define SBAR() __builtin_amdgcn_sched_barrier(0)
constexpr int NSLOT=3, SLOTB=8192;
constexpr int LDS_K=0, LDS_V=NSLOT*SLOTB, LDS_WS=2*NSLOT*SLOTB, LDS_OST=LDS_WS+NW*64*4, LDS_BYTES=LDS_OST+NW*4096;
__device__ __forceinline__ void glds16(const void*gsrc,unsigned lds_dst){unsigned keep;
  asm volatile("s_mov_b32 %0, m0\n\ts_mov_b32 m0, %2\n\ts_nop 0\n\tglobal_load_lds_dwordx4 %1, off\n\ts_mov_b32 m0, %0":"=&s"(keep):"v"(gsrc),"s"(lds_dst):"memory");}
typedef float f32x2_t __attribute__((ext_vector_type(2))); typedef __bf16 bf16x2_t __attribute__((ext_vector_type(2)));
__device__ __forceinline__ unsigned cvtpk_s(float lo,float hi){f32x2_t v={lo,hi};bf16x2_t b=__builtin_convertvector(v,bf16x2_t);return __builtin_bit_cast(unsigned,b);}
#define WAIT_BAR(N) asm volatile("s_waitcnt vmcnt(" #N ") lgkmcnt(0)\n\ts_barrier":::"memory")

__device__ __forceinline__ void qkt(f32x16&p0,f32x16&p1,const char*Kslot,const bf16x8*qr,const f32x16&negm,int r32,int hi){
  const char*kb=Kslot+hi*1024+r32*16;
  #pragma unroll
  for(int d0=0;d0<4;++d0){
    const bf16x8 b0=*reinterpret_cast<const bf16x8*>(kb+d0*2048);
    const bf16x8 b1=*reinterpret_cast<const bf16x8*>(kb+d0*2048+512);
    if(d0==0){p0=__builtin_amdgcn_mfma_f32_32x32x16_bf16(b0,qr[0],negm,0,0,0);p1=__builtin_amdgcn_mfma_f32_32x32x16_bf16(b1,qr[0],negm,0,0,0);}
    else{p0=__builtin_amdgcn_mfma_f32_32x32x16_bf16(b0,qr[d0],p0,0,0,0);p1=__builtin_amdgcn_mfma_f32_32x32x16_bf16(b1,qr[d0],p1,0,0,0);}}
}
typedef __attribute__((address_space(3))) const char* lds_cptr;
typedef short v4i16_t __attribute__((ext_vector_type(4)));
__device__ __forceinline__ void kload8(bf16x8*kf,lds_cptr kp){
  kf[0]=*(const __attribute__((address_space(3))) bf16x8*)(kp);      kf[1]=*(const __attribute__((address_space(3))) bf16x8*)(kp+512);
  kf[2]=*(const __attribute__((address_space(3))) bf16x8*)(kp+2048); kf[3]=*(const __attribute__((address_space(3))) bf16x8*)(kp+2560);
  kf[4]=*(const __attribute__((address_space(3))) bf16x8*)(kp+4096); kf[5]=*(const __attribute__((address_space(3))) bf16x8*)(kp+4608);
  kf[6]=*(const __attribute__((address_space(3))) bf16x8*)(kp+6144); kf[7]=*(const __attribute__((address_space(3))) bf16x8*)(kp+6656);
}
__device__ __forceinline__ void kload2(bf16x8*kf,lds_cptr kp,int j){ kf[2*j]=*(const __attribute__((address_space(3))) bf16x8*)(kp+j*2048); kf[2*j+1]=*(const __attribute__((address_space(3))) bf16x8*)(kp+j*2048+512); }
__device__ __forceinline__ s16x4 vtr(lds_cptr p){ return __builtin_bit_cast(s16x4,__builtin_amdgcn_ds_read_tr16_b64_v4i16((__attribute__((address_space(3))) v4i16_t*)p)); }
__device__ __forceinline__ void pv(f32x16*o,int vb,bf16x8 pa0,bf16x8 pa1,bf16x8 pa2,bf16x8 pa3){
  #pragma unroll
  for(int d0=0;d0<2;++d0){s16x4 lo[4],hi[4];
    #pragma unroll
    for(int ks=0;ks<4;++ks){
      asm volatile("ds_read_b64_tr_b16 %0,%1 offset:%c2":"=&v"(lo[ks]):"v"(vb),"i"(d0*4096+ks*1024):"memory");
      asm volatile("ds_read_b64_tr_b16 %0,%1 offset:%c2":"=&v"(hi[ks]):"v"(vb),"i"(d0*4096+ks*1024+512):"memory");}
    asm volatile("s_waitcnt lgkmcnt(0)":::"memory");SBAR();
    #define PK(k) (bf16x8){lo[k][0],lo[k][1],lo[k][2],lo[k][3],hi[k][0],hi[k][1],hi[k][2],hi[k][3]}
    o[d0]=__builtin_amdgcn_mfma_f32_32x32x16_bf16(pa0,PK(0),o[d0],0,0,0);
    o[d0]=__builtin_amdgcn_mfma_f32_32x32x16_bf16(pa1,PK(1),o[d0],0,0,0);
    o[d0]=__builtin_amdgcn_mfma_f32_32x32x16_bf16(pa2,PK(2),o[d0],0,0,0);
    o[d0]=__builtin_amdgcn_mfma_f32_32x32x16_bf16(pa3,PK(3),o[d0],0,0,0);
    #undef PK
  }
}
__device__ __forceinline__ float bfbits2f(unsigned short h){ return __builtin_bit_cast(float,(unsigned)h<<16); }

__device__ __forceinline__ void attn_unit(const bf16*Qu,const bf16*__restrict__ Kh,const bf16*__restrict__ Vh,const int NT,bf16*Ou,const bf16*Gu,const float shift,char*shm){
  const int tid=threadIdx.x,lane=tid&63,r32=lane&31,hi=lane>>5; const int wid=__builtin_amdgcn_readfirstlane(tid>>6);
  const bf16*Qw=Qu+(long)(wid*QBLK)*QP;
  const unsigned lds0=(unsigned)(uintptr_t)shm;
  float*wsf=(float*)(shm+LDS_WS)+wid*64;
  const bf16*ksrc=Kh+(long)lane*KP+wid*8;
  const bf16*vsrc=Vh+(long)(16*(wid&3)+(lane>>2))*KP+(wid>>2)*32+(lane&3)*8;
  const unsigned kdst=lds0+LDS_K+wid*1024, vdst=lds0+LDS_V+wid*1024;
  #define DMA_K(t,slot) glds16(ksrc+(long)(t)*KVBLK*KP,(unsigned)__builtin_amdgcn_readfirstlane(kdst+(slot)))
  #define DMA_V(t,slot) glds16(vsrc+(long)(t)*KVBLK*KP,(unsigned)__builtin_amdgcn_readfirstlane(vdst+(slot)))
  const int vb0=(int)(lds0+LDS_V)+((lane>>4)&1)*32+(lane&3)*8+(4*hi+((lane&15)>>2))*64;
  const char*Kbase=shm+LDS_K; bf16x8 kf[8];
  const lds_cptr shm3=(lds_cptr)shm; const lds_cptr kp0=shm3+LDS_K+hi*1024+r32*16; const lds_cptr vp0=shm3+LDS_V+((lane>>4)&1)*32+(lane&3)*8+(4*hi+((lane&15)>>2))*64;
  DMA_K(0,0);DMA_V(0,0);DMA_K(1,SLOTB);
  bf16x8 qr[4];
  #pragma unroll
  for(int d0=0;d0<4;++d0)qr[d0]=*reinterpret_cast<const bf16x8*>(&Qw[(long)r32*QP+d0*16+hi*8]);
  float l_reg=0.f;f32x16 o[2];o[0]=f32x16{};o[1]=f32x16{};f32x16 negm;
  #pragma unroll
  for(int r=0;r<16;++r)negm[r]=-shift;
  asm volatile("":"+v"(negm));
  f32x16 pA0,pA1,pB0,pB1;
  int sl_prev=0,sl_cur=0,sl_next=SLOTB;
  #define ROT() do{sl_prev=sl_cur;sl_cur=sl_next;sl_next=(sl_next==(NSLOT-1)*SLOTB)?0:sl_next+SLOTB;}while(0)
  DMA_K(2,2*SLOTB);
  WAIT_BAR(3);
  qkt(pA0,pA1,Kbase,qr,negm,r32,hi);asm volatile("s_nop 15\n\ts_nop 7":"+v"(pA0),"+v"(pA1));
  _Pragma("unroll") for(int r=0;r<16;++r)pA0[r]=__builtin_amdgcn_exp2f(pA0[r]);
  _Pragma("unroll") for(int r=0;r<16;++r)pA1[r]=__builtin_amdgcn_exp2f(pA1[r]);
  WAIT_BAR(0);
  DMA_K(3,0);DMA_V(1,SLOTB);
  ROT();
  kload8(kf,kp0+sl_cur);
  WAIT_BAR(2);
  s16x4 vlo[8],vhi[8]; u32x4 pw0,pw1,pw2,pw3;
  #define PKW(P,B) cvtpk_s(P[B],P[B+1])
  #define PAF(k) __builtin_bit_cast(bf16x8,pw##k)
  #define VFR(i) (bf16x8){vlo[i][0],vlo[i][1],vlo[i][2],vlo[i][3],vhi[i][0],vhi[i][1],vhi[i][2],vhi[i][3]}
  #define PIN(x) asm volatile("":"+v"(x))
  #define GAPA(MF,A0,A1,A2,A3,W0,W1,PW) do{ MF; sacc+=A0; sacc+=A1; sacc+=A2; sacc+=A3; PIN(sacc); W0; W1; PIN(PW); SBAR(); }while(0)
  #define EX(v) __builtin_amdgcn_exp2f(v)
  #define GAPB(MF,X,B) do{ MF; X[B]=EX(X[B]); X[B+1]=EX(X[B+1]); X[B+2]=EX(X[B+2]); X[B+3]=EX(X[B+3]); PIN(X); SBAR(); }while(0)
  #define VRD(i) do{ vlo[i]=vtr(vp_+(((i)>>2)*4096+((i)&3)*1024)); vhi[i]=vtr(vp_+(((i)>>2)*4096+((i)&3)*1024+512)); }while(0)
  #define KRD(G,j) do{ if(G){ kload2(kf,kp0+sl_next,j); SBAR(); } }while(0)
  #define STEP(C0,C1,P0,P1,t,GK,GV,GL) do{ SBAR(); \
    const lds_cptr vp_=vp0+sl_prev; \
    VRD(0); SBAR(); float sacc=(P0[0]+P0[1]); \
    GAPA(C0=__builtin_amdgcn_mfma_f32_32x32x16_bf16(kf[0],qr[0],negm,0,0,0), P0[2],P0[3],P0[4],P0[5],     pw0[0]=PKW(P0,0), pw0[1]=PKW(P0,2), pw0); \
    VRD(4); SBAR(); GAPA(C1=__builtin_amdgcn_mfma_f32_32x32x16_bf16(kf[1],qr[0],negm,0,0,0), P0[6],P0[7],P0[8],P0[9],     pw0[2]=PKW(P0,4), pw0[3]=PKW(P0,6), pw0); \
    VRD(1); SBAR(); GAPA(C0=__builtin_amdgcn_mfma_f32_32x32x16_bf16(kf[2],qr[1],C0,0,0,0),   P0[10],P0[11],P0[12],P0[13], pw1[0]=PKW(P0,8), pw1[1]=PKW(P0,10), pw1); \
    VRD(5); SBAR(); GAPA(C1=__builtin_amdgcn_mfma_f32_32x32x16_bf16(kf[3],qr[1],C1,0,0,0),   P0[14],P0[15],P1[0],P1[1],   pw1[2]=PKW(P0,12),pw1[3]=PKW(P0,14), pw1); \
    VRD(2); SBAR(); GAPA(C0=__builtin_amdgcn_mfma_f32_32x32x16_bf16(kf[4],qr[2],C0,0,0,0),   P1[2],P1[3],P1[4],P1[5],     pw2[0]=PKW(P1,0), pw2[1]=PKW(P1,2), pw2); \
    VRD(6); SBAR(); GAPA(C1=__builtin_amdgcn_mfma_f32_32x32x16_bf16(kf[5],qr[2],C1,0,0,0),   P1[6],P1[7],P1[8],P1[9],     pw2[2]=PKW(P1,4), pw2[3]=PKW(P1,6), pw2); \
    VRD(3); SBAR(); GAPA(C0=__builtin_amdgcn_mfma_f32_32x32x16_bf16(kf[6],qr[3],C0,0,0,0),   P1[10],P1[11],P1[12],P1[13], pw3[0]=PKW(P1,8), pw3[1]=PKW(P1,10), pw3); \
    VRD(7); SBAR(); GAPA(C1=__builtin_amdgcn_mfma_f32_32x32x16_bf16(kf[7],qr[3],C1,0,0,0),   P1[14],P1[15],0.f,0.f,       pw3[2]=PKW(P1,12),pw3[3]=PKW(P1,14), pw3); \
    l_reg+=sacc; \
    if(GK){DMA_K((t)+3,sl_cur);} if(GV){DMA_V((t)+1,sl_next);} \
    SBAR(); \
    GAPB(o[0]=__builtin_amdgcn_mfma_f32_32x32x16_bf16(PAF(0),VFR(0),o[0],0,0,0), C0,0); \
    GAPB(o[1]=__builtin_amdgcn_mfma_f32_32x32x16_bf16(PAF(0),VFR(4),o[1],0,0,0), C0,4); \
    KRD(GL,0); GAPB(o[0]=__builtin_amdgcn_mfma_f32_32x32x16_bf16(PAF(1),VFR(1),o[0],0,0,0), C0,8); \
    KRD(GL,1); GAPB(o[1]=__builtin_amdgcn_mfma_f32_32x32x16_bf16(PAF(1),VFR(5),o[1],0,0,0), C0,12); \
    KRD(GL,2); GAPB(o[0]=__builtin_amdgcn_mfma_f32_32x32x16_bf16(PAF(2),VFR(2),o[0],0,0,0), C1,0); \
    KRD(GL,3); GAPB(o[1]=__builtin_amdgcn_mfma_f32_32x32x16_bf16(PAF(2),VFR(6),o[1],0,0,0), C1,4); \
    GAPB(o[0]=__builtin_amdgcn_mfma_f32_32x32x16_bf16(PAF(3),VFR(3),o[0],0,0,0), C1,8); \
    GAPB(o[1]=__builtin_amdgcn_mfma_f32_32x32x16_bf16(PAF(3),VFR(7),o[1],0,0,0), C1,12); \
    }while(0)
  int t=1;
  for(;t+5<NT;t+=2){
    STEP(pB0,pB1,pA0,pA1,t,true,true,true);     WAIT_BAR(2); ROT();
    STEP(pA0,pA1,pB0,pB1,t+1,true,true,true);   WAIT_BAR(2); ROT();
  }
  #define ENDW(tt) do{ if((tt)+3<NT){WAIT_BAR(2);} else if((tt)+2<NT){WAIT_BAR(1);} else {WAIT_BAR(0);} }while(0)
  for(;t+1<NT;t+=2){
    STEP(pB0,pB1,pA0,pA1,t,(t+3<NT),(t+1<NT),(t+1<NT));       ENDW(t);   ROT();
    STEP(pA0,pA1,pB0,pB1,t+1,(t+4<NT),(t+2<NT),(t+2<NT));     ENDW(t+1); ROT();
  }
  STEP(pB0,pB1,pA0,pA1,NT-1,false,false,false);
  { float sacc=pB0[0]+pB0[1]; _Pragma("unroll") for(int r=2;r<16;++r)sacc+=pB0[r]; _Pragma("unroll") for(int r=0;r<16;++r)sacc+=pB1[r]; l_reg+=sacc;
    pw0=(u32x4){PKW(pB0,0),PKW(pB0,2),PKW(pB0,4),PKW(pB0,6)};pw1=(u32x4){PKW(pB0,8),PKW(pB0,10),PKW(pB0,12),PKW(pB0,14)};pw2=(u32x4){PKW(pB1,0),PKW(pB1,2),PKW(pB1,4),PKW(pB1,6)};pw3=(u32x4){PKW(pB1,8),PKW(pB1,10),PKW(pB1,12),PKW(pB1,14)};
    SBAR(); pv(o,vb0+sl_cur,PAF(0),PAF(1),PAF(2),PAF(3)); }
  #undef PKW
  #undef PAF
  #undef VFR
  #undef PIN
  #undef GAPA
  #undef GAPB
  #undef EX
  #undef VRD
  #undef KRD
  #undef STEP
  #undef ENDW
  {auto rr=__builtin_amdgcn_permlane32_swap(__float_as_uint(l_reg),__float_as_uint(l_reg),false,false);l_reg=__uint_as_float(rr[0])+__uint_as_float(rr[1]);}
  if(hi==0)wsf[32+r32]=l_reg;asm volatile("s_waitcnt lgkmcnt(0)":::"memory");
  float rli[16];
  #pragma unroll
  for(int r=0;r<16;++r)rli[r]=__builtin_amdgcn_rcpf(wsf[32+crow(r,hi)]);
  bf16*Ow=Ou+(long)(wid*QBLK)*OP; const bf16*Gw=Gu+(long)(wid*QBLK)*GP;
  { bf16*stg=(bf16*)(shm+LDS_OST)+wid*2048;
    #pragma unroll
    for(int r=0;r<16;++r){const int orow=crow(r,hi);
      #pragma unroll
      for(int d0=0;d0<2;++d0)stg[orow*64+d0*32+r32]=__float2bfloat16(o[d0][r]*rli[r]);}
    asm volatile("s_waitcnt lgkmcnt(0)":::"memory");
    #pragma unroll
    for(int i=0;i<4;++i){const int row=i*8+(lane>>3),ch=lane&7; const u32x4 v=*(const u32x4*)(stg+row*64+ch*8); const u32x4 gq=*(const u32x4*)(Gw+(long)row*GP+ch*8);
      u32x4 w;
      #pragma unroll
      for(int e=0;e<4;++e){ const float a0=bfbits2f((unsigned short)(v[e]&0xffffu))*bfbits2f((unsigned short)(gq[e]&0xffffu)), a1=bfbits2f((unsigned short)(v[e]>>16))*bfbits2f((unsigned short)(gq[e]>>16)); w[e]=cvtpk_s(a0,a1); }
      *(u32x4*)(Ow+(long)row*OP+ch*8)=w;} }
  asm volatile("s_waitcnt lgkmcnt(0)\n\ts_barrier":::"memory");
  #undef DMA_K
  #undef DMA_V
  #undef ROT
}
constexpr int ATTN_LDS_BYTES=LDS_BYTES;
#undef SBAR
#undef WAIT_BAR
}

__device__ __forceinline__ void p3a_fourier_s1(Frame& F) {
    using abf = attn_body::bf16;
    for (int v = F.vcu; v < 256; v += F.G) {
        fourier_s1_pair(F, v, v + 256);
        if (v < 16) fourier_ctx_item(F, v);
        else if (v < 64) {
            const int u = v - 16; const int b2 = u / 12, hq = u % 12, hk2 = hq / 3; const size_t row0 = (size_t)MLAT + (size_t)b2 * CTXL;
            const abf* Q0 = (const abf*)(F.ws + WS_Q0); const abf* KA = (const abf*)(F.ws + WS_KALL); const abf* VA = (const abf*)(F.ws + WS_VALL);
            __syncthreads();
            attn_body::attn_unit(Q0 + row0 * 768 + hq * 64, KA + (size_t)b2 * NKEYS * 256 + hk2 * 64, VA + (size_t)b2 * NKEYS * 256 + hk2 * 64, CTXL / 64,
                                 (abf*)(F.ws + WS_Y) + row0 * 1024 + hq * 64, (const abf*)(F.ws + WS_GA) + row0 * 768 + hq * 64, ((const float*)(F.ws + WS_MISCF))[0], (char*)(F.lds + RING_OFF));
        }
    }
}
__device__ __forceinline__ void p3_even_mixers(Frame& F) {
    using abf = attn_body::bf16;
    const abf* Q0 = (const abf*)(F.ws + WS_Q0); const abf* KA = (const abf*)(F.ws + WS_KALL); const abf* VA = (const abf*)(F.ws + WS_VALL);
    const abf* GA = (const abf*)(F.ws + WS_GA); abf* Y = (abf*)(F.ws + WS_Y);
    const float shift = ((const float*)(F.ws + WS_MISCF))[0];
    char* shm = (char*)(F.lds + RING_OFF);
    for (int v = F.vcu; v < 256; v += F.G) {
        for (int k = 0; k < 4; ++k) fourier_s2_item(F, v + 256 * k);
        const int pair = v >> 4, b = pair >> 2, hk = pair & 3;
        for (int i = 0; i < 6; ++i) {
            const int j = (v & 15) * 6 + i; const int hq = hk * 3 + (j >> 5), qb = j & 31;
            const size_t row0 = (size_t)b * SEQ + (size_t)qb * 256;
            attn_body::attn_unit(Q0 + row0 * 768 + hq * 64, KA + (size_t)b * NKEYS * 256 + hk * 64, VA + (size_t)b * NKEYS * 256 + hk * 64, NKEYS / 64,
                                 Y + row0 * 1024 + hq * 64, GA + row0 * 768 + hq * 64, shift, shm);
        }
    }
}

__device__ __forceinline__ int chain_slot(int dir, int step) { return dir == 0 ? step : (step == 0 ? 1 : (step == 1 ? 0 : 67 - step)); }

typedef short s16x4 __attribute__((ext_vector_type(4)));
__device__ __forceinline__ void p7_mlstm_prep(Frame& F) {
    LAS unsigned char* L = F.lds + RING_OFF;
    LAS float* msh = (LAS float*)(F.lds + RING_BYTES + 1024);
    int lane = F.lane, w = F.wave; asm volatile("" : "+v"(lane), "+s"(w));
    const int tid = w * 64 + lane;
    const float* TOT = (const float*)(F.ws + WS_TOT); const float* AMAX = (const float*)(F.ws + WS_AMAX);
    float totA = 0.f, amxA = 0.f, totB = 0.f, amxB = 0.f, aval = 0.f; v4u qn[8], kn[8];
#define P7_LOAD(ITX) do { const int itx_ = (ITX); const int bh_ = itx_ >> 6, slot_ = 2 + (itx_ & 63); const size_t it_ = (size_t)(bh_ * NSLOT + slot_); \
        if (w < 2) { const int cd_ = w * 16 + bh_; const int sA_ = chain_slot(w, lane), sB_ = chain_slot(w, 64 + (lane & 1)); \
            totA = TOT[cd_ * NSLOT + sA_]; amxA = AMAX[cd_ * NSLOT + sA_]; totB = TOT[cd_ * NSLOT + sB_]; amxB = AMAX[cd_ * NSLOT + sB_]; } \
        if (tid >= 256) { const int dir_ = (tid - 256) >> 7, s2_ = tid & 127, cd_ = dir_ * 16 + bh_; aval = ((const float*)(F.ws + WS_AA))[((size_t)cd_ * NSLOT + slot_) * 128 + s2_]; } \
        const bf16* kb_ = (const bf16*)(F.ws + WS_KB) + it_ * 32768; const bf16* qb_ = (const bf16*)(F.ws + WS_QB) + it_ * 32768; \
        _Pragma("unroll") for (int ks = 0; ks < 8; ++ks) qn[ks] = *(const GAS v4u*)(qb_ + ((w * 8 + ks) * 64 + lane) * 8); \
        _Pragma("unroll") for (int i = 0; i < 8; ++i) kn[i] = *(const GAS v4u*)(kb_ + (size_t)(tid + 512 * i) * 8); } while (0)
    if (F.vcu < 1024) P7_LOAD(F.vcu);
    for (int itx = F.vcu; itx < 1024; itx += F.G) {
        const int bh = itx >> 6, slot = 2 + (itx & 63);
        __syncthreads();
        v4u qf[8];
#pragma unroll
        for (int ks = 0; ks < 8; ++ks) qf[ks] = qn[ks];
        {
          if (w < 2) {
              const int dir = w;
              const int pos = (dir == 0) ? slot : (slot == 1 ? 0 : (slot == 0 ? 1 : 67 - slot));
              float A = totA, B = amxA + totA;
#pragma unroll
              for (int d = 1; d < 64; d <<= 1) { const float Ap = __shfl_up(A, d), Bp = __shfl_up(B, d); if (lane >= d) { B = fmaxf(Bp + A, B); A = Ap + A; } }
              float m = 0.f;
              if (pos >= 1) { const int pl = (pos - 1 < 63) ? (pos - 1) : 63;
                  float Am = __builtin_bit_cast(float, __builtin_amdgcn_readlane(__builtin_bit_cast(int, A), pl)), Bm = __builtin_bit_cast(float, __builtin_amdgcn_readlane(__builtin_bit_cast(int, B), pl));
                  if (pos == 65) { const float t64 = __builtin_bit_cast(float, __builtin_amdgcn_readlane(__builtin_bit_cast(int, totB), 0)), x64 = __builtin_bit_cast(float, __builtin_amdgcn_readlane(__builtin_bit_cast(int, amxB), 0));
                      Bm = fmaxf(Bm + t64, x64 + t64); Am = Am + t64; }
                  m = fmaxf(Am, Bm); }
              if (lane == 0) msh[dir] = m;
          }
          if (tid >= 256) msh[512 + ((tid - 256) >> 7) * 128 + (tid & 127)] = aval;
#pragma unroll
          for (int i = 0; i < 8; ++i) *(LAS v4u*)(L + (tid + 512 * i) * 16) = kn[i]; }
        __syncthreads();
        if (itx + F.G < 1024) P7_LOAD(itx + F.G);
        {
            const int chunk = slot - 2; const int c = lane & 15, g4 = lane >> 4;
            const int tl = 16 * w + c;
            const LAS unsigned char* kl = L + ((c & 3) >> 1) * 256 + (4 * g4 + (c >> 2)) * 16 + 8 * (c & 1);
            float Mt[2];
#pragma unroll
            for (int dir = 0; dir < 2; ++dir) { const int cd = dir * 16 + bh; Mt[dir] = fmaxf(msh[dir], ((const float*)(F.ws + WS_PM))[((size_t)cd * NSLOT + slot) * 128 + tl]); }
#pragma unroll 2
            for (int nt = 0; nt < 8; ++nt) {
                f32x4 acc = {0.f, 0.f, 0.f, 0.f};
                const LAS unsigned char* kn = kl + (nt >> 1) * 1024 + (nt & 1) * 512;
#pragma unroll
                for (int ks = 0; ks < 8; ++ks) {
                    const s16x4 t0 = __builtin_amdgcn_ds_read_tr16_b64_v4i16((LAS s16x4*)(kn + ks * 8192)), t1 = __builtin_amdgcn_ds_read_tr16_b64_v4i16((LAS s16x4*)(kn + ks * 8192 + 4096));
                    const bf16x8 kf = __builtin_shufflevector(t0, t1, 0, 1, 2, 3, 4, 5, 6, 7);
                    acc = __builtin_amdgcn_mfma_f32_16x16x32_bf16(kf, __builtin_bit_cast(bf16x8, qf[ks]), acc, 0, 0, 0); }
                const int s0 = 16 * nt + 4 * g4;
#pragma unroll
                for (int dir = 0; dir < 2; ++dir) { const int cd = dir * 16 + bh;
                    if (dir == 0 ? ((nt >> 1) > (w >> 1)) : ((nt >> 1) < (w >> 1))) continue;
                    const f32x4 a4 = *(const LAS f32x4*)(msh + 512 + dir * 128 + s0);
                    float v[4];
#pragma unroll
                    for (int r = 0; r < 4; ++r) { const int s2 = s0 + r; const bool on = dir ? (s2 >= tl) : (s2 <= tl); v[r] = on ? acc[r] * __expf(a4[r] - Mt[dir]) : 0.f; }
                    unsigned long long pk8 = (unsigned long long)pk2(v[0], v[1]) | ((unsigned long long)pk2(v[2], v[3]) << 32);
                    unsigned long long* so = (unsigned long long*)((bf16*)(F.ws + WS_S) + ((size_t)(dir * 16 + bh) * 64 + chunk) * 16384);
                    so[(((w * 4 + (nt >> 1)) * 64 + (2 * (nt & 1) + (g4 >> 1)) * 16 + c) * 2) + (g4 & 1)] = pk8; }
            }
        }
    }
#undef P7_LOAD
}

__device__ __forceinline__ void p8_mlstm_scan(Frame& F) {
    LAS unsigned char* CB0 = F.lds + RING_OFF;
    LAS unsigned char* OST = F.lds + RING_OFF + 49152;
    LAS unsigned char* VL = F.lds + RING_OFF + 61440;
    LAS float* msh = (LAS float*)(F.lds + RING_BYTES + 1024);
    int lane = F.lane, w = F.wave; asm volatile("" : "+v"(lane), "+s"(w));
    const int c = lane & 15, g4 = lane >> 4, tid = w * 64 + lane;
    const float* TOT = (const float*)(F.ws + WS_TOT); const float* AMAX = (const float*)(F.ws + WS_AMAX);
    for (int v = F.vcu; v < 256; v += F.G) {
        const int sl = v & 7, cd = v >> 3, dir = cd >> 4, bh = cd & 15, b = bh >> 2, h = bh & 3;
        __syncthreads();
        if (tid < NSLOT) { msh[256 + tid] = TOT[cd * NSLOT + tid]; msh[384 + tid] = AMAX[cd * NSLOT + tid]; }
        __syncthreads();
        if (tid == 0) { float m = 0.f; for (int st = 0; st < NSLOT; ++st) { const int s = chain_slot(dir, st); msh[s] = m; const float M = fmaxf(m, msh[384 + s]); msh[128 + s] = M; m = msh[256 + s] + M; } }
        __syncthreads();
        f32x4 C[2][3];
#pragma unroll
        for (int mt = 0; mt < 2; ++mt)
#pragma unroll
            for (int nt = 0; nt < 3; ++nt) C[mt][nt] = (f32x4){0.f, 0.f, 0.f, 0.f};
        bf16* Hout = (bf16*)(F.ws + (dir ? WS_HB : WS_HF));
        const int pnt = tid >> 8, pks = (tid >> 6) & 3, pc = tid & 15, pkg = (tid >> 4) & 3;
        v4u stg_v; f32x4 stg_a0, stg_a1;
#define P8_STAGE_LOAD(ST) do { const int slot_ = chain_slot(dir, (ST)); const size_t it_ = (size_t)bh * NSLOT + slot_; \
            stg_v = *(const GAS v4u*)((const bf16*)(F.ws + WS_VB) + it_ * 32768 + (size_t)sl * 4096 + tid * 8); \
            const float* aa_ = (const float*)(F.ws + WS_AA) + ((size_t)cd * NSLOT + slot_) * 128 + 32 * pks + 8 * pkg; stg_a0 = *(const f32x4*)aa_; stg_a1 = *(const f32x4*)(aa_ + 4); } while (0)
#define P8_STAGE_WRITE(ST) do { const int slot_ = chain_slot(dir, (ST)); const float M_ = msh[128 + slot_]; \
            LAS unsigned char* vb_ = VL + ((ST) & 1) * 20480; float wv_[8]; \
            _Pragma("unroll") for (int j = 0; j < 4; ++j) { wv_[j] = __expf(stg_a0[j] - M_); wv_[4 + j] = __expf(stg_a1[j] - M_); } \
            v4u sc_; _Pragma("unroll") for (int e = 0; e < 4; ++e) { const float lo_ = __builtin_bit_cast(float, stg_v[e] << 16) * wv_[2 * e], hi_ = __builtin_bit_cast(float, stg_v[e] & 0xffff0000u) * wv_[2 * e + 1]; sc_[e] = pk2(lo_, hi_); } \
            *(LAS v4u*)(vb_ + tid * 16) = stg_v; *(LAS v4u*)(vb_ + 8192 + tid * 16) = sc_; \
            if (pnt == 0) { v4u wf_; wf_.x = (pc == 0) ? pk2(wv_[0], wv_[1]) : 0u; wf_.y = (pc == 0) ? pk2(wv_[2], wv_[3]) : 0u; wf_.z = (pc == 0) ? pk2(wv_[4], wv_[5]) : 0u; wf_.w = (pc == 0) ? pk2(wv_[6], wv_[7]) : 0u; \
                *(LAS v4u*)(vb_ + 16384 + (tid & 255) * 16) = wf_; } } while (0)
        v4u qf[8]; bf16x8 sf[4];
        const int kslo = dir ? (w >> 1) : 0, kshi = dir ? 3 : (w >> 1);
#define P8_Q_LOAD(ST) do { const int slot_ = chain_slot(dir, (ST)); const size_t it_ = (size_t)bh * NSLOT + slot_; \
            const bf16* qfr_ = (const bf16*)(F.ws + WS_QB) + it_ * 32768 + (size_t)w * 4096 + lane * 8; \
            _Pragma("unroll") for (int ks = 0; ks < 8; ++ks) qf[ks] = *(const GAS v4u*)(qfr_ + ks * 512); } while (0)
#define P8_S_LOAD(ST) do { const int slot_ = chain_slot(dir, (ST)); \
            const bf16* Sfr_ = (const bf16*)(F.ws + WS_S) + ((size_t)(dir * 16 + bh) * 64 + (slot_ - 2)) * 16384 + (size_t)w * 2048 + lane * 8; \
            _Pragma("unroll") for (int ks = 0; ks < 4; ++ks) if (ks >= kslo && ks <= kshi) sf[ks] = *(const bf16x8*)(Sfr_ + ks * 512); } while (0)
        P8_STAGE_LOAD(0); P8_STAGE_WRITE(0);
        __syncthreads();
        for (int st = 0; st < NSLOT; ++st) {
            const int slot = chain_slot(dir, st); const size_t it = (size_t)bh * NSLOT + slot;
            const bf16* kT = (const bf16*)(F.ws + WS_KB) + it * 32768;
            const float* cumv = (const float*)(F.ws + WS_CUM) + ((size_t)cd * NSLOT + slot) * 128; const float* pmv = (const float*)(F.ws + WS_PM) + ((size_t)cd * NSLOT + slot) * 128;
            const float m_in = msh[slot]; const float M = msh[128 + slot]; const float decay = __expf(m_in - M);
            LAS unsigned char* vb = VL + (st & 1) * 20480; LAS unsigned char* CB = CB0 + (st & 1) * 24576;
            f32x4 p4 = {0.f, 0.f, 0.f, 0.f}, c4 = {0.f, 0.f, 0.f, 0.f};
            if (st >= 2) { p4 = *(const f32x4*)(pmv + 16 * w + 4 * g4); c4 = *(const f32x4*)(cumv + 16 * w + 4 * g4); }
            bf16x8 kf[2][4];
#pragma unroll
            for (int mt = 0; mt < 2; ++mt)
#pragma unroll
                for (int ks = 0; ks < 4; ++ks) kf[mt][ks] = *(const bf16x8*)(kT + (size_t)((w * 2 + mt) * 4 + ks) * 512 + lane * 8);
            if (st + 1 < NSLOT) P8_STAGE_LOAD(st + 1);
            if (st >= 2) {
                const int chunk = slot - 2;
#pragma unroll
                for (int nt = 0; nt < 3; ++nt) { v4u f; f.x = pk2m(C[0][nt][0], C[0][nt][1]); f.y = pk2m(C[0][nt][2], C[0][nt][3]); f.z = pk2m(C[1][nt][0], C[1][nt][1]); f.w = pk2m(C[1][nt][2], C[1][nt][3]);
                    *(LAS v4u*)(CB + ((w * 3 + nt) * 64 + lane) * 16) = f; }
                __syncthreads();
                f32x4 acc[3] = {{0.f, 0.f, 0.f, 0.f}, {0.f, 0.f, 0.f, 0.f}, {0.f, 0.f, 0.f, 0.f}};
                {
                    bf16x8 cbf[3][3];
#pragma unroll
                    for (int pk = 0; pk < 2; ++pk)
#pragma unroll
                        for (int nt = 0; nt < 3; ++nt) cbf[pk][nt] = *(const LAS bf16x8*)(CB + ((pk * 3 + nt) * 64 + lane) * 16);
#pragma unroll
                    for (int ks = 0; ks < 8; ++ks) { const bf16x8 qa = __builtin_bit_cast(bf16x8, qf[ks]);
                        if (ks + 2 < 8) {
#pragma unroll
                            for (int nt = 0; nt < 3; ++nt) cbf[(ks + 2) % 3][nt] = *(const LAS bf16x8*)(CB + (((ks + 2) * 3 + nt) * 64 + lane) * 16); }
#pragma unroll
                        for (int nt = 0; nt < 3; ++nt) acc[nt] = __builtin_amdgcn_mfma_f32_16x16x32_bf16(qa, cbf[ks % 3][nt], acc[nt], 0, 0, 0);
                        __builtin_amdgcn_sched_barrier(0);
                    }
                }
                if (st + 1 < NSLOT) P8_Q_LOAD(st + 1);
                float Mt[4], iw[4];
#pragma unroll
                for (int r = 0; r < 4; ++r) { Mt[r] = fmaxf(m_in, p4[r]); iw[r] = __expf(m_in - Mt[r]); }
#pragma unroll
                for (int nt = 0; nt < 3; ++nt)
#pragma unroll
                    for (int r = 0; r < 4; ++r) acc[nt][r] *= iw[r];
                const bf16x8 ones = (c == 0) ? (bf16x8){0x3F80, 0x3F80, 0x3F80, 0x3F80, 0x3F80, 0x3F80, 0x3F80, 0x3F80} : (bf16x8){0, 0, 0, 0, 0, 0, 0, 0};
#pragma unroll
                for (int ks = 0; ks < 4; ++ks) if (ks >= kslo && ks <= kshi) {
                    const bf16x8 v0 = *(const LAS bf16x8*)(vb + ((0 * 4 + ks) * 64 + lane) * 16), v1 = *(const LAS bf16x8*)(vb + ((1 * 4 + ks) * 64 + lane) * 16);
                    acc[0] = __builtin_amdgcn_mfma_f32_16x16x32_bf16(sf[ks], v0, acc[0], 0, 0, 0);
                    acc[1] = __builtin_amdgcn_mfma_f32_16x16x32_bf16(sf[ks], v1, acc[1], 0, 0, 0);
                    acc[2] = __builtin_amdgcn_mfma_f32_16x16x32_bf16(sf[ks], ones, acc[2], 0, 0, 0); }
                if (st + 1 < NSLOT) P8_S_LOAD(st + 1);
                {
                    LAS unsigned short* ost = (LAS unsigned short*)(OST + w * 1280);
#pragma unroll
                    for (int r = 0; r < 4; ++r) { const float den = __shfl(acc[2][r], g4 * 16); const float dn = fmaxf(fabsf(den), __expf(-c4[r] - Mt[r])); const float inv = __builtin_amdgcn_rcpf(dn);
                        const unsigned pr = pk2(acc[0][r] * inv, acc[1][r] * inv);
                        ost[(4 * g4 + r) * 40 + c] = (unsigned short)(pr & 0xffffu); ost[(4 * g4 + r) * 40 + 16 + c] = (unsigned short)(pr >> 16); }
                    asm volatile("s_waitcnt lgkmcnt(0)" ::: "memory");
                    const int orow = lane >> 2, och = lane & 3;
                    const v4u ov = *(const LAS v4u*)(OST + w * 1280 + orow * 80 + och * 16);
                    *(GAS v4u*)(Hout + ((size_t)b * SEQ + (size_t)chunk * 128 + 16 * w + orow) * 1024 + h * 256 + 32 * sl + 8 * och) = ov;
                }
            }
            if (st == 1) { P8_Q_LOAD(2); P8_S_LOAD(2); }
#pragma unroll
            for (int mt = 0; mt < 2; ++mt)
#pragma unroll
                for (int nt = 0; nt < 3; ++nt) C[mt][nt] = C[mt][nt] * decay;
#pragma unroll
            for (int ks = 0; ks < 4; ++ks) {
                const bf16x8 b0 = *(const LAS bf16x8*)(vb + 8192 + ((0 * 4 + ks) * 64 + lane) * 16), b1 = *(const LAS bf16x8*)(vb + 8192 + ((1 * 4 + ks) * 64 + lane) * 16), b2 = *(const LAS bf16x8*)(vb + 16384 + (ks * 64 + lane) * 16);
#pragma unroll
                for (int mt = 0; mt < 2; ++mt) { C[mt][0] = __builtin_amdgcn_mfma_f32_16x16x32_bf16(kf[mt][ks], b0, C[mt][0], 0, 0, 0); C[mt][1] = __builtin_amdgcn_mfma_f32_16x16x32_bf16(kf[mt][ks], b1, C[mt][1], 0, 0, 0);
                    C[mt][2] = __builtin_amdgcn_mfma_f32_16x16x32_bf16(kf[mt][ks], b2, C[mt][2], 0, 0, 0); }
            }
            if (st + 1 < NSLOT) P8_STAGE_WRITE(st + 1);
            if (st < 2) __syncthreads();
        }
#undef P8_STAGE_LOAD
#undef P8_STAGE_WRITE
#undef P8_Q_LOAD
#undef P8_S_LOAD
    }
}

__device__ __forceinline__ void p9_mlstm_merge(Frame& F) {
    const GAS v4u* og = (const GAS v4u*)(F.ws + WS_OG); const GAS v4u* hf = (const GAS v4u*)(F.ws + WS_HF); const GAS v4u* hb = (const GAS v4u*)(F.ws + WS_HB); GAS v4u* y = (GAS v4u*)(F.ws + WS_YMIX);
    const size_t n16 = (size_t)MLAT * 1024 * 2 / 16; const size_t g0 = (size_t)(F.vcu * NWAVES * 64 + F.tid), gs = (size_t)F.G * NWAVES * 64;
    for (size_t i = g0; i < n16; i += gs) { const v4u a = og[i], p = hf[i], q = hb[i]; v4u o;
#pragma unroll
        for (int e = 0; e < 4; ++e) { const float lo = __builtin_bit_cast(float, a[e] << 16) * (__builtin_bit_cast(float, p[e] << 16) + __builtin_bit_cast(float, q[e] << 16));
            const float hi2 = __builtin_bit_cast(float, a[e] & 0xffff0000u) * (__builtin_bit_cast(float, p[e] & 0xffff0000u) + __builtin_bit_cast(float, q[e] & 0xffff0000u)); o[e] = pk2(lo, hi2); }
        y[i] = o; }
}

constexpr int N_PHASES = 12;
#ifndef MK_N_LAUNCHES
#define MK_N_LAUNCHES 1
#endif
struct Args { const float* in[17]; float* out; unsigned char* ws; int ph_lo, ph_hi, li, pad; };
__global__ void __launch_bounds__(NWAVES * 64, 2) hyb_fwd(Args args) {
    extern __shared__ __attribute__((aligned(16))) unsigned char lds[];
    Frame F;
    F.lds = (LAS unsigned char*)lds;
    F.MISC = (volatile LAS unsigned*)(F.lds + MISC_OFF);
    F.tid = threadIdx.x; F.lane = F.tid & 63; F.wave = __builtin_amdgcn_readfirstlane(F.tid >> 6);
    F.G = gridDim.x; { const int bx = blockIdx.x; F.vcu = (F.G % 8 == 0) ? (bx % 8) * (F.G / 8) + bx / 8 : bx; }
    F.ws = args.ws; F.ctl = (gu32*)(args.ws + WS_CTL);
    F.x = args.in[0]; F.c = args.in[1]; F.ctx = args.in[2]; F.c_ctx = args.in[3]; F.ada_w = args.in[4]; F.ada_b = args.in[5]; F.pgain = args.in[6]; F.pbias = args.in[7];
    F.w0 = args.in[8]; F.qgain = args.in[9]; F.kgain = args.in[10]; F.fgain = args.in[11]; F.wfmix = args.in[12]; F.wo0 = args.in[13]; F.w1 = args.in[14]; F.gbias = args.in[15]; F.wo1 = args.in[16];
    F.out = args.out;
    for (int u = F.tid; u < (LDS_BYTES - LDSCTL_OFF) / 4; u += NWAVES * 64) ((LAS unsigned*)(F.lds + LDSCTL_OFF))[u] = 0u;
    __syncthreads();
    XcdBarrier bar = xcd_barrier_post((unsigned*)(F.ctl + CW_BAR) + args.li * XCD_BAR_WORDS, F.MISC + 8);
    const int lo = args.ph_lo, hi = args.ph_hi;
#define IN(k) (lo <= (k) && (k) < hi)
#define SEAM(k) do { if (IN(k) && IN((k) + 1)) xcd_barrier(bar); } while (0)
    unsigned char* ws = args.ws;
    const float* mod = (const float*)(ws + WS_MOD);

    if (IN(0)) { p0_tables(F); } SEAM(0);
    if (IN(1)) { p1_h0_rows(F); } SEAM(1);
    if (IN(2)) {
        pg8::Gemm g{(const pg8::bf16_t*)(ws + WS_H), (const pg8::bf16_t*)(ws + WS_W0T), MTOT, EVEN_N, 1024}; pg8::StaticOrder S; S.init(MTOT, EVEN_N, F.G, (int)blockIdx.x);
        epi::EpiEven E{(pg8::bf16_t*)(ws + WS_Q0),
                       F.qgain, F.kgain, F.fgain, (const float*)(ws + WS_ROPE)};
        pg8::gemm_phase<epi::EpiEven, pg8::StaticOrder, true, true>(F.lds + RING_OFF, g, S, E);
    } SEAM(2);
    if (IN(3)) { p3a_fourier_s1(F); xcd_barrier(bar);
        p3_even_mixers(F);
    } SEAM(3);
    if (IN(4)) {
        pg8::Gemm g{(const pg8::bf16_t*)(ws + WS_Y), (const pg8::bf16_t*)(ws + WS_WO0T), MTOT, 1024, 1024}; pg8::StaticOrder S; S.init(MTOT, 1024, F.G, (int)blockIdx.x);
        epi::EpiGate E{(pg8::bf16_t*)(ws + WS_GY), mod};
        pg8::gemm_phase<epi::EpiGate, pg8::StaticOrder, true, true>(F.lds + RING_OFF, g, S, E);
    } SEAM(4);
    if (IN(5)) { p5_rowpass(F); } SEAM(5);
    if (IN(6)) {
        gate_scans(F);
        pg8::Gemm g{(const pg8::bf16_t*)(ws + WS_H), (const pg8::bf16_t*)(ws + WS_W1T), MTOT, ODD_N, 1024}; pg8::StaticOrder S; S.init(MTOT, ODD_N, F.G, (int)blockIdx.x); S.revn = true;
        epi::EpiOdd E{(pg8::bf16_t*)(ws + WS_QB), (pg8::bf16_t*)(ws + WS_OG)};
        pg8::gemm_phase<epi::EpiOdd, pg8::StaticOrder, true, true>(F.lds + RING_OFF, g, S, E);
    } SEAM(6);
    if (IN(7)) { p7_mlstm_prep(F); } SEAM(7);
    if (IN(8)) { p8_mlstm_scan(F);
    } SEAM(8);
    if (IN(9)) { p9_mlstm_merge(F); } SEAM(9);
    if (IN(10)) {
        pg8::Gemm g{(const pg8::bf16_t*)(ws + WS_YMIX), (const pg8::bf16_t*)(ws + WS_WO1T), MLAT, 1024, 1024}; pg8::StaticOrder S; S.init(MLAT, 1024, F.G, (int)blockIdx.x);
        epi::EpiGate E{(pg8::bf16_t*)(ws + WS_GY), mod + 5 * 3072};
        pg8::gemm_phase<epi::EpiGate, pg8::StaticOrder, true, true>(F.lds + RING_OFF, g, S, E);
    } SEAM(10);
    if (IN(11)) { p11_final_ln(F); }
#undef IN
#undef SEAM
}

extern "C" void kernel_launch(void* const* d_in, const int* in_sizes, int n_in, void* d_out, int out_size, void* d_ws, size_t ws_size, hipStream_t stream) {
    static int grid = 0;
    if (grid == 0) {
        if (n_in != 17 || in_sizes[0] != MLAT * 1024 || out_size != MLAT * 1024 || ws_size < WS_END) {
            fprintf(stderr, "kernel_launch: unexpected problem (n_in %d, in0 %d, out %d, ws %zu; need ws >= %zu); nothing launched\n", n_in, n_in > 0 ? in_sizes[0] : -1, out_size, ws_size, (size_t)WS_END); grid = -1; return; }
        int dev = 0, cus = 0, per_cu = 0;
        if (hipGetDevice(&dev) != hipSuccess || hipDeviceGetAttribute(&cus, hipDeviceAttributeMultiprocessorCount, dev) != hipSuccess) { fprintf(stderr, "kernel_launch: device query failed\n"); grid = -1; return; }
        if (hipFuncSetAttribute((const void*)hyb_fwd, hipFuncAttributeMaxDynamicSharedMemorySize, LDS_BYTES) != hipSuccess) { fprintf(stderr, "kernel_launch: hipFuncSetAttribute failed\n"); grid = -1; return; }
        if (hipOccupancyMaxActiveBlocksPerMultiprocessor(&per_cu, (const void*)hyb_fwd, NWAVES * 64, LDS_BYTES) != hipSuccess || per_cu < 1)
            fprintf(stderr, "kernel_launch: note: occupancy query reports %d workgroups per CU\n", per_cu);
        (void)hipGetLastError();
        grid = cus;
    }
    if (grid < 0) return;
    if (hipMemsetAsync((char*)d_ws + WS_CTL, 0, CTL_ZERO_BYTES, stream) != hipSuccess) { fprintf(stderr, "kernel_launch: hipMemsetAsync failed\n"); return; }
    Args a{};
    for (int i = 0; i < 17; ++i) a.in[i] = (const float*)d_in[i];
    a.out = (float*)d_out; a.ws = (unsigned char*)d_ws;
    constexpr int NL = MK_N_LAUNCHES;
    static_assert(NL == 1 || NL == N_PHASES, "MK_N_LAUNCHES: 1 (one launch) or 12 (one launch per phase)");
    for (int li = 0; li < NL; ++li) {
        a.ph_lo = (NL == 1) ? 0 : li; a.ph_hi = (NL == 1) ? N_PHASES : li + 1; a.li = (NL == 1) ? 0 : 1 + li;
        hipLaunchKernelGGL(hyb_fwd, dim3(grid), dim3(NWAVES * 64), LDS_BYTES, stream, a);
        const hipError_t le = hipPeekAtLastError();
        if (le != hipSuccess) { fprintf(stderr, "kernel_launch: launch %d failed: %s\n", li, hipGetErrorName(le)); break; }
    }
}
```

```cpp
#include <hip/hip_runtime.h>
#include <hip/hip_bf16.h>
#include <cstdio>
#include <cstdint>
#include <cmath>
namespace pg8 {
#define PG8_LAS __attribute__((address_space(3)))
typedef unsigned short bf16_t;
typedef short bf16x8 __attribute__((ext_vector_type(8)));
typedef float f32x4 __attribute__((ext_vector_type(4)));
typedef unsigned u32x4 __attribute__((ext_vector_type(4)));
constexpr int BM = 256, BK = 64, HALF = 128, HTB = HALF * BK * 2  , STAGE_BYTES = 8 * HTB, NXCD = 8, WGM = 8;

__host__ __device__ __forceinline__ int lds_byte(int r, int c) { const int st = (r >> 4) * 2 + (c >> 5), rr = r & 15, cc = c & 31, ob = rr * 64 + cc * 2; return st * 1024 + (ob ^ (((ob >> 9) & 1) << 5)); }
__host__ __device__ __forceinline__ void stage_rc(int b, int& R, int& C) { const int st = b / 1024, sb = b % 1024, swz = sb ^ (((sb >> 9) & 1) << 5); R = (st >> 1) * 16 + swz / 64; C = (st & 1) * 32 + (swz % 64) / 2; }
__host__ __device__ __forceinline__ int perm32(int rho) { const int n = rho >> 4, i = rho & 15; return 8 * (i >> 2) + 4 * n + (i & 3); }

struct Unit { int pm, pn; };
struct Gemm { const bf16_t* A; const bf16_t* Bt; int M, N, K; };

struct StaticOrder {
    int nM, nN, nwg, G, c;
    __host__ __device__ void init(int M, int N, int G_, int c_) { nM = M / BM; nN = N / BM; nwg = nM * nN; G = G_; c = c_; }
    __host__ __device__ bool next(int i, Unit& u) const {
        const long L = (long)i * G + c; if (L >= nwg) return false;
        int wgid = (int)L; { const int q = nwg / NXCD, r = nwg % NXCD, xcd = wgid % NXCD, off = wgid / NXCD; wgid = (xcd < r ? xcd * (q + 1) : r * (q + 1) + (xcd - r) * q) + off; }
        const int nig = WGM * nN, gid = wgid / nig, fm = gid * WGM, gsz = (nM - fm) < WGM ? (nM - fm) : WGM;
        u.pm = fm + ((wgid % nig) % gsz); u.pn = (wgid % nig) / gsz; return true;
    }
    __device__ __forceinline__ void a_ready(const Unit&) const {}
    __device__ __forceinline__ void done(const Unit&) const {}
};


typedef float cvf2_t __attribute__((ext_vector_type(2))); typedef __bf16 cvb2_t __attribute__((ext_vector_type(2)));
__device__ __forceinline__ unsigned cvt_pk_bf16(float lo, float hi) { const cvf2_t v = {lo, hi}; return __builtin_bit_cast(unsigned, __builtin_convertvector(v, cvb2_t)); }
template <class Epi> __device__ __forceinline__ const char* unit_a(const Gemm& g, const Epi& E, const Unit& u, size_t tstep) {
    if constexpr (Epi::SWAP_AB) { if (E.swap_ab(u)) return (const char*)g.Bt + (size_t)u.pn * tstep; }
    return (const char*)g.A + (size_t)u.pm * tstep; }
template <class Epi> __device__ __forceinline__ const char* unit_b(const Gemm& g, const Epi& E, const Unit& u, size_t tstep) {
    if constexpr (Epi::SWAP_AB) { if (E.swap_ab(u)) return (const char*)g.A + (size_t)u.pm * tstep; }
    return (const char*)g.Bt + (size_t)u.pn * tstep; }
template <class Epi, class Sched, bool ALIGN_EPI = false, bool SP2 = false>
__device__ __forceinline__ void gemm_phase(PG8_LAS unsigned char* lds, const Gemm g, const Sched& S, const Epi& E) {
    const int tid = threadIdx.x, wid = __builtin_amdgcn_readfirstlane(tid >> 6), lane = tid & 63, wr = wid >> 2, wc = wid & 3, fr = lane & 15, fq = lane >> 4;
    const int K = g.K, nt = K / BK;
    unsigned voffA[2], voffB[2];
#pragma unroll
    for (int i = 0; i < 2; ++i) { int R, C; stage_rc(tid * 16 + i * 8192, R, C); const int Rb = Epi::PERM ? ((R & ~31) + perm32(R & 31)) : R;
        voffA[i] = (unsigned)(R * K + C) * 2u; voffB[i] = (unsigned)(Rb * K + C) * 2u; }
    const size_t kstep = (size_t)(BK * 2);
    const size_t hstep = (size_t)HALF * K * 2;
    const size_t tstep = 2 * hstep;
    const unsigned ldsw = (unsigned)wid * 1024u;
    const int aoff = lds_byte(wr * 64 + fr, fq * 8), boff = lds_byte(wc * 32 + fr, fq * 8);
#define PG8_SA(b, h) (((b) * 2 + (h)) * HTB)
#define PG8_SB(b, h) ((4 + (b) * 2 + (h)) * HTB)
#define PG8_STAGE(bufoff, gbase, voff) do { _Pragma("unroll") for (int _i = 0; _i < 2; ++_i) \
        __builtin_amdgcn_global_load_lds((const unsigned*)((const char*)(gbase) + (voff)[_i]), (PG8_LAS unsigned*)(lds + (bufoff) + ldsw + _i * 8192), 16, 0, 0); } while (0)
#define PG8_LDA(dst, b, h) do { _Pragma("unroll") for (int m = 0; m < 4; ++m) _Pragma("unroll") for (int k = 0; k < 2; ++k) dst[m][k] = *(const PG8_LAS bf16x8*)(lds + PG8_SA(b, h) + aoff + m * 2048 + k * 1024); } while (0)
#define PG8_LDB(dst, b, h) do { _Pragma("unroll") for (int n = 0; n < 2; ++n) _Pragma("unroll") for (int k = 0; k < 2; ++k) dst[n][k] = *(const PG8_LAS bf16x8*)(lds + PG8_SB(b, h) + boff + n * 2048 + k * 1024); } while (0)
#define PG8_MMA(ai, bj, At, Bt) do { __builtin_amdgcn_s_setprio(1); _Pragma("unroll") for (int m = 0; m < 4; ++m) _Pragma("unroll") for (int n = 0; n < 2; ++n) _Pragma("unroll") for (int k = 0; k < 2; ++k) \
        acc[ai][bj][m][n] = __builtin_amdgcn_mfma_f32_16x16x32_bf16(Bt[n][k], At[m][k], acc[ai][bj][m][n], 0, 0, 0); __builtin_amdgcn_s_setprio(0); } while (0)
#define PG8_WAIT_V(n) asm volatile("s_waitcnt vmcnt(" #n ")" ::: "memory")
#define PG8_WAIT_L(n) asm volatile("s_waitcnt lgkmcnt(" #n ")" ::: "memory")
#define PG8_BAR __builtin_amdgcn_s_barrier()
#define PG8_SCHED __builtin_amdgcn_sched_barrier(0)
    Unit cur, nxt; int ui = 0;
    if (!S.next(0, cur)) return;
    f32x4 acc[2][2][4][2];
#pragma unroll
    for (int a = 0; a < 2; ++a)
#pragma unroll
        for (int b = 0; b < 2; ++b)
#pragma unroll
            for (int m = 0; m < 4; ++m)
#pragma unroll
                for (int n = 0; n < 2; ++n) acc[a][b][m][n] = (f32x4){0.f, 0.f, 0.f, 0.f};
    bf16x8 At[4][2], B0[2][2], B1[2][2];
    const char* cA = unit_a(g, E, cur, tstep); const char* cB = unit_b(g, E, cur, tstep);
    S.a_ready(cur);
    if constexpr (SP2) {
        PG8_STAGE(PG8_SB(0, 0), cB, voffB); PG8_STAGE(PG8_SB(0, 1), cB + hstep, voffB); PG8_STAGE(PG8_SA(0, 0), cA, voffA); PG8_STAGE(PG8_SA(0, 1), cA + hstep, voffA);
        if (wr == 1) PG8_BAR;
        PG8_WAIT_V(2); PG8_BAR;
        PG8_STAGE(PG8_SB(1, 0), cB + kstep, voffB); PG8_STAGE(PG8_SA(1, 0), cA + kstep, voffA); PG8_STAGE(PG8_SB(1, 1), cB + hstep + kstep, voffB);
        PG8_WAIT_V(6); PG8_BAR;
    } else {
        PG8_STAGE(PG8_SB(0, 0), cB, voffB); PG8_STAGE(PG8_SA(0, 0), cA, voffA); PG8_STAGE(PG8_SB(0, 1), cB + hstep, voffB); PG8_STAGE(PG8_SA(0, 1), cA + hstep, voffA);
        if (wr == 1) PG8_BAR;
        PG8_WAIT_V(4); PG8_BAR;
        PG8_STAGE(PG8_SB(1, 0), cB + kstep, voffB); PG8_STAGE(PG8_SA(1, 0), cA + kstep, voffA); PG8_STAGE(PG8_SB(1, 1), cB + hstep + kstep, voffB);
        PG8_WAIT_V(6); PG8_BAR;
    }
    for (;;) {
        const bool has_next = S.next(ui + 1, nxt);
        const char* nA = has_next ? unit_a(g, E, nxt, tstep) : cA; const char* nB = has_next ? unit_b(g, E, nxt, tstep) : cB;
        for (int t = 0; t < nt; t += 2) {
            const bool last = (t == nt - 2);
            const char* a1 = cA + (size_t)(t + 1) * kstep;
            const char* a2 = last ? nA : cA + (size_t)(t + 2) * kstep; const char* b2 = last ? nB : cB + (size_t)(t + 2) * kstep;
            const char* a3 = a2 + kstep; const char* b3 = b2 + kstep;
            if (last && has_next) S.a_ready(nxt);
            if constexpr (SP2) {
            PG8_LDB(B0, 0, 0); PG8_LDB(B1, 0, 1); PG8_SCHED; PG8_LDA(At, 0, 0); PG8_STAGE(PG8_SA(1, 1), a1 + hstep, voffA);
            PG8_WAIT_V(8); PG8_WAIT_L(0); PG8_BAR; PG8_MMA(0, 0, At, B0); PG8_MMA(0, 1, At, B1); PG8_BAR; PG8_SCHED;
            PG8_LDA(At, 0, 1); PG8_STAGE(PG8_SB(0, 0), b2, voffB); PG8_STAGE(PG8_SB(0, 1), b2 + hstep, voffB); PG8_STAGE(PG8_SA(0, 0), a2, voffA);
            PG8_WAIT_V(8); PG8_WAIT_L(0); PG8_BAR; PG8_MMA(1, 0, At, B0); PG8_MMA(1, 1, At, B1); PG8_BAR; PG8_SCHED;
            PG8_LDB(B0, 1, 0); PG8_LDB(B1, 1, 1); PG8_SCHED; PG8_LDA(At, 1, 0); PG8_STAGE(PG8_SA(0, 1), a2 + hstep, voffA);
            PG8_WAIT_V(8); PG8_WAIT_L(0); PG8_BAR; PG8_MMA(0, 0, At, B0); PG8_MMA(0, 1, At, B1); PG8_BAR; PG8_SCHED;
            PG8_LDA(At, 1, 1); PG8_STAGE(PG8_SB(1, 0), b3, voffB); PG8_STAGE(PG8_SB(1, 1), b3 + hstep, voffB); PG8_STAGE(PG8_SA(1, 0), a3, voffA);
            PG8_WAIT_V(8); PG8_WAIT_L(0); PG8_BAR; PG8_MMA(1, 0, At, B0); PG8_MMA(1, 1, At, B1); PG8_BAR; PG8_SCHED;
            } else {
            PG8_LDB(B0, 0, 0); PG8_SCHED; PG8_LDA(At, 0, 0); PG8_STAGE(PG8_SA(1, 1), a1 + hstep, voffA);
            PG8_WAIT_L(8); PG8_BAR; PG8_WAIT_L(0); PG8_MMA(0, 0, At, B0); PG8_BAR; PG8_SCHED;
            PG8_LDB(B1, 0, 1); PG8_STAGE(PG8_SB(0, 0), b2, voffB);
            PG8_BAR; PG8_WAIT_L(0); PG8_MMA(0, 1, At, B1); PG8_BAR;
            PG8_LDA(At, 0, 1); PG8_STAGE(PG8_SA(0, 0), a2, voffA);
            PG8_BAR; PG8_WAIT_L(0); PG8_MMA(1, 0, At, B0); PG8_BAR; PG8_SCHED;
            PG8_STAGE(PG8_SB(0, 1), b2 + hstep, voffB);
            PG8_WAIT_V(6); PG8_BAR; PG8_MMA(1, 1, At, B1); PG8_BAR;
            PG8_LDB(B0, 1, 0); PG8_SCHED; PG8_LDA(At, 1, 0); PG8_STAGE(PG8_SA(0, 1), a2 + hstep, voffA);
            PG8_WAIT_L(8); PG8_BAR; PG8_WAIT_L(0); PG8_MMA(0, 0, At, B0); PG8_BAR; PG8_SCHED;
            PG8_LDB(B1, 1, 1); PG8_STAGE(PG8_SB(1, 0), b3, voffB);
            PG8_BAR; PG8_WAIT_L(0); PG8_MMA(0, 1, At, B1); PG8_BAR;
            PG8_LDA(At, 1, 1); PG8_STAGE(PG8_SA(1, 0), a3, voffA);
            PG8_BAR; PG8_WAIT_L(0); PG8_MMA(1, 0, At, B0); PG8_BAR; PG8_SCHED;
            PG8_STAGE(PG8_SB(1, 1), b3 + hstep, voffB);
            PG8_WAIT_V(6); PG8_BAR; PG8_MMA(1, 1, At, B1); PG8_BAR;
            }
        }
        if constexpr (ALIGN_EPI) { if (wr == 0) PG8_BAR; }
        if constexpr (!Epi::AFTER_DRAIN) { E(acc, cur, wr, wc, fr, fq); S.done(cur); }
        if (!has_next) break;
#pragma unroll
        for (int a = 0; a < 2; ++a)
#pragma unroll
            for (int b = 0; b < 2; ++b)
#pragma unroll
                for (int m = 0; m < 4; ++m)
#pragma unroll
                    for (int n = 0; n < 2; ++n) acc[a][b][m][n] = (f32x4){0.f, 0.f, 0.f, 0.f};
        cur = nxt; cA = nA; cB = nB; ++ui;
        if constexpr (ALIGN_EPI) { if (wr == 1) PG8_BAR; }
    }
    PG8_WAIT_V(0);
    if constexpr (!ALIGN_EPI) { if (wr == 0) PG8_BAR; }
    PG8_BAR;
    if constexpr (Epi::AFTER_DRAIN) { E.fused(acc, cur, wr, wc, fr, fq, lds, wid, lane); S.done(cur); }
#undef PG8_SA
#undef PG8_SB
#undef PG8_STAGE
#undef PG8_LDA
#undef PG8_LDB
#undef PG8_MMA
#undef PG8_WAIT_V
#undef PG8_WAIT_L
#undef PG8_BAR
#undef PG8_SCHED
}
}


constexpr int BATCH = 4, SEQ = 8192, DM = 1024, CTXL = 256;
constexpr int MLAT = BATCH * SEQ, MCTX = BATCH * CTXL, MTOT = MLAT + MCTX;
constexpr int EVEN_N = 2560, ODD_N = 5120, ODD_IN_W = 5136;
constexpr int NKEYS = CTXL + SEQ;
constexpr int NSLOT = 66;
constexpr float LN_EPS = 1e-6f;
constexpr float ALPHA_RES = 1.4142135623730951f;
constexpr float QSCALE = 0.125f * 1.4426950408889634f;

namespace epi {
using pg8::f32x4; using pg8::u32x4; using pg8::bf16_t; using pg8::Unit;
__device__ __forceinline__ unsigned pk(float lo, float hi) { return pg8::cvt_pk_bf16(lo, hi); }
__device__ __forceinline__ float sigmoidf_(float v) { return __builtin_amdgcn_rcpf(1.0f + __expf(-v)); }
__device__ __forceinline__ float siluf_(float v) { return v * __builtin_amdgcn_rcpf(1.0f + __expf(-v)); }

struct EpiEven {
    static constexpr bool PERM = true, AFTER_DRAIN = false, SWAP_AB = false;
    bf16_t* Q0;
    static constexpr size_t oGA = (size_t)MTOT * 768, oKALL = oGA + (size_t)MTOT * 768, oVALL = oKALL + (size_t)BATCH * NKEYS * 256, oU = oVALL + (size_t)BATCH * NKEYS * 256, oGB = oU + (size_t)MTOT * 256;
    const float *qgain, *kgain, *fgain;
    const float* rope;
    __device__ __forceinline__ void operator()(const f32x4 (&acc)[2][2][4][2], const Unit& u, int wr, int wc, int fr, int fq) const {
        const int pm = u.pm, pn = u.pn;
        const bool lat = pm < 128;
        const int b = lat ? (pm >> 5) : (pm - 128);
        const int type = (pn < 3) ? 0 : (pn < 6) ? 1 : (pn - 4);
        const bool norm = (type == 0 || type == 2 || type == 4);
        const bool dorope = lat && (type == 0 || type == 2);
        f32x4 gn[2][2];
        if (norm) {
            const float* gp = (type == 0) ? qgain : (type == 2) ? kgain : (fgain + 64 * wc);
#pragma unroll
            for (int bj = 0; bj < 2; ++bj)
#pragma unroll
                for (int n = 0; n < 2; ++n) gn[bj][n] = *(const f32x4*)(gp + 32 * bj + 8 * fq + 4 * n);
        }
#pragma unroll
        for (int ai = 0; ai < 2; ++ai)
#pragma unroll
            for (int m = 0; m < 4; ++m) {
                const int rl = ai * 128 + wr * 64 + m * 16 + fr;
                const int mrow = pm * 256 + rl;
                const int t = lat ? ((pm & 31) * 256 + rl) : rl;
                f32x4 v[2][2];
#pragma unroll
                for (int bj = 0; bj < 2; ++bj)
#pragma unroll
                    for (int n = 0; n < 2; ++n) v[bj][n] = acc[ai][bj][m][n];
                if (norm) {
                    float ss = 0.f;
#pragma unroll
                    for (int bj = 0; bj < 2; ++bj)
#pragma unroll
                        for (int n = 0; n < 2; ++n) { const f32x4 x = v[bj][n]; ss += (x[0] * x[0] + x[1] * x[1]) + (x[2] * x[2] + x[3] * x[3]); }
                    ss += __shfl_xor(ss, 16); ss += __shfl_xor(ss, 32);
                    const float r = rsqrtf(ss * (1.0f / 64.0f) + LN_EPS);
#pragma unroll
                    for (int bj = 0; bj < 2; ++bj)
#pragma unroll
                        for (int n = 0; n < 2; ++n) v[bj][n] = v[bj][n] * r * gn[bj][n];
                }
                if (dorope) {
                    const float* cb = (fq < 2) ? (rope + (t >> 6) * 16) : (rope + 4096 + (t & 63) * 16);
                    const int so = (fq < 2) ? 2048 : 1024;
#pragma unroll
                    for (int n = 0; n < 2; ++n) {
                        const f32x4 c4 = *(const f32x4*)(cb + 8 * (fq & 1) + 4 * n), s4 = *(const f32x4*)(cb + so + 8 * (fq & 1) + 4 * n);
                        const f32x4 x1 = v[0][n], x2 = v[1][n];
                        v[0][n] = x1 * c4 - x2 * s4; v[1][n] = x1 * s4 + x2 * c4;
                    }
                }
                if (type == 0) {
#pragma unroll
                    for (int bj = 0; bj < 2; ++bj)
#pragma unroll
                        for (int n = 0; n < 2; ++n) v[bj][n] = v[bj][n] * QSCALE;
                } else if (type == 1 || type == 5) {
#pragma unroll
                    for (int bj = 0; bj < 2; ++bj)
#pragma unroll
                        for (int n = 0; n < 2; ++n) { f32x4 x = v[bj][n]; x[0] = siluf_(x[0]); x[1] = siluf_(x[1]); x[2] = siluf_(x[2]); x[3] = siluf_(x[3]); v[bj][n] = x; }
                }
                size_t doff;
                if (type == 0)      doff = (size_t)mrow * 768 + (4 * pn + wc) * 64;
                else if (type == 1) doff = oGA + (size_t)mrow * 768 + (pn - 3) * 256 + wc * 64;
                else if (type == 2) doff = oKALL + ((size_t)b * NKEYS + (lat ? 256 + t : t)) * 256 + wc * 64;
                else if (type == 3) doff = oVALL + ((size_t)b * NKEYS + (lat ? 256 + t : t)) * 256 + wc * 64;
                else if (type == 4) doff = oU + (size_t)mrow * 256 + wc * 64;
                else                doff = oGB + (size_t)mrow * 256 + wc * 64;
                bf16_t* dst = Q0 + doff;
#pragma unroll
                for (int bj = 0; bj < 2; ++bj) {
                    u32x4 w; w.x = pk(v[bj][0][0], v[bj][0][1]); w.y = pk(v[bj][0][2], v[bj][0][3]); w.z = pk(v[bj][1][0], v[bj][1][1]); w.w = pk(v[bj][1][2], v[bj][1][3]);
                    *(u32x4*)(dst + 32 * bj + 8 * fq) = w;
                }
            }
    }
};

struct EpiOdd {
    static constexpr bool PERM = true, AFTER_DRAIN = false, SWAP_AB = true;
    bf16_t *QB, *OG;
    __device__ __forceinline__ bool swap_ab(const Unit& u) const { return u.pn >= 4 && u.pn < 12; }
    __device__ __forceinline__ void operator()(const f32x4 (&acc)[2][2][4][2], const Unit& u, int wr, int wc, int fr, int fq) const {
        asm volatile("" : "+v"(fr), "+v"(fq));
        const int pm = u.pm, pn = u.pn;
        const bool lat = pm < 128;
        const int b = lat ? (pm >> 5) : (pm - 128);
        if (pn < 4) {
            const int h = pn;
#pragma unroll
            for (int ai = 0; ai < 2; ++ai) {
                const int slot = lat ? (2 + 2 * (pm & 31) + ai) : ai;
                bf16_t* blk = QB + ((size_t)(b * 4 + h) * NSLOT + slot) * 32768;
#pragma unroll
                for (int m = 0; m < 4; ++m)
#pragma unroll
                    for (int bj = 0; bj < 2; ++bj)
#pragma unroll
                        for (int n = 0; n < 2; ++n) {
                            const f32x4 a = acc[ai][bj][m][n];
                            const unsigned long long w = (unsigned long long)pk(a[0], a[1]) | ((unsigned long long)pk(a[2], a[3]) << 32);
                            *(unsigned long long*)(blk + ((((4 * wr + m) * 8 + 4 * bj + wc) * 64 + ((2 * fq + n) & 3) * 16 + fr) * 8) + 4 * (fq >> 1)) = w;
                        }
            }
        } else if (pn < 12) {
            const int h = pn & 3;
            bf16_t* base = QB + (size_t)(pn >> 2) * (size_t)(33 * 1024 * 1024);
#pragma unroll
            for (int bj = 0; bj < 2; ++bj) {
                const int slot = lat ? (2 + 2 * (pm & 31) + bj) : bj;
                bf16_t* blk = base + ((size_t)(b * 4 + h) * NSLOT + slot) * 32768 + (size_t)(wc * 64 + fq * 16 + fr) * 8;
#pragma unroll
                for (int ai = 0; ai < 2; ++ai)
#pragma unroll
                    for (int m = 0; m < 4; ++m) {
                        const f32x4 a0 = acc[ai][bj][m][0], a1 = acc[ai][bj][m][1];
                        u32x4 w; w.x = pk(a0[0], a0[1]); w.y = pk(a0[2], a0[3]); w.z = pk(a1[0], a1[1]); w.w = pk(a1[2], a1[3]);
                        *(u32x4*)(blk + (((4 * ai + 2 * wr + (m >> 1)) * 2 + (m & 1)) * 4) * 512) = w;
                    }
            }
        } else {
#pragma unroll
            for (int ai = 0; ai < 2; ++ai)
#pragma unroll
                for (int m = 0; m < 4; ++m) {
                    const int mrow = pm * 256 + ai * 128 + wr * 64 + m * 16 + fr;
                    float r[8];
#pragma unroll
                    for (int n = 0; n < 2; ++n)
#pragma unroll
                        for (int j = 0; j < 4; ++j) { const float o = acc[ai][0][m][n][j], z = acc[ai][1][m][n][j]; r[4 * n + j] = z * __builtin_amdgcn_rcpf((1.0f + __expf(-o)) * (1.0f + __expf(-z))); }
                    u32x4 w; w.x = pk(r[0], r[1]); w.y = pk(r[2], r[3]); w.z = pk(r[4], r[5]); w.w = pk(r[6], r[7]);
                    *(u32x4*)(OG + (size_t)mrow * 1024 + (pn - 12) * 128 + wc * 32 + 8 * fq) = w;
                }
        }
    }
};

struct EpiGate {
    static constexpr bool PERM = true, AFTER_DRAIN = false, SWAP_AB = false;
    bf16_t* GY; const float* mod;
    __device__ __forceinline__ void operator()(const f32x4 (&acc)[2][2][4][2], const Unit& u, int wr, int wc, int fr, int fq) const {
        const int pm = u.pm, pn = u.pn;
        const bool lat = pm < 128;
        const int b = lat ? (pm >> 5) : (pm - 128);
        const float* gp = mod + (lat ? b : 4) * 3072 + 2048;
        const int col0 = pn * 256 + wc * 32 + 8 * fq;
        f32x4 gv[2][2];
#pragma unroll
        for (int bj = 0; bj < 2; ++bj)
#pragma unroll
            for (int n = 0; n < 2; ++n) gv[bj][n] = *(const f32x4*)(gp + col0 + bj * 128 + n * 4);
#pragma unroll
        for (int ai = 0; ai < 2; ++ai)
#pragma unroll
            for (int m = 0; m < 4; ++m) {
                const int rl = ai * 128 + wr * 64 + m * 16 + fr;
                bf16_t* dst = GY + (size_t)(pm * 256 + rl) * 1024 + col0;
#pragma unroll
                for (int bj = 0; bj < 2; ++bj) { const f32x4 a0 = acc[ai][bj][m][0] * gv[bj][0], a1 = acc[ai][bj][m][1] * gv[bj][1];
                    u32x4 w; w.x = pk(a0[0], a0[1]); w.y = pk(a0[2], a0[3]); w.z = pk(a1[0], a1[1]); w.w = pk(a1[2], a1[3]);
                    *(u32x4*)(dst + bj * 128) = w; }
            }
    }
};

}
#define GAS __attribute__((address_space(1)))
#define LAS __attribute__((address_space(3)))
typedef unsigned short bf16;
typedef unsigned v4u __attribute__((ext_vector_type(4)));
typedef float f32x4 __attribute__((ext_vector_type(4)));
typedef float f32x2v __attribute__((ext_vector_type(2)));
typedef short bf16x8 __attribute__((ext_vector_type(8)));
typedef GAS unsigned gu32;
typedef GAS unsigned long long gu64;
#define RLX_AGENT __ATOMIC_RELAXED, __HIP_MEMORY_SCOPE_AGENT
#define LDS_WAIT() asm volatile("s_waitcnt lgkmcnt(0)" ::: "memory")
#define VM_WAIT() asm volatile("s_waitcnt vmcnt(0)" ::: "memory")
__device__ __forceinline__ unsigned long long rt() { return __builtin_amdgcn_s_memrealtime(); }
__device__ __forceinline__ unsigned pk2(float lo, float hi) { unsigned r; asm("v_cvt_pk_bf16_f32 %0, %1, %2" : "=v"(r) : "v"(lo), "v"(hi)); return r; }
__device__ __forceinline__ unsigned pk2m(float lo, float hi) { return pg8::cvt_pk_bf16(lo, hi); }
__device__ __forceinline__ unsigned f2bf(float f) { return pk2(f, f) & 0xffffu; }

#define XB_TMO      128
#define XB_XCNT(j)  (256  + 64 * (j))
#define XB_XSUB(j)  (1280 + 64 * (j))
#define XB_XGEN(j)  (2304 + 64 * (j))
#define XB_TOP      3328
#define XB_TOPGEN   3392
#define XCD_BAR_WORDS 3456
#define XB_SPIN_CAP (1u << 18)

__device__ __forceinline__ unsigned xb_ld(unsigned* p)              { return __hip_atomic_load(p, __ATOMIC_RELAXED, __HIP_MEMORY_SCOPE_AGENT); }
__device__ __forceinline__ unsigned xb_add(unsigned* p, unsigned v) { return __hip_atomic_fetch_add(p, v, __ATOMIC_RELAXED, __HIP_MEMORY_SCOPE_AGENT); }
__device__ __forceinline__ unsigned xb_xcc_id() { return (unsigned)__builtin_amdgcn_s_getreg((3 << 11) | 20) & 0xFu; }
#define XB_SPIN(cond, bar) do { unsigned _sp = 0; while (cond) { __builtin_amdgcn_s_sleep(1); \
    if ((++_sp & 255u) == 0u) { if (xb_ld(&(bar)[XB_TMO])) break; if (_sp > XB_SPIN_CAP) { atomicAdd(&(bar)[XB_TMO], 1u); break; } } } } while (0)

struct XcdBarrier {
    unsigned* bar; unsigned x;
    volatile LAS unsigned* st;
};

__device__ __forceinline__ XcdBarrier xcd_barrier_post(unsigned* bar, volatile LAS unsigned* st) {
    XcdBarrier b; b.bar = bar; b.x = xb_xcc_id(); b.st = st;
    if (threadIdx.x == 0) (void)xb_add(&bar[XB_XCNT(b.x)], 1u);
    return b;
}
__device__ __forceinline__ void xcd_barrier_complete(unsigned* bar, unsigned x, unsigned& nloc, unsigned& nx) {
    const unsigned G = gridDim.x * gridDim.y * gridDim.z;
    unsigned sum, cnt, mine, sp = 0u;
    for (;;) {
        sum = 0u; cnt = 0u; mine = 0u;
#pragma unroll
        for (unsigned j = 0; j < 16; ++j) { const unsigned c = xb_ld(&bar[XB_XCNT(j)]); sum += c; cnt += (c > 0u) ? 1u : 0u; mine = (j == x) ? c : mine; }
        if (sum == G) break;
        __builtin_amdgcn_s_sleep(1);
        if ((++sp & 255u) == 0u) { if (xb_ld(&bar[XB_TMO])) break; if (sp > XB_SPIN_CAP) { atomicAdd(&bar[XB_TMO], 1u); break; } }
    }
    nloc = mine > 0u ? mine : 1u; nx = cnt > 0u ? cnt : 1u;
}

__device__ __forceinline__ void xcd_barrier(const XcdBarrier& b) {
    asm volatile("s_waitcnt vmcnt(0)" ::: "memory");
    __syncthreads();
    if (threadIdx.x == 0) {
        unsigned* bar = b.bar;
        __builtin_amdgcn_s_waitcnt(0);
        unsigned nloc = b.st[0], nx = b.st[1];
        if (nloc == 0u) { xcd_barrier_complete(bar, b.x, nloc, nx); b.st[0] = nloc; b.st[1] = nx; }
        const unsigned old = xb_add(&bar[XB_XSUB(b.x)], 1u);
        const unsigned gen = old / nloc;
        if (old + 1u == (gen + 1u) * nloc) {
            __builtin_amdgcn_fence(__ATOMIC_RELEASE, "agent");
            asm volatile("s_waitcnt vmcnt(0)" ::: "memory");
            const unsigned og = xb_add(&bar[XB_TOP], 1u);
            const unsigned tg = og / nx;
            if (og + 1u == (tg + 1u) * nx) xb_add(&bar[XB_TOPGEN], 1u);
            else XB_SPIN(xb_ld(&bar[XB_TOPGEN]) == tg, bar);
            __builtin_amdgcn_fence(__ATOMIC_ACQUIRE, "agent");
            xb_add(&bar[XB_XGEN(b.x)], 1u);
            asm volatile("s_waitcnt vmcnt(0)" ::: "memory");
        } else {
            XB_SPIN(xb_ld(&bar[XB_XGEN(b.x)]) == gen, bar);
            __builtin_amdgcn_fence(__ATOMIC_ACQUIRE, "agent");
            asm volatile("s_waitcnt vmcnt(0)" ::: "memory");
        }
    }
    __syncthreads();
}


constexpr int NWAVES = 8;
constexpr size_t MiB = 1u << 20, KiB = 1u << 10;
constexpr size_t WS_CTL = 0, CTL_ZERO_BYTES = 1 * MiB;
constexpr size_t WS_MOD = 1 * MiB;
constexpr size_t WS_ROPE = 1 * MiB + 128 * KiB;
constexpr size_t WS_MISCF = 1 * MiB + 160 * KiB;
constexpr size_t WS_WG = 1 * MiB + 192 * KiB;
constexpr size_t WS_FMT = 1 * MiB + 256 * KiB;
constexpr size_t WS_FMF = 1 * MiB + 320 * KiB;
constexpr size_t WS_A1 = 1 * MiB + 512 * KiB;
constexpr size_t WS_A2 = 1 * MiB + 640 * KiB;
constexpr size_t WS_TW = 1 * MiB + 704 * KiB;
constexpr size_t WS_ACTX = 1 * MiB + 768 * KiB;
constexpr size_t WS_CUM = 2 * MiB, WS_AA = 4 * MiB, WS_PM = 6 * MiB;
constexpr size_t WS_TOT = 8 * MiB, WS_AMAX = 8 * MiB + 16 * KiB;
constexpr size_t WS_GRAW = 10 * MiB;
constexpr size_t WS_W0T = 16 * MiB, WS_WO0T = 21 * MiB, WS_W1T = 23 * MiB, WS_WO1T = 33 * MiB;
constexpr size_t WS_H = 36 * MiB;
constexpr size_t WS_Q0 = 102 * MiB;
constexpr size_t WS_GA = WS_Q0 + (size_t)MTOT * 768 * 2;
constexpr size_t WS_KALL = WS_GA + (size_t)MTOT * 768 * 2;
constexpr size_t WS_VALL = WS_KALL + (size_t)BATCH * NKEYS * 256 * 2;
constexpr size_t WS_U = WS_VALL + (size_t)BATCH * NKEYS * 256 * 2;
constexpr size_t WS_GB = WS_U + (size_t)MTOT * 256 * 2;
constexpr size_t WS_Y = WS_GB + (size_t)MTOT * 256 * 2;
constexpr size_t WS_L0_END = WS_Y + (size_t)MTOT * 1024 * 2;
constexpr size_t WS_QB = 102 * MiB, WS_KB = 168 * MiB, WS_VB = 234 * MiB, WS_OG = 300 * MiB;
constexpr size_t WS_HF = 366 * MiB, WS_HB = 430 * MiB;
constexpr size_t WS_YG = 366 * MiB;
constexpr size_t WS_GY = WS_H;
constexpr size_t WS_S = WS_H;
constexpr size_t WS_YMIX = WS_QB;
constexpr size_t WS_ZC = 494 * MiB;
constexpr size_t WS_END = 498 * MiB;
static_assert(WS_L0_END <= 366 * MiB && WS_W1T + (size_t)ODD_N * 1024 * 2 <= WS_WO1T && WS_H + (size_t)MTOT * 2048 <= WS_Q0, "d_ws map");

constexpr int CW_TMO = 0, CW_CODE = 1;
constexpr int CW_BAR = 4096;
constexpr int RING_OFF = 0, RING_BYTES = 131072;
constexpr int LDSCTL_OFF = RING_BYTES, MISC_OFF = LDSCTL_OFF + 320;
constexpr int LDS_BYTES = 147456;

struct Frame {
    LAS unsigned char* lds;
    volatile LAS unsigned* MISC;
    gu32* ctl;
    int tid, lane, wave;
    int vcu, G;
    unsigned char* ws;
    const float *x, *c, *ctx, *c_ctx, *ada_w, *ada_b, *pgain, *pbias, *w0, *qgain, *kgain, *fgain, *wfmix, *wo0, *w1, *gbias, *wo1;
    float* out;
};
__device__ __forceinline__ float wave_sum(float v) {
#pragma unroll
    for (int o = 1; o < 64; o <<= 1) v += __shfl_xor(v, o);
    return v;
}
__device__ __forceinline__ float silu_acc(float v) { return v / (1.0f + expf(-v)); }

constexpr int P0_ITEMS = 96 + 1 + 1 + 4 + 1 + 1 + 1;
__device__ __forceinline__ void weights_pass(Frame& F, const int gw, const int NGW);
__device__ __forceinline__ void p0_tables(Frame& F) {
    float* mod = (float*)(F.ws + WS_MOD);
    for (int it = blockIdx.x; it < P0_ITEMS; it += F.G) {
        __syncthreads();
        if (it < 96) {
            const int layer = it / 48, cb = it % 48;
            LAS float* sl = (LAS float*)(F.lds);
            LAS float* red = sl + 5 * 1024;
            for (int i = F.tid; i < 5 * 1024; i += NWAVES * 64) { const int r = i >> 10, k = i & 1023; const float v = (r < 4) ? F.c[r * 1024 + k] : F.c_ctx[k]; sl[i] = silu_acc(v); }
            __syncthreads();
            const int col = F.tid & 63, kg = F.tid >> 6;
            const float* W = F.ada_w + (size_t)layer * 1024 * 3072 + cb * 64 + col;
            float a[5] = {0.f, 0.f, 0.f, 0.f, 0.f};
            for (int k0 = kg * 128; k0 < kg * 128 + 128; k0 += 16) {
                float wv[16];
#pragma unroll
                for (int u = 0; u < 16; ++u) wv[u] = W[(size_t)(k0 + u) * 3072];
#pragma unroll
                for (int u = 0; u < 16; ++u)
#pragma unroll
                    for (int r = 0; r < 5; ++r) a[r] += sl[r * 1024 + k0 + u] * wv[u]; }
#pragma unroll
            for (int r = 0; r < 5; ++r) red[(kg * 5 + r) * 64 + col] = a[r];
            __syncthreads();
            if (F.tid < 320) { const int r = F.tid >> 6; float s = 0.f;
#pragma unroll
                for (int g = 0; g < 8; ++g) s += red[(g * 5 + r) * 64 + col];
                mod[(layer * 5 + r) * 3072 + cb * 64 + col] = s + F.ada_b[layer * 3072 + cb * 64 + col]; }
        } else if (it == 96) {
            float* rp = (float*)(F.ws + WS_ROPE);
            for (int i = F.tid; i < 3072; i += NWAVES * 64) {
                const int j = (i < 2048) ? i : (i - 2048); const int pos = j >> 4, fi = j & 15;
                const float invf = powf(10000.0f, -(float)fi / 16.0f); const float ang = (float)pos * invf;
                if (i < 2048) { rp[i] = cosf(ang); rp[2048 + i] = sinf(ang); } else { rp[4096 + j] = cosf(ang); rp[5120 + j] = sinf(ang); }
            }
        } else if (it == 97) {
            if (F.tid == 0) { float gq = 0.f, gk = 0.f; for (int i = 0; i < 64; ++i) { gq = fmaxf(gq, fabsf(F.qgain[i])); gk = fmaxf(gk, fabsf(F.kgain[i])); }
                ((float*)(F.ws + WS_MISCF))[0] = QSCALE * 64.0f * gq * gk * 1.001f; }
        } else if (it < 102) {
            const int g = it - 98;
            LAS float* cs = (LAS float*)(F.lds); LAS float* sn = cs + 64;
            if (F.tid < 64) { cs[F.tid] = cospif((float)F.tid / 32.0f); sn[F.tid] = sinpif((float)F.tid / 32.0f); }
            __syncthreads();
            bf16* fmt = (bf16*)(F.ws + WS_FMT) + (size_t)g * 128 * 64; float* fmf = (float*)(F.ws + WS_FMF) + (size_t)g * 64 * 64 * 2;
            const float* wm = F.wfmix + (size_t)g * 64 * 64;
            for (int i = F.tid; i < 64 * 64; i += NWAVES * 64) { const int cch = i >> 6, d = i & 63; float re = 0.f, im = 0.f;
                for (int kc = 0; kc < 64; ++kc) { const float w = wm[kc * 64 + d]; const int j = (kc * cch) & 63; re += cs[j] * w; im -= sn[j] * w; }
                re *= 0.0013810679320049757f; im *= 0.0013810679320049757f;
                fmf[(cch * 64 + d) * 2] = re; fmf[(cch * 64 + d) * 2 + 1] = im;
                fmt[(2 * d) * 64 + cch] = (bf16)f2bf(re); fmt[(2 * d + 1) * 64 + cch] = (bf16)f2bf(im); }
        } else if (it == 102) {
            LAS float* cs = (LAS float*)(F.lds); LAS float* sn = cs + 128;
            if (F.tid < 128) { cs[F.tid] = cospif((float)F.tid / 64.0f); sn[F.tid] = sinpif((float)F.tid / 64.0f); }
            __syncthreads();
            bf16* a1 = (bf16*)(F.ws + WS_A1);
            for (int i = F.tid; i < 256 * 256; i += NWAVES * 64) { const int row = i >> 8, col = i & 255; const int k1 = row >> 1, ro = row & 1, t1 = col >> 1, ri = col & 1; const int j = (k1 * t1) & 127;
                const float cv = cs[j], sv = sn[j]; const float v = (ro == 0) ? (ri == 0 ? cv : sv) : (ri == 0 ? -sv : cv); a1[i] = (bf16)f2bf(v); }
        } else if (it == 104) {
            LAS float* cs = (LAS float*)(F.lds); LAS float* sn = cs + 256;
            if (F.tid < 256) { cs[F.tid] = cospif((float)F.tid / 128.0f); sn[F.tid] = sinpif((float)F.tid / 128.0f); }
            __syncthreads();
            bf16* ac = (bf16*)(F.ws + WS_ACTX);
            for (int i = F.tid; i < 256 * 512; i += NWAVES * 64) { const int kt = i >> 9, col = i & 511; const int t = col >> 1, ri = col & 1; const int j = (kt * t) & 255; ac[i] = (bf16)f2bf(ri == 0 ? cs[j] : sn[j]); }
        } else {
            LAS float* cs = (LAS float*)(F.lds); LAS float* sn = cs + 64;
            if (F.tid < 64) { cs[F.tid] = cospif((float)F.tid / 32.0f); sn[F.tid] = sinpif((float)F.tid / 32.0f); }
            __syncthreads();
            bf16* a2 = (bf16*)(F.ws + WS_A2);
            for (int i = F.tid; i < 64 * 128; i += NWAVES * 64) { const int k2 = i >> 7, col = i & 127; const int t2 = col >> 1, ri = col & 1; const int j = (k2 * t2) & 63; a2[i] = (bf16)f2bf(ri == 0 ? cs[j] : sn[j]); }
            float* tw = (float*)(F.ws + WS_TW);
            for (int i = F.tid; i < 128 * 64; i += NWAVES * 64) { const int k1 = i >> 6, t2 = i & 63; const float a = (float)(k1 * t2) / 4096.0f; tw[2 * i] = cospif(a); tw[2 * i + 1] = sinpif(a); }
        }
    }
    __syncthreads();
    if (F.G >= P0_ITEMS + 64) { if ((int)blockIdx.x >= P0_ITEMS) weights_pass(F, ((int)blockIdx.x - P0_ITEMS) * NWAVES + F.wave, (F.G - P0_ITEMS) * NWAVES); }
    else weights_pass(F, (int)blockIdx.x * NWAVES + F.wave, F.G * NWAVES);
}

__device__ __forceinline__ void transpose_item(const float* W, int srcN, int n0, int kb, bf16* WT, int drow0, float scale, LAS float* scr, int lane) {
    const int k0 = 64 * kb;
#pragma unroll 8
    for (int i = 0; i < 32; ++i) { const int kk = 2 * i + (lane >> 5); scr[kk * 33 + (lane & 31)] = W[(size_t)(k0 + kk) * srcN + n0 + (lane & 31)] * scale; }
    LDS_WAIT(); asm volatile("" ::: "memory");
    const int c = lane & 7;
#pragma unroll
    for (int j = 0; j < 4; ++j) { const int n = (lane >> 3) + 8 * j; const LAS float* s = scr + (8 * c) * 33 + n;
        v4u o; o.x = pk2(s[0 * 33], s[1 * 33]); o.y = pk2(s[2 * 33], s[3 * 33]); o.z = pk2(s[4 * 33], s[5 * 33]); o.w = pk2(s[6 * 33], s[7 * 33]);
        *(GAS v4u*)(WT + (size_t)(drow0 + n) * 1024 + k0 + 8 * c) = o; }
    LDS_WAIT(); asm volatile("" ::: "memory");
}
__device__ __forceinline__ void weights_pass(Frame& F, const int gw, const int NGW) {
    LAS float* scr = (LAS float*)(F.lds + RING_OFF + F.wave * 16384);
    constexpr int I_W0 = 16 * (EVEN_N / 32), I_WO = 16 * 32, I_W1 = 16 * (ODD_N / 32);
    constexpr int NITEMS = I_W0 + I_WO + I_W1 + I_WO;
    for (int it = gw; it < NITEMS; it += NGW) {
        int r = it;
        if (r < I_W0) { const int kb = r / (EVEN_N / 32), nb = r % (EVEN_N / 32), n0 = nb * 32; const int pn = n0 >> 8, L = n0 & 255, wc = L >> 6, bj = (L >> 5) & 1;
            transpose_item(F.w0, EVEN_N, n0, kb, (bf16*)(F.ws + WS_W0T), pn * 256 + bj * 128 + wc * 32, 1.0f, scr, F.lane); continue; } r -= I_W0;
        if (r < I_WO) { transpose_item(F.wo0, 1024, (r % 32) * 32, r / 32, (bf16*)(F.ws + WS_WO0T), (r % 32) * 32, 1.0f, scr, F.lane); continue; } r -= I_WO;
        if (r < I_W1) { const int kb = r / (ODD_N / 32), nb = r % (ODD_N / 32), n0 = nb * 32; int drow; float sc = 1.0f;
            if (n0 < 3072) { drow = n0; if (n0 >= 1024 && n0 < 2048) sc = 0.0625f; }
            else if (n0 < 4096) { const int fo = n0 - 3072; drow = 256 * (12 + (fo >> 7)) + (fo & 127); }
            else { const int fz = n0 - 4096; drow = 256 * (12 + (fz >> 7)) + 128 + (fz & 127); }
            transpose_item(F.w1, ODD_IN_W, n0, kb, (bf16*)(F.ws + WS_W1T), drow, sc, scr, F.lane); continue; } r -= I_W1;
        transpose_item(F.wo1, 1024, (r % 32) * 32, r / 32, (bf16*)(F.ws + WS_WO1T), (r % 32) * 32, 1.0f, scr, F.lane);
    }
    { float* wg = (float*)(F.ws + WS_WG);
        for (int i = gw * 64 + F.lane; i < 16 * 1024; i += NGW * 64) { const int j = i >> 10, k = i & 1023; wg[i] = F.w1[(size_t)k * ODD_IN_W + ODD_N + j]; } }
}
__device__ __forceinline__ void p1_h0_rows(Frame& F) {
    const int gw = F.vcu * NWAVES + F.wave;
    {
        const float* mod0 = (const float*)(F.ws + WS_MOD);
        int lane = F.lane; asm volatile("" : "+v"(lane));
        const int rpw = (MTOT + F.G * NWAVES - 1) / (F.G * NWAVES);
        const int m0 = gw * rpw, m1 = (m0 + rpw < MTOT) ? (m0 + rpw) : MTOT;
        if (m0 < m1) {
            f32x4 vn[4], sc[4], sh[4]; int rcur = -1;
            { const float* xr = (m0 < MLAT) ? (F.x + (size_t)m0 * 1024) : (F.ctx + (size_t)(m0 - MLAT) * 1024);
#pragma unroll
              for (int j = 0; j < 4; ++j) vn[j] = *((const GAS f32x4*)xr + lane + 64 * j); }
            for (int m = m0; m < m1; ++m) {
                f32x4 v[4];
#pragma unroll
                for (int j = 0; j < 4; ++j) v[j] = vn[j];
                if (m + 1 < m1) { const int m2 = m + 1; const float* xr = (m2 < MLAT) ? (F.x + (size_t)m2 * 1024) : (F.ctx + (size_t)(m2 - MLAT) * 1024);
#pragma unroll
                    for (int j = 0; j < 4; ++j) vn[j] = *((const GAS f32x4*)xr + lane + 64 * j); }
                const int r = (m < MLAT) ? (m >> 13) : 4;
                if (r != rcur) { rcur = r;
#pragma unroll
                    for (int j = 0; j < 4; ++j) { sh[j] = *((const f32x4*)(mod0 + r * 3072) + lane + 64 * j); sc[j] = *((const f32x4*)(mod0 + r * 3072 + 1024) + lane + 64 * j) + 1.0f; } }
                float s = 0.f;
#pragma unroll
                for (int j = 0; j < 4; ++j) s += (v[j].x + v[j].y) + (v[j].z + v[j].w);
                const float mean = wave_sum(s) * (1.f / 1024.f); float s2 = 0.f;
#pragma unroll
                for (int j = 0; j < 4; ++j) { v[j] = v[j] - mean; s2 += (v[j].x * v[j].x + v[j].y * v[j].y) + (v[j].z * v[j].z + v[j].w * v[j].w); }
                const float rstd = rsqrtf(wave_sum(s2) * (1.f / 1024.f) + LN_EPS);
                GAS unsigned long long* o8 = (GAS unsigned long long*)((bf16*)(F.ws + WS_H) + (size_t)m * 1024) + lane;
#pragma unroll
                for (int j = 0; j < 4; ++j) { const f32x4 h = v[j] * rstd * sc[j] + sh[j]; o8[64 * j] = (unsigned long long)pk2(h.x, h.y) | ((unsigned long long)pk2(h.z, h.w) << 32); }
            }
        }
    }
}

__device__ __forceinline__ void p5_rowpass(Frame& F) {
    const float* mod1 = (const float*)(F.ws + WS_MOD) + 5 * 3072;
    const float* wg = (const float*)(F.ws + WS_WG);
    float* zlat = F.out; float* graw = (float*)(F.ws + WS_GRAW);
    int lane = F.lane, wv = F.wave; asm volatile("" : "+v"(lane), "+s"(wv));
    const int gw = F.vcu * NWAVES + wv;
    LAS f32x4* wgl = (LAS f32x4*)(F.lds);
    __syncthreads();
    for (int i = wv * 64 + lane; i < 16 * 256; i += NWAVES * 64) wgl[i] = *((const f32x4*)wg + i);
    __syncthreads();
    const int rpw = (MTOT + F.G * NWAVES - 1) / (F.G * NWAVES);
    const int m0 = gw * rpw, m1 = (m0 + rpw < MTOT) ? (m0 + rpw) : MTOT;
    if (m0 < m1) {
        f32x4 vn[4], sc[4], sh[4], pg[4], pb[4]; int rcur = -1;
#pragma unroll
        for (int j = 0; j < 4; ++j) { pg[j] = *((const f32x4*)F.pgain + lane + 64 * j); pb[j] = *((const f32x4*)F.pbias + lane + 64 * j); }
        const unsigned long long* gyb = (const unsigned long long*)(F.ws + WS_GY);
        unsigned long long gn[4];
        { const float* xr0 = (m0 < MLAT) ? (F.x + (size_t)m0 * 1024) : (F.ctx + (size_t)(m0 - MLAT) * 1024);
#pragma unroll
          for (int j = 0; j < 4; ++j) { vn[j] = *((const GAS f32x4*)xr0 + lane + 64 * j); gn[j] = gyb[(size_t)m0 * 256 + lane + 64 * j]; } }
        const float gb = (lane < 16) ? F.gbias[lane] : 0.f;
        for (int m = m0; m < m1; ++m) {
            f32x4 v[4];
#pragma unroll
            for (int j = 0; j < 4; ++j) { const unsigned lo = (unsigned)gn[j], hi = (unsigned)(gn[j] >> 32);
                v[j].x = vn[j].x * ALPHA_RES + __builtin_bit_cast(float, lo << 16); v[j].y = vn[j].y * ALPHA_RES + __builtin_bit_cast(float, lo & 0xffff0000u);
                v[j].z = vn[j].z * ALPHA_RES + __builtin_bit_cast(float, hi << 16); v[j].w = vn[j].w * ALPHA_RES + __builtin_bit_cast(float, hi & 0xffff0000u); }
            GAS unsigned long long* zr = (GAS unsigned long long*)(zlat + (size_t)m * 1024) + lane;
            if (m + 1 < m1) { const int m2 = m + 1; const float* x2 = (m2 < MLAT) ? (F.x + (size_t)m2 * 1024) : (F.ctx + (size_t)(m2 - MLAT) * 1024);
#pragma unroll
                for (int j = 0; j < 4; ++j) { vn[j] = *((const GAS f32x4*)x2 + lane + 64 * j); gn[j] = gyb[(size_t)m2 * 256 + lane + 64 * j]; } }
            const int r = (m < MLAT) ? (m >> 13) : 4;
            if (r != rcur) { rcur = r;
#pragma unroll
                for (int j = 0; j < 4; ++j) { sh[j] = *((const f32x4*)(mod1 + r * 3072) + lane + 64 * j); sc[j] = *((const f32x4*)(mod1 + r * 3072 + 1024) + lane + 64 * j) + 1.0f; } }
            float s = 0.f;
#pragma unroll
            for (int j = 0; j < 4; ++j) s += (v[j].x + v[j].y) + (v[j].z + v[j].w);
            float mean = wave_sum(s) * (1.f / 1024.f); float s2 = 0.f;
#pragma unroll
            for (int j = 0; j < 4; ++j) { v[j] = v[j] - mean; s2 += (v[j].x * v[j].x + v[j].y * v[j].y) + (v[j].z * v[j].z + v[j].w * v[j].w); }
            float rstd = rsqrtf(wave_sum(s2) * (1.f / 1024.f) + LN_EPS);
            s = 0.f;
#pragma unroll
            for (int j = 0; j < 4; ++j) { v[j] = v[j] * rstd * pg[j] + pb[j]; if (m < MLAT) zr[64 * j] = (unsigned long long)pk2(v[j].x, v[j].y) | ((unsigned long long)pk2(v[j].z, v[j].w) << 32); s += (v[j].x + v[j].y) + (v[j].z + v[j].w); }
            mean = wave_sum(s) * (1.f / 1024.f); s2 = 0.f;
#pragma unroll
            for (int j = 0; j < 4; ++j) { v[j] = v[j] - mean; s2 += (v[j].x * v[j].x + v[j].y * v[j].y) + (v[j].z * v[j].z + v[j].w * v[j].w); }
            rstd = rsqrtf(wave_sum(s2) * (1.f / 1024.f) + LN_EPS);
            GAS unsigned long long* o8 = (GAS unsigned long long*)((bf16*)(F.ws + WS_H) + (size_t)m * 1024) + lane;
#pragma unroll
            for (int j = 0; j < 4; ++j) { v[j] = v[j] * rstd * sc[j] + sh[j]; o8[64 * j] = (unsigned long long)pk2(v[j].x, v[j].y) | ((unsigned long long)pk2(v[j].z, v[j].w) << 32); }
            float d[16];
#pragma unroll
            for (int gi = 0; gi < 16; ++gi) { float a = 0.f;
#pragma unroll
                for (int j = 0; j < 4; ++j) { const f32x4 w = wgl[gi * 256 + lane + 64 * j]; a += (v[j].x * w.x + v[j].y * w.y) + (v[j].z * w.z + v[j].w * w.w); }
                d[gi] = a; if ((gi & 3) == 3) __builtin_amdgcn_sched_barrier(0); }
            { const bool b5 = (lane & 32) != 0, b4 = (lane & 16) != 0, b3 = (lane & 8) != 0, b2 = (lane & 4) != 0;
              float e[8], g4v[4], h2[2];
#pragma unroll
              for (int i = 0; i < 8; ++i) { const float send = b5 ? d[i] : d[8 + i], own = b5 ? d[8 + i] : d[i]; e[i] = own + __shfl_xor(send, 32); }
#pragma unroll
              for (int i = 0; i < 4; ++i) { const float send = b4 ? e[i] : e[4 + i], own = b4 ? e[4 + i] : e[i]; g4v[i] = own + __shfl_xor(send, 16); }
#pragma unroll
              for (int i = 0; i < 2; ++i) { const float send = b3 ? g4v[i] : g4v[2 + i], own = b3 ? g4v[2 + i] : g4v[i]; h2[i] = own + __shfl_xor(send, 8); }
              float t1 = (b2 ? h2[1] : h2[0]) + __shfl_xor(b2 ? h2[0] : h2[1], 4);
              t1 += __shfl_xor(t1, 2); t1 += __shfl_xor(t1, 1);
              const int gidx = ((lane >> 5) & 1) * 8 + ((lane >> 4) & 1) * 4 + ((lane >> 3) & 1) * 2 + ((lane >> 2) & 1);
              const float gbv = __shfl(gb, gidx);
              if ((lane & 3) == 0) graw[(size_t)m * 16 + gidx] = t1 + gbv; }
        }
    }
    __syncthreads();
}
__device__ __forceinline__ void gate_scans(Frame& F) {
    LAS float* gl = (LAS float*)(F.lds);
    const float* graw = (const float*)(F.ws + WS_GRAW);
    int lane = F.lane, wv = F.wave; asm volatile("" : "+v"(lane), "+s"(wv));
    for (int u = F.vcu; u < 264; u += F.G) {
        const bool lat = u < 256; const int b = lat ? (u >> 6) : ((u - 256) >> 1); const int slot = lat ? (2 + (u & 63)) : ((u - 256) & 1);
        const size_t row0 = lat ? (size_t)u * 128 : (size_t)MLAT + (size_t)(u - 256) * 128;
        __syncthreads();
        *(LAS f32x4*)(gl + F.tid * 4) = *(const f32x4*)(graw + row0 * 16 + F.tid * 4);
        __syncthreads();
        const int dir = wv >> 2, h = wv & 3; const int cd = dir * 16 + b * 4 + h;
        const int p0 = dir ? (127 - 2 * lane) : (2 * lane), p1 = dir ? (126 - 2 * lane) : (2 * lane + 1);
        const float li0 = gl[p0 * 16 + 8 * dir + h], fp0 = gl[p0 * 16 + 8 * dir + 4 + h], li1 = gl[p1 * 16 + 8 * dir + h], fp1 = gl[p1 * 16 + 8 * dir + 4 + h];
        const float lf0 = fminf(fp0, 0.f) - log1pf(expf(-fabsf(fp0))), lf1 = fminf(fp1, 0.f) - log1pf(expf(-fabsf(fp1)));
        float ps = lf0 + lf1;
#pragma unroll
        for (int d = 1; d < 64; d <<= 1) { const float t = __shfl_up(ps, d); if (lane >= d) ps += t; }
        const float ex = ps - (lf0 + lf1);
        const float run0 = ex + lf0, run1 = run0 + lf1;
        const float a0 = li0 - run0, a1 = li1 - run1;
        float pm = fmaxf(a0, a1);
#pragma unroll
        for (int d = 1; d < 64; d <<= 1) { const float t = __shfl_up(pm, d); if (lane >= d) pm = fmaxf(pm, t); }
        float em = __shfl_up(pm, 1); if (lane == 0) em = -INFINITY;
        const float mx0 = fmaxf(em, a0), mx1 = fmaxf(mx0, a1);
        float* cum = (float*)(F.ws + WS_CUM) + ((size_t)cd * NSLOT + slot) * 128; float* aa = (float*)(F.ws + WS_AA) + ((size_t)cd * NSLOT + slot) * 128; float* pmx = (float*)(F.ws + WS_PM) + ((size_t)cd * NSLOT + slot) * 128;
        const int pl = dir ? p1 : p0;
        f32x2v cv, av, mv;
        cv.x = dir ? run1 : run0; cv.y = dir ? run0 : run1; av.x = dir ? a1 : a0; av.y = dir ? a0 : a1; mv.x = dir ? mx1 : mx0; mv.y = dir ? mx0 : mx1;
        *(f32x2v*)(cum + pl) = cv; *(f32x2v*)(aa + pl) = av; *(f32x2v*)(pmx + pl) = mv;
        if (lane == 63) { ((float*)(F.ws + WS_TOT))[cd * NSLOT + slot] = run1; ((float*)(F.ws + WS_AMAX))[cd * NSLOT + slot] = mx1; }
    }
    __syncthreads();
}

__device__ __forceinline__ void p11_final_ln(Frame& F) {
    int lane = F.lane, wv = F.wave; asm volatile("" : "+v"(lane), "+s"(wv));
    const int gw = F.vcu * NWAVES + wv;
    const int rpw = (MLAT + F.G * NWAVES - 1) / (F.G * NWAVES);
    const int m0 = gw * rpw, m1 = (m0 + rpw < MLAT) ? (m0 + rpw) : MLAT;
    if (m0 < m1) {
        f32x4 pg[4], pb[4]; unsigned long long xn[4];
#pragma unroll
        for (int j = 0; j < 4; ++j) { pg[j] = *((const f32x4*)(F.pgain + 1024) + lane + 64 * j); pb[j] = *((const f32x4*)(F.pbias + 1024) + lane + 64 * j); }
        const unsigned long long* gyb = (const unsigned long long*)(F.ws + WS_GY); unsigned long long gn[4];
#pragma unroll
        for (int j = 0; j < 4; ++j) { xn[j] = *((const GAS unsigned long long*)(F.out + (size_t)m0 * 1024) + lane + 64 * j); gn[j] = gyb[(size_t)m0 * 256 + lane + 64 * j]; }
        for (int m = m0; m < m1; ++m) {
            f32x4 v[4];
#pragma unroll
            for (int j = 0; j < 4; ++j) { const unsigned lo = (unsigned)gn[j], hi = (unsigned)(gn[j] >> 32), xl = (unsigned)xn[j], xh = (unsigned)(xn[j] >> 32);
                v[j].x = __builtin_bit_cast(float, xl << 16) * ALPHA_RES + __builtin_bit_cast(float, lo << 16); v[j].y = __builtin_bit_cast(float, xl & 0xffff0000u) * ALPHA_RES + __builtin_bit_cast(float, lo & 0xffff0000u);
                v[j].z = __builtin_bit_cast(float, xh << 16) * ALPHA_RES + __builtin_bit_cast(float, hi << 16); v[j].w = __builtin_bit_cast(float, xh & 0xffff0000u) * ALPHA_RES + __builtin_bit_cast(float, hi & 0xffff0000u); }
            GAS f32x4* zr = (GAS f32x4*)(F.out + (size_t)m * 1024) + lane;
            if (m + 1 < m1) {
#pragma unroll
                for (int j = 0; j < 4; ++j) { xn[j] = *((const GAS unsigned long long*)(F.out + (size_t)(m + 1) * 1024) + lane + 64 * j); gn[j] = gyb[(size_t)(m + 1) * 256 + lane + 64 * j]; } }
            float s = 0.f;
#pragma unroll
            for (int j = 0; j < 4; ++j) s += (v[j].x + v[j].y) + (v[j].z + v[j].w);
            const float mean = wave_sum(s) * (1.f / 1024.f); float s2 = 0.f;
#pragma unroll
            for (int j = 0; j < 4; ++j) { v[j] = v[j] - mean; s2 += (v[j].x * v[j].x + v[j].y * v[j].y) + (v[j].z * v[j].z + v[j].w * v[j].w); }
            const float rstd = rsqrtf(wave_sum(s2) * (1.f / 1024.f) + LN_EPS);
#pragma unroll
            for (int j = 0; j < 4; ++j) zr[64 * j] = v[j] * rstd * pg[j] + pb[j];
        }
    }
}

typedef float f32x16 __attribute__((ext_vector_type(16)));

__device__ __forceinline__ float bf2f(unsigned short h) { return __builtin_bit_cast(float, (unsigned)h << 16); }

__device__ __forceinline__ void fourier_s1_f1(Frame& F, int item, LAS unsigned char* L, int lane, int w) {
    const int tp = item & 31, g = (item >> 5) & 3, b = item >> 7;
    const int r = lane & 31, h = lane >> 5;
    const int t2l = w >> 2, t1 = 32 * (w & 3) + r; const int t = 64 * t1 + 2 * tp + t2l;
    const bf16* Ur = (const bf16*)(F.ws + WS_U) + ((size_t)b * SEQ + t) * 256 + g * 64 + 8 * h;
    bf16x8 bu[4];
#pragma unroll
    for (int ks = 0; ks < 4; ++ks) bu[ks] = *(const bf16x8*)(Ur + 16 * ks);
    const bf16* FMT = (const bf16*)(F.ws + WS_FMT) + (size_t)(g * 128 + r) * 64 + 8 * h;
#pragma unroll
    for (int mt = 0; mt < 4; ++mt) {
        f32x16 a = {0.f, 0.f, 0.f, 0.f, 0.f, 0.f, 0.f, 0.f, 0.f, 0.f, 0.f, 0.f, 0.f, 0.f, 0.f, 0.f};
#pragma unroll
        for (int ks = 0; ks < 4; ++ks) { const bf16x8 af = *(const bf16x8*)(FMT + mt * 32 * 64 + 16 * ks); a = __builtin_amdgcn_mfma_f32_32x32x16_bf16(af, bu[ks], a, 0, 0, 0); }
#pragma unroll
        for (int q = 0; q < 8; ++q) { const int d = 16 * mt + 4 * (q >> 1) + 2 * h + (q & 1); const int col = t2l * 64 + d;
            *(LAS unsigned*)(L + col * 512 + (((t1 >> 2) ^ (col & 15)) << 4) + (t1 & 3) * 4) = pk2m(a[2 * q], a[2 * q + 1]); }
    }
}
__device__ __forceinline__ void fourier_s1_dft(Frame& F, int item, const LAS unsigned char* L, const bf16x8 (&a1)[16], int lane, int w) {
    const int tp = item & 31;
    const int r = lane & 31, h = lane >> 5;
    const f32x2v* TW = (const f32x2v*)(F.ws + WS_TW);
    unsigned long long* YG = (unsigned long long*)(F.ws + WS_YG) + (size_t)item * 128 * 64;
#pragma unroll
    for (int np = 0; np < 2; ++np) {
        f32x16 a0 = {0.f, 0.f, 0.f, 0.f, 0.f, 0.f, 0.f, 0.f, 0.f, 0.f, 0.f, 0.f, 0.f, 0.f, 0.f, 0.f}, a2 = a0;
        const int c0 = 32 * np + r, c2 = 64 + 32 * np + r;
#pragma unroll
        for (int ks = 0; ks < 16; ++ks) {
            const bf16x8 b0 = *(const LAS bf16x8*)(L + c0 * 512 + (((2 * ks + h) ^ (c0 & 15)) << 4)), b2 = *(const LAS bf16x8*)(L + c2 * 512 + (((2 * ks + h) ^ (c2 & 15)) << 4));
            a0 = __builtin_amdgcn_mfma_f32_32x32x16_bf16(a1[ks], b0, a0, 0, 0, 0); a2 = __builtin_amdgcn_mfma_f32_32x32x16_bf16(a1[ks], b2, a2, 0, 0, 0);
        }
        const int d = 32 * np + r;
#pragma unroll
        for (int q = 0; q < 8; ++q) {
            const int k1 = 16 * w + 4 * (q >> 1) + 2 * h + (q & 1);
            const f32x2v tw0 = TW[k1 * 64 + 2 * tp], tw1 = TW[k1 * 64 + 2 * tp + 1];
            const float zr0 = a0[2 * q] * tw0.x + a0[2 * q + 1] * tw0.y, zi0 = a0[2 * q + 1] * tw0.x - a0[2 * q] * tw0.y;
            const float zr1 = a2[2 * q] * tw1.x + a2[2 * q + 1] * tw1.y, zi1 = a2[2 * q + 1] * tw1.x - a2[2 * q] * tw1.y;
            YG[k1 * 64 + d] = (unsigned long long)pk2(zr0, zi0) | ((unsigned long long)pk2(zr1, zi1) << 32);
        }
    }
}
__device__ __forceinline__ void fourier_s1_pair(Frame& F, int item0, int item1) {
    LAS unsigned char* L = F.lds + RING_OFF;
    int lane = F.lane, w = F.wave; asm volatile("" : "+v"(lane), "+s"(w));
    __syncthreads();
    fourier_s1_f1(F, item0, L, lane, w);
    fourier_s1_f1(F, item1, L + 65536, lane, w);
    bf16x8 a1[16];
    { const bf16* A1 = (const bf16*)(F.ws + WS_A1) + (size_t)(32 * w + (lane & 31)) * 256 + 8 * (lane >> 5);
#pragma unroll
      for (int ks = 0; ks < 16; ++ks) a1[ks] = *(const bf16x8*)(A1 + 16 * ks); }
    __syncthreads();
    fourier_s1_dft(F, item0, L, a1, lane, w);
    fourier_s1_dft(F, item1, L + 65536, a1, lane, w);
}
__device__ __forceinline__ void fourier_s2_item(Frame& F, int item) {
    const int kp = item & 63, g = (item >> 6) & 3, b = item >> 8;
    int lane = F.lane, w = F.wave; asm volatile("" : "+v"(lane), "+s"(w));
    const int r = lane & 31, h = lane >> 5, nt = w & 3, mt = w >> 2;
    const int k1 = 2 * kp + (nt >> 1), d = 32 * (nt & 1) + r;
    const unsigned long long* YG = (const unsigned long long*)(F.ws + WS_YG) + ((size_t)(b * 4 + g) * 32 * 128 + k1) * 64 + d;
    const bf16* A2 = (const bf16*)(F.ws + WS_A2) + (size_t)(32 * mt + r) * 128 + 8 * h;
    f32x16 acc = {0.f, 0.f, 0.f, 0.f, 0.f, 0.f, 0.f, 0.f, 0.f, 0.f, 0.f, 0.f, 0.f, 0.f, 0.f, 0.f};
    unsigned long long yb[8][2];
#pragma unroll
    for (int ks = 0; ks < 8; ++ks) { yb[ks][0] = YG[(size_t)(4 * ks + 2 * h) * 128 * 64]; yb[ks][1] = YG[(size_t)(4 * ks + 2 * h + 1) * 128 * 64]; }
#pragma unroll
    for (int ks = 0; ks < 8; ++ks) {
        const bf16x8 af = *(const bf16x8*)(A2 + 16 * ks);
        v4u bq; bq.x = (unsigned)yb[ks][0]; bq.y = (unsigned)(yb[ks][0] >> 32); bq.z = (unsigned)yb[ks][1]; bq.w = (unsigned)(yb[ks][1] >> 32);
        acc = __builtin_amdgcn_mfma_f32_32x32x16_bf16(af, __builtin_bit_cast(bf16x8, bq), acc, 0, 0, 0);
    }
    LAS float* stg = (LAS float*)(F.lds + RING_OFF + 86016) + w * 1152;
#pragma unroll
    for (int rg = 0; rg < 16; ++rg) stg[((rg & 3) + 8 * (rg >> 2) + 4 * h) * 36 + r] = acc[rg];
    asm volatile("s_waitcnt lgkmcnt(0)" ::: "memory");
    const int q4 = lane & 3;
#pragma unroll
    for (int ps = 0; ps < 2; ++ps) {
        const int row = 16 * ps + (lane >> 2); const int t = k1 + 128 * (32 * mt + row);
        const f32x4 x0 = *(const LAS f32x4*)(stg + row * 36 + 8 * q4), x1 = *(const LAS f32x4*)(stg + row * 36 + 8 * q4 + 4);
        const v4u gq = *(const GAS v4u*)((const bf16*)(F.ws + WS_GB) + ((size_t)b * SEQ + t) * 256 + g * 64 + 32 * (nt & 1) + 8 * q4);
        v4u o;
        o.x = pk2(x0[0] * __builtin_bit_cast(float, gq.x << 16), x0[1] * __builtin_bit_cast(float, gq.x & 0xffff0000u));
        o.y = pk2(x0[2] * __builtin_bit_cast(float, gq.y << 16), x0[3] * __builtin_bit_cast(float, gq.y & 0xffff0000u));
        o.z = pk2(x1[0] * __builtin_bit_cast(float, gq.z << 16), x1[1] * __builtin_bit_cast(float, gq.z & 0xffff0000u));
        o.w = pk2(x1[2] * __builtin_bit_cast(float, gq.w << 16), x1[3] * __builtin_bit_cast(float, gq.w & 0xffff0000u));
        *(GAS v4u*)((bf16*)(F.ws + WS_Y) + ((size_t)b * SEQ + t) * 1024 + 768 + g * 64 + 32 * (nt & 1) + 8 * q4) = o;
    }
    asm volatile("s_waitcnt lgkmcnt(0)" ::: "memory");
}
__device__ __forceinline__ void fourier_ctx_item(Frame& F, int item) {
    const int g = item & 3, b = item >> 2;
    LAS unsigned char* L = F.lds + RING_OFF;
    int lane = F.lane, w = F.wave; asm volatile("" : "+v"(lane), "+s"(w));
    const int r = lane & 31, h = lane >> 5;
    __syncthreads();
    {
        const int t = 32 * w + r;
        const bf16* Ur = (const bf16*)(F.ws + WS_U) + ((size_t)MLAT + b * CTXL + t) * 256 + g * 64 + 8 * h;
        bf16x8 bu[4];
#pragma unroll
        for (int ks = 0; ks < 4; ++ks) bu[ks] = *(const bf16x8*)(Ur + 16 * ks);
        const bf16* FMT = (const bf16*)(F.ws + WS_FMT) + (size_t)(g * 128 + r) * 64 + 8 * h;
#pragma unroll
        for (int mt = 0; mt < 4; ++mt) {
            f32x16 a = {0.f, 0.f, 0.f, 0.f, 0.f, 0.f, 0.f, 0.f, 0.f, 0.f, 0.f, 0.f, 0.f, 0.f, 0.f, 0.f};
#pragma unroll
            for (int ks = 0; ks < 4; ++ks) { const bf16x8 af = *(const bf16x8*)(FMT + mt * 32 * 64 + 16 * ks); a = __builtin_amdgcn_mfma_f32_32x32x16_bf16(af, bu[ks], a, 0, 0, 0); }
#pragma unroll
            for (int q = 0; q < 8; ++q) { const int d = 16 * mt + 4 * (q >> 1) + 2 * h + (q & 1);
                *(LAS unsigned*)(L + d * 1024 + (((t >> 2) ^ (d & 15)) << 4) + (t & 3) * 4) = pk2(a[2 * q] * 5.656854249492381f, a[2 * q + 1] * 5.656854249492381f); }
        }
    }
    __syncthreads();
    {
        const bf16* AC = (const bf16*)(F.ws + WS_ACTX) + (size_t)(32 * w + r) * 512 + 8 * h;
        f32x16 acc[2];
#pragma unroll
        for (int nt = 0; nt < 2; ++nt) acc[nt] = (f32x16){0.f, 0.f, 0.f, 0.f, 0.f, 0.f, 0.f, 0.f, 0.f, 0.f, 0.f, 0.f, 0.f, 0.f, 0.f, 0.f};
#pragma unroll 4
        for (int ks = 0; ks < 32; ++ks) { const bf16x8 af = *(const bf16x8*)(AC + 16 * ks);
#pragma unroll
            for (int nt = 0; nt < 2; ++nt) { const int d = 32 * nt + r; const bf16x8 bfr = *(const LAS bf16x8*)(L + d * 1024 + (((2 * ks + h) ^ (d & 15)) << 4)); acc[nt] = __builtin_amdgcn_mfma_f32_32x32x16_bf16(af, bfr, acc[nt], 0, 0, 0); } }
        __syncthreads();
        LAS float* stg = (LAS float*)L + w * 2176;
#pragma unroll
        for (int nt = 0; nt < 2; ++nt)
#pragma unroll
            for (int rg = 0; rg < 16; ++rg) stg[((rg & 3) + 8 * (rg >> 2) + 4 * h) * 68 + 32 * nt + r] = acc[nt][rg];
        asm volatile("s_waitcnt lgkmcnt(0)" ::: "memory");
        const int q8 = lane & 7;
#pragma unroll
        for (int ps = 0; ps < 4; ++ps) {
            const int row = 8 * ps + (lane >> 3); const size_t tok = (size_t)MLAT + b * CTXL + 32 * w + row;
            const f32x4 x0 = *(const LAS f32x4*)(stg + row * 68 + 8 * q8), x1 = *(const LAS f32x4*)(stg + row * 68 + 8 * q8 + 4);
            const v4u gq = *(const GAS v4u*)((const bf16*)(F.ws + WS_GB) + tok * 256 + g * 64 + 8 * q8);
            v4u o;
            o.x = pk2(x0[0] * __builtin_bit_cast(float, gq.x << 16), x0[1] * __builtin_bit_cast(float, gq.x & 0xffff0000u));
            o.y = pk2(x0[2] * __builtin_bit_cast(float, gq.y << 16), x0[3] * __builtin_bit_cast(float, gq.y & 0xffff0000u));
            o.z = pk2(x1[0] * __builtin_bit_cast(float, gq.z << 16), x1[1] * __builtin_bit_cast(float, gq.z & 0xffff0000u));
            o.w = pk2(x1[2] * __builtin_bit_cast(float, gq.w << 16), x1[3] * __builtin_bit_cast(float, gq.w & 0xffff0000u));
            *(GAS v4u*)((bf16*)(F.ws + WS_Y) + tok * 1024 + 768 + g * 64 + 8 * q8) = o;
        }
    }
    __syncthreads();
}

namespace attn_body {
using bf16=__hip_bfloat16;
using bf16x8=__attribute__((ext_vector_type(8)))short;
using s16x4=__attribute__((ext_vector_type(4)))short;
using f32x16=__attribute__((ext_vector_type(16)))float;
using u32x4=__attribute__((ext_vector_type(4)))unsigned;
constexpr int NW=8,QBLK=32,QB=QBLK*NW,KVBLK=64;
constexpr int QP=768,KP=256,OP=1024,GP=768;
__device__ __forceinline__ int crow(int r,int hi){return (r&3)+8*(r>>2)+4*hi;}
#define SBAR() __builtin_amdgcn_sched_barrier(0)
constexpr int NSLOT=3, SLOTB=8192;
constexpr int LDS_K=0, LDS_V=NSLOT*SLOTB, LDS_WS=2*NSLOT*SLOTB, LDS_OST=LDS_WS+NW*64*4, LDS_BYTES=LDS_OST+NW*4096;
__device__ __forceinline__ void glds16(const void*gsrc,unsigned lds_dst){unsigned keep;
  asm volatile("s_mov_b32 %0, m0\n\ts_mov_b32 m0, %2\n\ts_nop 0\n\tglobal_load_lds_dwordx4 %1, off\n\ts_mov_b32 m0, %0":"=&s"(keep):"v"(gsrc),"s"(lds_dst):"memory");}
typedef float f32x2_t __attribute__((ext_vector_type(2))); typedef __bf16 bf16x2_t __attribute__((ext_vector_type(2)));
__device__ __forceinline__ unsigned cvtpk_s(float lo,float hi){f32x2_t v={lo,hi};bf16x2_t b=__builtin_convertvector(v,bf16x2_t);return __builtin_bit_cast(unsigned,b);}
#define WAIT_BAR(N) asm volatile("s_waitcnt vmcnt(" #N ") lgkmcnt(0)\n\ts_barrier":::"memory")

__device__ __forceinline__ void qkt(f32x16&p0,f32x16&p1,const char*Kslot,const bf16x8*qr,const f32x16&negm,int r32,int hi){
  const char*kb=Kslot+hi*1024+r32*16;
  #pragma unroll
  for(int d0=0;d0<4;++d0){
    const bf16x8 b0=*reinterpret_cast<const bf16x8*>(kb+d0*2048);
    const bf16x8 b1=*reinterpret_cast<const bf16x8*>(kb+d0*2048+512);
    if(d0==0){p0=__builtin_amdgcn_mfma_f32_32x32x16_bf16(b0,qr[0],negm,0,0,0);p1=__builtin_amdgcn_mfma_f32_32x32x16_bf16(b1,qr[0],negm,0,0,0);}
    else{p0=__builtin_amdgcn_mfma_f32_32x32x16_bf16(b0,qr[d0],p0,0,0,0);p1=__builtin_amdgcn_mfma_f32_32x32x16_bf16(b1,qr[d0],p1,0,0,0);}}
}
typedef __attribute__((address_space(3))) const char* lds_cptr;
typedef short v4i16_t __attribute__((ext_vector_type(4)));
__device__ __forceinline__ void kload8(bf16x8*kf,lds_cptr kp){
  kf[0]=*(const __attribute__((address_space(3))) bf16x8*)(kp);      kf[1]=*(const __attribute__((address_space(3))) bf16x8*)(kp+512);
  kf[2]=*(const __attribute__((address_space(3))) bf16x8*)(kp+2048); kf[3]=*(const __attribute__((address_space(3))) bf16x8*)(kp+2560);
  kf[4]=*(const __attribute__((address_space(3))) bf16x8*)(kp+4096); kf[5]=*(const __attribute__((address_space(3))) bf16x8*)(kp+4608);
  kf[6]=*(const __attribute__((address_space(3))) bf16x8*)(kp+6144); kf[7]=*(const __attribute__((address_space(3))) bf16x8*)(kp+6656);
}
__device__ __forceinline__ void kload2(bf16x8*kf,lds_cptr kp,int j){ kf[2*j]=*(const __attribute__((address_space(3))) bf16x8*)(kp+j*2048); kf[2*j+1]=*(const __attribute__((address_space(3))) bf16x8*)(kp+j*2048+512); }
__device__ __forceinline__ s16x4 vtr(lds_cptr p){ return __builtin_bit_cast(s16x4,__builtin_amdgcn_ds_read_tr16_b64_v4i16((__attribute__((address_space(3))) v4i16_t*)p)); }
__device__ __forceinline__ void pv(f32x16*o,int vb,bf16x8 pa0,bf16x8 pa1,bf16x8 pa2,bf16x8 pa3){
  #pragma unroll
  for(int d0=0;d0<2;++d0){s16x4 lo[4],hi[4];
    #pragma unroll
    for(int ks=0;ks<4;++ks){
      asm volatile("ds_read_b64_tr_b16 %0,%1 offset:%c2":"=&v"(lo[ks]):"v"(vb),"i"(d0*4096+ks*1024):"memory");
      asm volatile("ds_read_b64_tr_b16 %0,%1 offset:%c2":"=&v"(hi[ks]):"v"(vb),"i"(d0*4096+ks*1024+512):"memory");}
    asm volatile("s_waitcnt lgkmcnt(0)":::"memory");SBAR();
    #define PK(k) (bf16x8){lo[k][0],lo[k][1],lo[k][2],lo[k][3],hi[k][0],hi[k][1],hi[k][2],hi[k][3]}
    o[d0]=__builtin_amdgcn_mfma_f32_32x32x16_bf16(pa0,PK(0),o[d0],0,0,0);
    o[d0]=__builtin_amdgcn_mfma_f32_32x32x16_bf16(pa1,PK(1),o[d0],0,0,0);
    o[d0]=__builtin_amdgcn_mfma_f32_32x32x16_bf16(pa2,PK(2),o[d0],0,0,0);
    o[d0]=__builtin_amdgcn_mfma_f32_32x32x16_bf16(pa3,PK(3),o[d0],0,0,0);
    #undef PK
  }
}
__device__ __forceinline__ float bfbits2f(unsigned short h){ return __builtin_bit_cast(float,(unsigned)h<<16); }

__device__ __forceinline__ void attn_unit(const bf16*Qu,const bf16*__restrict__ Kh,const bf16*__restrict__ Vh,const int NT,bf16*Ou,const bf16*Gu,const float shift,char*shm){
  const int tid=threadIdx.x,lane=tid&63,r32=lane&31,hi=lane>>5; const int wid=__builtin_amdgcn_readfirstlane(tid>>6);
  const bf16*Qw=Qu+(long)(wid*QBLK)*QP;
  const unsigned lds0=(unsigned)(uintptr_t)shm;
  float*wsf=(float*)(shm+LDS_WS)+wid*64;
  const bf16*ksrc=Kh+(long)lane*KP+wid*8;
  const bf16*vsrc=Vh+(long)(16*(wid&3)+(lane>>2))*KP+(wid>>2)*32+(lane&3)*8;
  const unsigned kdst=lds0+LDS_K+wid*1024, vdst=lds0+LDS_V+wid*1024;
  #define DMA_K(t,slot) glds16(ksrc+(long)(t)*KVBLK*KP,(unsigned)__builtin_amdgcn_readfirstlane(kdst+(slot)))
  #define DMA_V(t,slot) glds16(vsrc+(long)(t)*KVBLK*KP,(unsigned)__builtin_amdgcn_readfirstlane(vdst+(slot)))
  const int vb0=(int)(lds0+LDS_V)+((lane>>4)&1)*32+(lane&3)*8+(4*hi+((lane&15)>>2))*64;
  const char*Kbase=shm+LDS_K; bf16x8 kf[8];
  const lds_cptr shm3=(lds_cptr)shm; const lds_cptr kp0=shm3+LDS_K+hi*1024+r32*16; const lds_cptr vp0=shm3+LDS_V+((lane>>4)&1)*32+(lane&3)*8+(4*hi+((lane&15)>>2))*64;
  DMA_K(0,0);DMA_V(0,0);DMA_K(1,SLOTB);
  bf16x8 qr[4];
  #pragma unroll
  for(int d0=0;d0<4;++d0)qr[d0]=*reinterpret_cast<const bf16x8*>(&Qw[(long)r32*QP+d0*16+hi*8]);
  float l_reg=0.f;f32x16 o[2];o[0]=f32x16{};o[1]=f32x16{};f32x16 negm;
  #pragma unroll
  for(int r=0;r<16;++r)negm[r]=-shift;
  asm volatile("":"+v"(negm));
  f32x16 pA0,pA1,pB0,pB1;
  int sl_prev=0,sl_cur=0,sl_next=SLOTB;
  #define ROT() do{sl_prev=sl_cur;sl_cur=sl_next;sl_next=(sl_next==(NSLOT-1)*SLOTB)?0:sl_next+SLOTB;}while(0)
  DMA_K(2,2*SLOTB);
  WAIT_BAR(3);
  qkt(pA0,pA1,Kbase,qr,negm,r32,hi);asm volatile("s_nop 15\n\ts_nop 7":"+v"(pA0),"+v"(pA1));
  _Pragma("unroll") for(int r=0;r<16;++r)pA0[r]=__builtin_amdgcn_exp2f(pA0[r]);
  _Pragma("unroll") for(int r=0;r<16;++r)pA1[r]=__builtin_amdgcn_exp2f(pA1[r]);
  WAIT_BAR(0);
  DMA_K(3,0);DMA_V(1,SLOTB);
  ROT();
  kload8(kf,kp0+sl_cur);
  WAIT_BAR(2);
  s16x4 vlo[8],vhi[8]; u32x4 pw0,pw1,pw2,pw3;
  #define PKW(P,B) cvtpk_s(P[B],P[B+1])
  #define PAF(k) __builtin_bit_cast(bf16x8,pw##k)
  #define VFR(i) (bf16x8){vlo[i][0],vlo[i][1],vlo[i][2],vlo[i][3],vhi[i][0],vhi[i][1],vhi[i][2],vhi[i][3]}
  #define PIN(x) asm volatile("":"+v"(x))
  #define GAPA(MF,A0,A1,A2,A3,W0,W1,PW) do{ MF; sacc+=A0; sacc+=A1; sacc+=A2; sacc+=A3; PIN(sacc); W0; W1; PIN(PW); SBAR(); }while(0)
  #define EX(v) __builtin_amdgcn_exp2f(v)
  #define GAPB(MF,X,B) do{ MF; X[B]=EX(X[B]); X[B+1]=EX(X[B+1]); X[B+2]=EX(X[B+2]); X[B+3]=EX(X[B+3]); PIN(X); SBAR(); }while(0)
  #define VRD(i) do{ vlo[i]=vtr(vp_+(((i)>>2)*4096+((i)&3)*1024)); vhi[i]=vtr(vp_+(((i)>>2)*4096+((i)&3)*1024+512)); }while(0)
  #define KRD(G,j) do{ if(G){ kload2(kf,kp0+sl_next,j); SBAR(); } }while(0)
  #define STEP(C0,C1,P0,P1,t,GK,GV,GL) do{ SBAR(); \
    const lds_cptr vp_=vp0+sl_prev; \
    VRD(0); SBAR(); float sacc=(P0[0]+P0[1]); \
    GAPA(C0=__builtin_amdgcn_mfma_f32_32x32x16_bf16(kf[0],qr[0],negm,0,0,0), P0[2],P0[3],P0[4],P0[5],     pw0[0]=PKW(P0,0), pw0[1]=PKW(P0,2), pw0); \
    VRD(4); SBAR(); GAPA(C1=__builtin_amdgcn_mfma_f32_32x32x16_bf16(kf[1],qr[0],negm,0,0,0), P0[6],P0[7],P0[8],P0[9],     pw0[2]=PKW(P0,4), pw0[3]=PKW(P0,6), pw0); \
    VRD(1); SBAR(); GAPA(C0=__builtin_amdgcn_mfma_f32_32x32x16_bf16(kf[2],qr[1],C0,0,0,0),   P0[10],P0[11],P0[12],P0[13], pw1[0]=PKW(P0,8), pw1[1]=PKW(P0,10), pw1); \
    VRD(5); SBAR(); GAPA(C1=__builtin_amdgcn_mfma_f32_32x32x16_bf16(kf[3],qr[1],C1,0,0,0),   P0[14],P0[15],P1[0],P1[1],   pw1[2]=PKW(P0,12),pw1[3]=PKW(P0,14), pw1); \
    VRD(2); SBAR(); GAPA(C0=__builtin_amdgcn_mfma_f32_32x32x16_bf16(kf[4],qr[2],C0,0,0,0),   P1[2],P1[3],P1[4],P1[5],     pw2[0]=PKW(P1,0), pw2[1]=PKW(P1,2), pw2); \
    VRD(6); SBAR(); GAPA(C1=__builtin_amdgcn_mfma_f32_32x32x16_bf16(kf[5],qr[2],C1,0,0,0),   P1[6],P1[7],P1[8],P1[9],     pw2[2]=PKW(P1,4), pw2[3]=PKW(P1,6), pw2); \
    VRD(3); SBAR(); GAPA(C0=__builtin_amdgcn_mfma_f32_32x32x16_bf16(kf[6],qr[3],C0,0,0,0),   P1[10],P1[11],P1[12],P1[13], pw3[0]=PKW(P1,8), pw3[1]=PKW(P1,10), pw3); \
    VRD(7); SBAR(); GAPA(C1=__builtin_amdgcn_mfma_f32_32x32x16_bf16(kf[7],qr[3],C1,0,0,0),   P1[14],P1[15],0.f,0.f,       pw3[2]=PKW(P1,12),pw3[3]=PKW(P1,14), pw3); \
    l_reg+=sacc; \
    if(GK){DMA_K((t)+3,sl_cur);} if(GV){DMA_V((t)+1,sl_next);} \
    SBAR(); \
    GAPB(o[0]=__builtin_amdgcn_mfma_f32_32x32x16_bf16(PAF(0),VFR(0),o[0],0,0,0), C0,0); \
    GAPB(o[1]=__builtin_amdgcn_mfma_f32_32x32x16_bf16(PAF(0),VFR(4),o[1],0,0,0), C0,4); \
    KRD(GL,0); GAPB(o[0]=__builtin_amdgcn_mfma_f32_32x32x16_bf16(PAF(1),VFR(1),o[0],0,0,0), C0,8); \
    KRD(GL,1); GAPB(o[1]=__builtin_amdgcn_mfma_f32_32x32x16_bf16(PAF(1),VFR(5),o[1],0,0,0), C0,12); \
    KRD(GL,2); GAPB(o[0]=__builtin_amdgcn_mfma_f32_32x32x16_bf16(PAF(2),VFR(2),o[0],0,0,0), C1,0); \
    KRD(GL,3); GAPB(o[1]=__builtin_amdgcn_mfma_f32_32x32x16_bf16(PAF(2),VFR(6),o[1],0,0,0), C1,4); \
    GAPB(o[0]=__builtin_amdgcn_mfma_f32_32x32x16_bf16(PAF(3),VFR(3),o[0],0,0,0), C1,8); \
    GAPB(o[1]=__builtin_amdgcn_mfma_f32_32x32x16_bf16(PAF(3),VFR(7),o[1],0,0,0), C1,12); \
    }while(0)
  int t=1;
  for(;t+5<NT;t+=2){
    STEP(pB0,pB1,pA0,pA1,t,true,true,true);     WAIT_BAR(2); ROT();
    STEP(pA0,pA1,pB0,pB1,t+1,true,true,true);   WAIT_BAR(2); ROT();
  }
  #define ENDW(tt) do{ if((tt)+3<NT){WAIT_BAR(2);} else if((tt)+2<NT){WAIT_BAR(1);} else {WAIT_BAR(0);} }while(0)
  for(;t+1<NT;t+=2){
    STEP(pB0,pB1,pA0,pA1,t,(t+3<NT),(t+1<NT),(t+1<NT));       ENDW(t);   ROT();
    STEP(pA0,pA1,pB0,pB1,t+1,(t+4<NT),(t+2<NT),(t+2<NT));     ENDW(t+1); ROT();
  }
  STEP(pB0,pB1,pA0,pA1,NT-1,false,false,false);
  { float sacc=pB0[0]+pB0[1]; _Pragma("unroll") for(int r=2;r<16;++r)sacc+=pB0[r]; _Pragma("unroll") for(int r=0;r<16;++r)sacc+=pB1[r]; l_reg+=sacc;
    pw0=(u32x4){PKW(pB0,0),PKW(pB0,2),PKW(pB0,4),PKW(pB0,6)};pw1=(u32x4){PKW(pB0,8),PKW(pB0,10),PKW(pB0,12),PKW(pB0,14)};pw2=(u32x4){PKW(pB1,0),PKW(pB1,2),PKW(pB1,4),PKW(pB1,6)};pw3=(u32x4){PKW(pB1,8),PKW(pB1,10),PKW(pB1,12),PKW(pB1,14)};
    SBAR(); pv(o,vb0+sl_cur,PAF(0),PAF(1),PAF(2),PAF(3)); }
  #undef PKW
  #undef PAF
  #undef VFR
  #undef PIN
  #undef GAPA
  #undef GAPB
  #undef EX
  #undef VRD
  #undef KRD
  #undef STEP
  #undef ENDW
  {auto rr=__builtin_amdgcn_permlane32_swap(__float_as_uint(l_reg),__float_as_uint(l_reg),false,false);l_reg=__uint_as_float(rr[0])+__uint_as_float(rr[1]);}
  if(hi==0)wsf[32+r32]=l_reg;asm volatile("s_waitcnt lgkmcnt(0)":::"memory");
  float rli[16];
  #pragma unroll
  for(int r=0;r<16;++r)rli[r]=__builtin_amdgcn_rcpf(wsf[32+crow(r,hi)]);
  bf16*Ow=Ou+(long)(wid*QBLK)*OP; const bf16*Gw=Gu+(long)(wid*QBLK)*GP;
  { bf16*stg=(bf16*)(shm+LDS_OST)+wid*2048;
    #pragma unroll
    for(int r=0;r<16;++r){const int orow=crow(r,hi);
      #pragma unroll
      for(int d0=0;d0<2;++d0)stg[orow*64+d0*32+r32]=__float2bfloat16(o[d0][r]*rli[r]);}
    asm volatile("s_waitcnt lgkmcnt(0)":::"memory");
    #pragma unroll
    for(int i=0;i<4;++i){const int row=i*8+(lane>>3),ch=lane&7; const u32x4 v=*(const u32x4*)(stg+row*64+ch*8); const u32x4 gq=*(const u32x4*)(Gw+(long)row*GP+ch*8);
      u32x4 w;
      #pragma unroll
      for(int e=0;e<4;++e){ const float a0=bfbits2f((unsigned short)(v[e]&0xffffu))*bfbits2f((unsigned short)(gq[e]&0xffffu)), a1=bfbits2f((unsigned short)(v[e]>>16))*bfbits2f((unsigned short)(gq[e]>>16)); w[e]=cvtpk_s(a0,a1); }
      *(u32x4*)(Ow+(long)row*OP+ch*8)=w;} }
  asm volatile("s_waitcnt lgkmcnt(0)\n\ts_barrier":::"memory");
  #undef DMA_K
  #undef DMA_V
  #undef ROT
}
constexpr int ATTN_LDS_BYTES=LDS_BYTES;
#undef SBAR
#undef WAIT_BAR
}

__device__ __forceinline__ void p3a_fourier_s1(Frame& F) {
    using abf = attn_body::bf16;
    for (int v = F.vcu; v < 256; v += F.G) {
        fourier_s1_pair(F, v, v + 256);
        if (v < 16) fourier_ctx_item(F, v);
        else if (v < 64) {
            const int u = v - 16; const int b2 = u / 12, hq = u % 12, hk2 = hq / 3; const size_t row0 = (size_t)MLAT + (size_t)b2 * CTXL;
            const abf* Q0 = (const abf*)(F.ws + WS_Q0); const abf* KA = (const abf*)(F.ws + WS_KALL); const abf* VA = (const abf*)(F.ws + WS_VALL);
            __syncthreads();
            attn_body::attn_unit(Q0 + row0 * 768 + hq * 64, KA + (size_t)b2 * NKEYS * 256 + hk2 * 64, VA + (size_t)b2 * NKEYS * 256 + hk2 * 64, CTXL / 64,
                                 (abf*)(F.ws + WS_Y) + row0 * 1024 + hq * 64, (const abf*)(F.ws + WS_GA) + row0 * 768 + hq * 64, ((const float*)(F.ws + WS_MISCF))[0], (char*)(F.lds + RING_OFF));
        }
    }
}
__device__ __forceinline__ void p3_even_mixers(Frame& F) {
    using abf = attn_body::bf16;
    const abf* Q0 = (const abf*)(F.ws + WS_Q0); const abf* KA = (const abf*)(F.ws + WS_KALL); const abf* VA = (const abf*)(F.ws + WS_VALL);
    const abf* GA = (const abf*)(F.ws + WS_GA); abf* Y = (abf*)(F.ws + WS_Y);
    const float shift = ((const float*)(F.ws + WS_MISCF))[0];
    char* shm = (char*)(F.lds + RING_OFF);
    for (int v = F.vcu; v < 256; v += F.G) {
        for (int k = 0; k < 4; ++k) fourier_s2_item(F, v + 256 * k);
        const int pair = v >> 4, b = pair >> 2, hk = pair & 3;
        for (int i = 0; i < 6; ++i) {
            const int j = (v & 15) * 6 + i; const int hq = hk * 3 + (j >> 5), qb = j & 31;
            const size_t row0 = (size_t)b * SEQ + (size_t)qb * 256;
            attn_body::attn_unit(Q0 + row0 * 768 + hq * 64, KA + (size_t)b * NKEYS * 256 + hk * 64, VA + (size_t)b * NKEYS * 256 + hk * 64, NKEYS / 64,
                                 Y + row0 * 1024 + hq * 64, GA + row0 * 768 + hq * 64, shift, shm);
        }
    }
}

__device__ __forceinline__ int chain_slot(int dir, int step) { return dir == 0 ? step : (step == 0 ? 1 : (step == 1 ? 0 : 67 - step)); }

typedef short s16x4 __attribute__((ext_vector_type(4)));
__device__ __forceinline__ void p7_mlstm_prep(Frame& F) {
    LAS unsigned char* L = F.lds + RING_OFF;
    LAS float* msh = (LAS float*)(F.lds + RING_BYTES + 1024);
    int lane = F.lane, w = F.wave; asm volatile("" : "+v"(lane), "+s"(w));
    const int tid = w * 64 + lane;
    const float* TOT = (const float*)(F.ws + WS_TOT); const float* AMAX = (const float*)(F.ws + WS_AMAX);
    float totA = 0.f, amxA = 0.f, totB = 0.f, amxB = 0.f, aval = 0.f; v4u qn[8], kn[8];
#define P7_LOAD(ITX) do { const int itx_ = (ITX); const int bh_ = itx_ >> 6, slot_ = 2 + (itx_ & 63); const size_t it_ = (size_t)(bh_ * NSLOT + slot_); \
        if (w < 2) { const int cd_ = w * 16 + bh_; const int sA_ = chain_slot(w, lane), sB_ = chain_slot(w, 64 + (lane & 1)); \
            totA = TOT[cd_ * NSLOT + sA_]; amxA = AMAX[cd_ * NSLOT + sA_]; totB = TOT[cd_ * NSLOT + sB_]; amxB = AMAX[cd_ * NSLOT + sB_]; } \
        if (tid >= 256) { const int dir_ = (tid - 256) >> 7, s2_ = tid & 127, cd_ = dir_ * 16 + bh_; aval = ((const float*)(F.ws + WS_AA))[((size_t)cd_ * NSLOT + slot_) * 128 + s2_]; } \
        const bf16* kb_ = (const bf16*)(F.ws + WS_KB) + it_ * 32768; const bf16* qb_ = (const bf16*)(F.ws + WS_QB) + it_ * 32768; \
        _Pragma("unroll") for (int ks = 0; ks < 8; ++ks) qn[ks] = *(const GAS v4u*)(qb_ + ((w * 8 + ks) * 64 + lane) * 8); \
        _Pragma("unroll") for (int i = 0; i < 8; ++i) kn[i] = *(const GAS v4u*)(kb_ + (size_t)(tid + 512 * i) * 8); } while (0)
    if (F.vcu < 1024) P7_LOAD(F.vcu);
    for (int itx = F.vcu; itx < 1024; itx += F.G) {
        const int bh = itx >> 6, slot = 2 + (itx & 63);
        __syncthreads();
        v4u qf[8];
#pragma unroll
        for (int ks = 0; ks < 8; ++ks) qf[ks] = qn[ks];
        {
          if (w < 2) {
              const int dir = w;
              const int pos = (dir == 0) ? slot : (slot == 1 ? 0 : (slot == 0 ? 1 : 67 - slot));
              float A = totA, B = amxA + totA;
#pragma unroll
              for (int d = 1; d < 64; d <<= 1) { const float Ap = __shfl_up(A, d), Bp = __shfl_up(B, d); if (lane >= d) { B = fmaxf(Bp + A, B); A = Ap + A; } }
              float m = 0.f;
              if (pos >= 1) { const int pl = (pos - 1 < 63) ? (pos - 1) : 63;
                  float Am = __builtin_bit_cast(float, __builtin_amdgcn_readlane(__builtin_bit_cast(int, A), pl)), Bm = __builtin_bit_cast(float, __builtin_amdgcn_readlane(__builtin_bit_cast(int, B), pl));
                  if (pos == 65) { const float t64 = __builtin_bit_cast(float, __builtin_amdgcn_readlane(__builtin_bit_cast(int, totB), 0)), x64 = __builtin_bit_cast(float, __builtin_amdgcn_readlane(__builtin_bit_cast(int, amxB), 0));
                      Bm = fmaxf(Bm + t64, x64 + t64); Am = Am + t64; }
                  m = fmaxf(Am, Bm); }
              if (lane == 0) msh[dir] = m;
          }
          if (tid >= 256) msh[512 + ((tid - 256) >> 7) * 128 + (tid & 127)] = aval;
#pragma unroll
          for (int i = 0; i < 8; ++i) *(LAS v4u*)(L + (tid + 512 * i) * 16) = kn[i]; }
        __syncthreads();
        if (itx + F.G < 1024) P7_LOAD(itx + F.G);
        {
            const int chunk = slot - 2; const int c = lane & 15, g4 = lane >> 4;
            const int tl = 16 * w + c;
            const LAS unsigned char* kl = L + ((c & 3) >> 1) * 256 + (4 * g4 + (c >> 2)) * 16 + 8 * (c & 1);
            float Mt[2];
#pragma unroll
            for (int dir = 0; dir < 2; ++dir) { const int cd = dir * 16 + bh; Mt[dir] = fmaxf(msh[dir], ((const float*)(F.ws + WS_PM))[((size_t)cd * NSLOT + slot) * 128 + tl]); }
#pragma unroll 2
            for (int nt = 0; nt < 8; ++nt) {
                f32x4 acc = {0.f, 0.f, 0.f, 0.f};
                const LAS unsigned char* kn = kl + (nt >> 1) * 1024 + (nt & 1) * 512;
#pragma unroll
                for (int ks = 0; ks < 8; ++ks) {
                    const s16x4 t0 = __builtin_amdgcn_ds_read_tr16_b64_v4i16((LAS s16x4*)(kn + ks * 8192)), t1 = __builtin_amdgcn_ds_read_tr16_b64_v4i16((LAS s16x4*)(kn + ks * 8192 + 4096));
                    const bf16x8 kf = __builtin_shufflevector(t0, t1, 0, 1, 2, 3, 4, 5, 6, 7);
                    acc = __builtin_amdgcn_mfma_f32_16x16x32_bf16(kf, __builtin_bit_cast(bf16x8, qf[ks]), acc, 0, 0, 0); }
                const int s0 = 16 * nt + 4 * g4;
#pragma unroll
                for (int dir = 0; dir < 2; ++dir) { const int cd = dir * 16 + bh;
                    if (dir == 0 ? ((nt >> 1) > (w >> 1)) : ((nt >> 1) < (w >> 1))) continue;
                    const f32x4 a4 = *(const LAS f32x4*)(msh + 512 + dir * 128 + s0);
                    float v[4];
#pragma unroll
                    for (int r = 0; r < 4; ++r) { const int s2 = s0 + r; const bool on = dir ? (s2 >= tl) : (s2 <= tl); v[r] = on ? acc[r] * __expf(a4[r] - Mt[dir]) : 0.f; }
                    unsigned long long pk8 = (unsigned long long)pk2(v[0], v[1]) | ((unsigned long long)pk2(v[2], v[3]) << 32);
                    unsigned long long* so = (unsigned long long*)((bf16*)(F.ws + WS_S) + ((size_t)(dir * 16 + bh) * 64 + chunk) * 16384);
                    so[(((w * 4 + (nt >> 1)) * 64 + (2 * (nt & 1) + (g4 >> 1)) * 16 + c) * 2) + (g4 & 1)] = pk8; }
            }
        }
    }
#undef P7_LOAD
}

__device__ __forceinline__ void p8_mlstm_scan(Frame& F) {
    LAS unsigned char* CB0 = F.lds + RING_OFF;
    LAS unsigned char* OST = F.lds + RING_OFF + 49152;
    LAS unsigned char* VL = F.lds + RING_OFF + 61440;
    LAS float* msh = (LAS float*)(F.lds + RING_BYTES + 1024);
    int lane = F.lane, w = F.wave; asm volatile("" : "+v"(lane), "+s"(w));
    const int c = lane & 15, g4 = lane >> 4, tid = w * 64 + lane;
    const float* TOT = (const float*)(F.ws + WS_TOT); const float* AMAX = (const float*)(F.ws + WS_AMAX);
    for (int v = F.vcu; v < 256; v += F.G) {
        const int sl = v & 7, cd = v >> 3, dir = cd >> 4, bh = cd & 15, b = bh >> 2, h = bh & 3;
        __syncthreads();
        if (tid < NSLOT) { msh[256 + tid] = TOT[cd * NSLOT + tid]; msh[384 + tid] = AMAX[cd * NSLOT + tid]; }
        __syncthreads();
        if (tid == 0) { float m = 0.f; for (int st = 0; st < NSLOT; ++st) { const int s = chain_slot(dir, st); msh[s] = m; const float M = fmaxf(m, msh[384 + s]); msh[128 + s] = M; m = msh[256 + s] + M; } }
        __syncthreads();
        f32x4 C[2][3];
#pragma unroll
        for (int mt = 0; mt < 2; ++mt)
#pragma unroll
            for (int nt = 0; nt < 3; ++nt) C[mt][nt] = (f32x4){0.f, 0.f, 0.f, 0.f};
        bf16* Hout = (bf16*)(F.ws + (dir ? WS_HB : WS_HF));
        const int pnt = tid >> 8, pks = (tid >> 6) & 3, pc = tid & 15, pkg = (tid >> 4) & 3;
        v4u stg_v; float stg_a = 0.f;
        LAS float* wtab = (LAS float*)(F.lds + RING_BYTES + 4096);
#define P8_STAGE_LOAD(ST) do { const int slot_ = chain_slot(dir, (ST)); const size_t it_ = (size_t)bh * NSLOT + slot_; \
            stg_v = *(const GAS v4u*)((const bf16*)(F.ws + WS_VB) + it_ * 32768 + (size_t)sl * 4096 + tid * 8); \
            } while (0)
#define P8_A_LOAD(ST) do { if (tid < 128 && (ST) < NSLOT) stg_a = ((const float*)(F.ws + WS_AA))[((size_t)cd * NSLOT + chain_slot(dir, (ST))) * 128 + tid]; } while (0)
#define P8_W_WRITE(ST) do { if (tid < 128) wtab[((ST) & 1) * 128 + tid] = __expf(stg_a - msh[128 + chain_slot(dir, (ST))]); } while (0)
#define P8_STAGE_WRITE(ST) do { \
            LAS unsigned char* vb_ = VL + ((ST) & 1) * 20480; float wv_[8]; \
            { const LAS float* wt_ = wtab + ((ST) & 1) * 128 + 32 * pks + 8 * pkg; const f32x4 w0_ = *(const LAS f32x4*)wt_, w1_ = *(const LAS f32x4*)(wt_ + 4); \
              _Pragma("unroll") for (int j = 0; j < 4; ++j) { wv_[j] = w0_[j]; wv_[4 + j] = w1_[j]; } } \
            v4u sc_; _Pragma("unroll") for (int e = 0; e < 4; ++e) { const float lo_ = __builtin_bit_cast(float, stg_v[e] << 16) * wv_[2 * e], hi_ = __builtin_bit_cast(float, stg_v[e] & 0xffff0000u) * wv_[2 * e + 1]; sc_[e] = pk2(lo_, hi_); } \
            *(LAS v4u*)(vb_ + tid * 16) = stg_v; *(LAS v4u*)(vb_ + 8192 + tid * 16) = sc_; \
            if (pnt == 0) { v4u wf_; wf_.x = (pc == 0) ? pk2(wv_[0], wv_[1]) : 0u; wf_.y = (pc == 0) ? pk2(wv_[2], wv_[3]) : 0u; wf_.z = (pc == 0) ? pk2(wv_[4], wv_[5]) : 0u; wf_.w = (pc == 0) ? pk2(wv_[6], wv_[7]) : 0u; \
                *(LAS v4u*)(vb_ + 16384 + (tid & 255) * 16) = wf_; } } while (0)
        v4u qf[8]; bf16x8 sf[4];
        const int kslo = dir ? (w >> 1) : 0, kshi = dir ? 3 : (w >> 1);
#define P8_Q_LOAD(ST) do { const int slot_ = chain_slot(dir, (ST)); const size_t it_ = (size_t)bh * NSLOT + slot_; \
            const bf16* qfr_ = (const bf16*)(F.ws + WS_QB) + it_ * 32768 + (size_t)w * 4096 + lane * 8; \
            _Pragma("unroll") for (int ks = 0; ks < 8; ++ks) qf[ks] = *(const GAS v4u*)(qfr_ + ks * 512); } while (0)
#define P8_S_LOAD(ST) do { const int slot_ = chain_slot(dir, (ST)); \
            const bf16* Sfr_ = (const bf16*)(F.ws + WS_S) + ((size_t)(dir * 16 + bh) * 64 + (slot_ - 2)) * 16384 + (size_t)w * 2048 + lane * 8; \
            _Pragma("unroll") for (int ks = 0; ks < 4; ++ks) if (ks >= kslo && ks <= kshi) sf[ks] = *(const bf16x8*)(Sfr_ + ks * 512); } while (0)
        P8_A_LOAD(0); P8_STAGE_LOAD(0); P8_W_WRITE(0); P8_A_LOAD(1); __syncthreads(); P8_STAGE_WRITE(0);
        __syncthreads();
        for (int st = 0; st < NSLOT; ++st) {
            const int slot = chain_slot(dir, st); const size_t it = (size_t)bh * NSLOT + slot;
            const bf16* kT = (const bf16*)(F.ws + WS_KB) + it * 32768;
            const float* cumv = (const float*)(F.ws + WS_CUM) + ((size_t)cd * NSLOT + slot) * 128; const float* pmv = (const float*)(F.ws + WS_PM) + ((size_t)cd * NSLOT + slot) * 128;
            const float m_in = msh[slot]; const float M = msh[128 + slot]; const float decay = __expf(m_in - M);
            LAS unsigned char* vb = VL + (st & 1) * 20480; LAS unsigned char* CB = CB0 + (st & 1) * 24576;
            f32x4 p4 = {0.f, 0.f, 0.f, 0.f}, c4 = {0.f, 0.f, 0.f, 0.f};
            if (st >= 2) { p4 = *(const f32x4*)(pmv + 16 * w + 4 * g4); c4 = *(const f32x4*)(cumv + 16 * w + 4 * g4); }
            bf16x8 kf[2][4];
#pragma unroll
            for (int mt = 0; mt < 2; ++mt)
#pragma unroll
                for (int ks = 0; ks < 4; ++ks) kf[mt][ks] = *(const bf16x8*)(kT + (size_t)((w * 2 + mt) * 4 + ks) * 512 + lane * 8);
            if (st + 1 < NSLOT) { P8_W_WRITE(st + 1); P8_STAGE_LOAD(st + 1); }
            P8_A_LOAD(st + 2);
            if (st < 2) __syncthreads();
            if (st >= 2) {
                const int chunk = slot - 2;
#pragma unroll
                for (int nt = 0; nt < 3; ++nt) { v4u f; f.x = pk2m(C[0][nt][0], C[0][nt][1]); f.y = pk2m(C[0][nt][2], C[0][nt][3]); f.z = pk2m(C[1][nt][0], C[1][nt][1]); f.w = pk2m(C[1][nt][2], C[1][nt][3]);
                    *(LAS v4u*)(CB + ((w * 3 + nt) * 64 + lane) * 16) = f; }
                __syncthreads();
                f32x4 acc[3] = {{0.f, 0.f, 0.f, 0.f}, {0.f, 0.f, 0.f, 0.f}, {0.f, 0.f, 0.f, 0.f}};
                {
                    bf16x8 cbf[3][3];
#pragma unroll
                    for (int pk = 0; pk < 2; ++pk)
#pragma unroll
                        for (int nt = 0; nt < 3; ++nt) cbf[pk][nt] = *(const LAS bf16x8*)(CB + ((pk * 3 + nt) * 64 + lane) * 16);
#pragma unroll
                    for (int ks = 0; ks < 8; ++ks) { const bf16x8 qa = __builtin_bit_cast(bf16x8, qf[ks]);
                        if (ks + 2 < 8) {
#pragma unroll
                            for (int nt = 0; nt < 3; ++nt) cbf[(ks + 2) % 3][nt] = *(const LAS bf16x8*)(CB + (((ks + 2) * 3 + nt) * 64 + lane) * 16); }
#pragma unroll
                        for (int nt = 0; nt < 3; ++nt) acc[nt] = __builtin_amdgcn_mfma_f32_16x16x32_bf16(qa, cbf[ks % 3][nt], acc[nt], 0, 0, 0);
                        __builtin_amdgcn_sched_barrier(0);
                    }
                }
                if (st + 1 < NSLOT) P8_Q_LOAD(st + 1);
                float Mt[4], iw[4];
#pragma unroll
                for (int r = 0; r < 4; ++r) { Mt[r] = fmaxf(m_in, p4[r]); iw[r] = __expf(m_in - Mt[r]); }
#pragma unroll
                for (int nt = 0; nt < 3; ++nt)
#pragma unroll
                    for (int r = 0; r < 4; ++r) acc[nt][r] *= iw[r];
                const bf16x8 ones = (c == 0) ? (bf16x8){0x3F80, 0x3F80, 0x3F80, 0x3F80, 0x3F80, 0x3F80, 0x3F80, 0x3F80} : (bf16x8){0, 0, 0, 0, 0, 0, 0, 0};
#pragma unroll
                for (int ks = 0; ks < 4; ++ks) if (ks >= kslo && ks <= kshi) {
                    const bf16x8 v0 = *(const LAS bf16x8*)(vb + ((0 * 4 + ks) * 64 + lane) * 16), v1 = *(const LAS bf16x8*)(vb + ((1 * 4 + ks) * 64 + lane) * 16);
                    acc[0] = __builtin_amdgcn_mfma_f32_16x16x32_bf16(sf[ks], v0, acc[0], 0, 0, 0);
                    acc[1] = __builtin_amdgcn_mfma_f32_16x16x32_bf16(sf[ks], v1, acc[1], 0, 0, 0);
                    acc[2] = __builtin_amdgcn_mfma_f32_16x16x32_bf16(sf[ks], ones, acc[2], 0, 0, 0); }
                if (st + 1 < NSLOT) P8_S_LOAD(st + 1);
                {
                    LAS unsigned short* ost = (LAS unsigned short*)(OST + w * 1280);
#pragma unroll
                    for (int r = 0; r < 4; ++r) { const float den = __shfl(acc[2][r], g4 * 16); const float dn = fmaxf(fabsf(den), __expf(-c4[r] - Mt[r])); const float inv = __builtin_amdgcn_rcpf(dn);
                        const unsigned pr = pk2(acc[0][r] * inv, acc[1][r] * inv);
                        ost[(4 * g4 + r) * 40 + c] = (unsigned short)(pr & 0xffffu); ost[(4 * g4 + r) * 40 + 16 + c] = (unsigned short)(pr >> 16); }
                    asm volatile("s_waitcnt lgkmcnt(0)" ::: "memory");
                    const int orow = lane >> 2, och = lane & 3;
                    const v4u ov = *(const LAS v4u*)(OST + w * 1280 + orow * 80 + och * 16);
                    *(GAS v4u*)(Hout + ((size_t)b * SEQ + (size_t)chunk * 128 + 16 * w + orow) * 1024 + h * 256 + 32 * sl + 8 * och) = ov;
                }
            }
            if (st == 1) { P8_Q_LOAD(2); P8_S_LOAD(2); }
#pragma unroll
            for (int mt = 0; mt < 2; ++mt)
#pragma unroll
                for (int nt = 0; nt < 3; ++nt) C[mt][nt] = C[mt][nt] * decay;
#pragma unroll
            for (int ks = 0; ks < 4; ++ks) {
                const bf16x8 b0 = *(const LAS bf16x8*)(vb + 8192 + ((0 * 4 + ks) * 64 + lane) * 16), b1 = *(const LAS bf16x8*)(vb + 8192 + ((1 * 4 + ks) * 64 + lane) * 16), b2 = *(const LAS bf16x8*)(vb + 16384 + (ks * 64 + lane) * 16);
#pragma unroll
                for (int mt = 0; mt < 2; ++mt) { C[mt][0] = __builtin_amdgcn_mfma_f32_16x16x32_bf16(kf[mt][ks], b0, C[mt][0], 0, 0, 0); C[mt][1] = __builtin_amdgcn_mfma_f32_16x16x32_bf16(kf[mt][ks], b1, C[mt][1], 0, 0, 0);
                    C[mt][2] = __builtin_amdgcn_mfma_f32_16x16x32_bf16(kf[mt][ks], b2, C[mt][2], 0, 0, 0); }
            }
            if (st + 1 < NSLOT) P8_STAGE_WRITE(st + 1);
            if (st < 2) __syncthreads();
        }
#undef P8_STAGE_LOAD
#undef P8_STAGE_WRITE
#undef P8_W_WRITE
#undef P8_A_LOAD
#undef P8_Q_LOAD
#undef P8_S_LOAD
    }
}

__device__ __forceinline__ void p9_mlstm_merge(Frame& F) {
    const GAS v4u* og = (const GAS v4u*)(F.ws + WS_OG); const GAS v4u* hf = (const GAS v4u*)(F.ws + WS_HF); const GAS v4u* hb = (const GAS v4u*)(F.ws + WS_HB); GAS v4u* y = (GAS v4u*)(F.ws + WS_YMIX);
    const size_t n16 = (size_t)MLAT * 1024 * 2 / 16; const size_t g0 = (size_t)(F.vcu * NWAVES * 64 + F.tid), gs = (size_t)F.G * NWAVES * 64;
    for (size_t i = g0; i < n16; i += gs) { const v4u a = og[i], p = hf[i], q = hb[i]; v4u o;
#pragma unroll
        for (int e = 0; e < 4; ++e) { const float lo = __builtin_bit_cast(float, a[e] << 16) * (__builtin_bit_cast(float, p[e] << 16) + __builtin_bit_cast(float, q[e] << 16));
            const float hi2 = __builtin_bit_cast(float, a[e] & 0xffff0000u) * (__builtin_bit_cast(float, p[e] & 0xffff0000u) + __builtin_bit_cast(float, q[e] & 0xffff0000u)); o[e] = pk2(lo, hi2); }
        y[i] = o; }
}

constexpr int N_PHASES = 12;
#ifndef MK_N_LAUNCHES
#define MK_N_LAUNCHES 1
#endif
struct Args { const float* in[17]; float* out; unsigned char* ws; int ph_lo, ph_hi, li, pad; };
__global__ void __launch_bounds__(NWAVES * 64, 2) hyb_fwd(Args args) {
    extern __shared__ __attribute__((aligned(16))) unsigned char lds[];
    Frame F;
    F.lds = (LAS unsigned char*)lds;
    F.MISC = (volatile LAS unsigned*)(F.lds + MISC_OFF);
    F.tid = threadIdx.x; F.lane = F.tid & 63; F.wave = __builtin_amdgcn_readfirstlane(F.tid >> 6);
    F.G = gridDim.x; { const int bx = blockIdx.x; F.vcu = (F.G % 8 == 0) ? (bx % 8) * (F.G / 8) + bx / 8 : bx; }
    F.ws = args.ws; F.ctl = (gu32*)(args.ws + WS_CTL);
    F.x = args.in[0]; F.c = args.in[1]; F.ctx = args.in[2]; F.c_ctx = args.in[3]; F.ada_w = args.in[4]; F.ada_b = args.in[5]; F.pgain = args.in[6]; F.pbias = args.in[7];
    F.w0 = args.in[8]; F.qgain = args.in[9]; F.kgain = args.in[10]; F.fgain = args.in[11]; F.wfmix = args.in[12]; F.wo0 = args.in[13]; F.w1 = args.in[14]; F.gbias = args.in[15]; F.wo1 = args.in[16];
    F.out = args.out;
    for (int u = F.tid; u < (LDS_BYTES - LDSCTL_OFF) / 4; u += NWAVES * 64) ((LAS unsigned*)(F.lds + LDSCTL_OFF))[u] = 0u;
    __syncthreads();
    XcdBarrier bar = xcd_barrier_post((unsigned*)(F.ctl + CW_BAR) + args.li * XCD_BAR_WORDS, F.MISC + 8);
    const int lo = args.ph_lo, hi = args.ph_hi;
#define IN(k) (lo <= (k) && (k) < hi)
#define SEAM(k) do { if (IN(k) && IN((k) + 1)) xcd_barrier(bar); } while (0)
    unsigned char* ws = args.ws;
    const float* mod = (const float*)(ws + WS_MOD);

    if (IN(0)) { p0_tables(F); } SEAM(0);
    if (IN(1)) { p1_h0_rows(F); } SEAM(1);
    if (IN(2)) {
        pg8::Gemm g{(const pg8::bf16_t*)(ws + WS_H), (const pg8::bf16_t*)(ws + WS_W0T), MTOT, EVEN_N, 1024}; pg8::StaticOrder S; S.init(MTOT, EVEN_N, F.G, (int)blockIdx.x);
        epi::EpiEven E{(pg8::bf16_t*)(ws + WS_Q0),
                       F.qgain, F.kgain, F.fgain, (const float*)(ws + WS_ROPE)};
        pg8::gemm_phase<epi::EpiEven, pg8::StaticOrder, true, true>(F.lds + RING_OFF, g, S, E);
    } SEAM(2);
    if (IN(3)) { p3a_fourier_s1(F); xcd_barrier(bar);
        p3_even_mixers(F);
    } SEAM(3);
    if (IN(4)) {
        pg8::Gemm g{(const pg8::bf16_t*)(ws + WS_Y), (const pg8::bf16_t*)(ws + WS_WO0T), MTOT, 1024, 1024}; pg8::StaticOrder S; S.init(MTOT, 1024, F.G, (int)blockIdx.x);
        epi::EpiGate E{(pg8::bf16_t*)(ws + WS_GY), mod};
        pg8::gemm_phase<epi::EpiGate, pg8::StaticOrder, true, true>(F.lds + RING_OFF, g, S, E);
    } SEAM(4);
    if (IN(5)) { p5_rowpass(F); } SEAM(5);
    if (IN(6)) {
        gate_scans(F);
        pg8::Gemm g{(const pg8::bf16_t*)(ws + WS_H), (const pg8::bf16_t*)(ws + WS_W1T), MTOT, ODD_N, 1024}; pg8::StaticOrder S; S.init(MTOT, ODD_N, F.G, (int)blockIdx.x);
        epi::EpiOdd E{(pg8::bf16_t*)(ws + WS_QB), (pg8::bf16_t*)(ws + WS_OG)};
        pg8::gemm_phase<epi::EpiOdd, pg8::StaticOrder, true, true>(F.lds + RING_OFF, g, S, E);
    } SEAM(6);
    if (IN(7)) { p7_mlstm_prep(F); } SEAM(7);
    if (IN(8)) { p8_mlstm_scan(F);
    } SEAM(8);
    if (IN(9)) { p9_mlstm_merge(F); } SEAM(9);
    if (IN(10)) {
        pg8::Gemm g{(const pg8::bf16_t*)(ws + WS_YMIX), (const pg8::bf16_t*)(ws + WS_WO1T), MLAT, 1024, 1024}; pg8::StaticOrder S; S.init(MLAT, 1024, F.G, (int)blockIdx.x);
        epi::EpiGate E{(pg8::bf16_t*)(ws + WS_GY), mod + 5 * 3072};
        pg8::gemm_phase<epi::EpiGate, pg8::StaticOrder, true, true>(F.lds + RING_OFF, g, S, E);
    } SEAM(10);
    if (IN(11)) { p11_final_ln(F); }
#undef IN
#undef SEAM
}

extern "C" void kernel_launch(void* const* d_in, const int* in_sizes, int n_in, void* d_out, int out_size, void* d_ws, size_t ws_size, hipStream_t stream) {
    static int grid = 0;
    if (grid == 0) {
        if (n_in != 17 || in_sizes[0] != MLAT * 1024 || out_size != MLAT * 1024 || ws_size < WS_END) {
            fprintf(stderr, "kernel_launch: unexpected problem (n_in %d, in0 %d, out %d, ws %zu; need ws >= %zu); nothing launched\n", n_in, n_in > 0 ? in_sizes[0] : -1, out_size, ws_size, (size_t)WS_END); grid = -1; return; }
        int dev = 0, cus = 0, per_cu = 0;
        if (hipGetDevice(&dev) != hipSuccess || hipDeviceGetAttribute(&cus, hipDeviceAttributeMultiprocessorCount, dev) != hipSuccess) { fprintf(stderr, "kernel_launch: device query failed\n"); grid = -1; return; }
        if (hipFuncSetAttribute((const void*)hyb_fwd, hipFuncAttributeMaxDynamicSharedMemorySize, LDS_BYTES) != hipSuccess) { fprintf(stderr, "kernel_launch: hipFuncSetAttribute failed\n"); grid = -1; return; }
        if (hipOccupancyMaxActiveBlocksPerMultiprocessor(&per_cu, (const void*)hyb_fwd, NWAVES * 64, LDS_BYTES) != hipSuccess || per_cu < 1)
            fprintf(stderr, "kernel_launch: note: occupancy query reports %d workgroups per CU\n", per_cu);
        (void)hipGetLastError();
        grid = cus;
    }
    if (grid < 0) return;
    if (hipMemsetAsync((char*)d_ws + WS_CTL, 0, CTL_ZERO_BYTES, stream) != hipSuccess) { fprintf(stderr, "kernel_launch: hipMemsetAsync failed\n"); return; }
    Args a{};
    for (int i = 0; i < 17; ++i) a.in[i] = (const float*)d_in[i];
    a.out = (float*)d_out; a.ws = (unsigned char*)d_ws;
    constexpr int NL = MK_N_LAUNCHES;
    static_assert(NL == 1 || NL == N_PHASES, "MK_N_LAUNCHES: 1 (one launch) or 12 (one launch per phase)");
    for (int li = 0; li < NL; ++li) {
        a.ph_lo = (NL == 1) ? 0 : li; a.ph_hi = (NL == 1) ? N_PHASES : li + 1; a.li = (NL == 1) ? 0 : 1 + li;
        hipLaunchKernelGGL(hyb_fwd, dim3(grid), dim3(NWAVES * 64), LDS_BYTES, stream, a);
        const hipError_t le = hipPeekAtLastError();
        if (le != hipSuccess) { fprintf(stderr, "kernel_launch: launch %d failed: %s\n", li, hipGetErrorName(le)); break; }
    }
}
```

```cpp
#include <hip/hip_runtime.h>
#include <hip/hip_bf16.h>
#include <cstdio>
#include <cstdint>
#include <cmath>
namespace pg8 {
#define PG8_LAS __attribute__((address_space(3)))
typedef unsigned short bf16_t;
typedef short bf16x8 __attribute__((ext_vector_type(8)));
typedef float f32x4 __attribute__((ext_vector_type(4)));
typedef unsigned u32x4 __attribute__((ext_vector_type(4)));
constexpr int BM = 256, BK = 64, HALF = 128, HTB = HALF * BK * 2  , STAGE_BYTES = 8 * HTB, NXCD = 8, WGM = 8;

__host__ __device__ __forceinline__ int lds_byte(int r, int c) { const int st = (r >> 4) * 2 + (c >> 5), rr = r & 15, cc = c & 31, ob = rr * 64 + cc * 2; return st * 1024 + (ob ^ (((ob >> 9) & 1) << 5)); }
__host__ __device__ __forceinline__ void stage_rc(int b, int& R, int& C) { const int st = b / 1024, sb = b % 1024, swz = sb ^ (((sb >> 9) & 1) << 5); R = (st >> 1) * 16 + swz / 64; C = (st & 1) * 32 + (swz % 64) / 2; }
__host__ __device__ __forceinline__ int perm32(int rho) { const int n = rho >> 4, i = rho & 15; return 8 * (i >> 2) + 4 * n + (i & 3); }

struct Unit { int pm, pn; };
struct Gemm { const bf16_t* A; const bf16_t* Bt; int M, N, K; };

struct StaticOrder {
    int nM, nN, nwg, G, c;
    __host__ __device__ void init(int M, int N, int G_, int c_) { nM = M / BM; nN = N / BM; nwg = nM * nN; G = G_; c = c_; }
    __host__ __device__ bool next(int i, Unit& u) const {
        const long L = (long)i * G + c; if (L >= nwg) return false;
        int wgid = (int)L; { const int q = nwg / NXCD, r = nwg % NXCD, xcd = wgid % NXCD, off = wgid / NXCD; wgid = (xcd < r ? xcd * (q + 1) : r * (q + 1) + (xcd - r) * q) + off; }
        const int nig = WGM * nN, gid = wgid / nig, fm = gid * WGM, gsz = (nM - fm) < WGM ? (nM - fm) : WGM;
        u.pm = fm + ((wgid % nig) % gsz); u.pn = (wgid % nig) / gsz; return true;
    }
    __device__ __forceinline__ void a_ready(const Unit&) const {}
    __device__ __forceinline__ void done(const Unit&) const {}
};


typedef float cvf2_t __attribute__((ext_vector_type(2))); typedef __bf16 cvb2_t __attribute__((ext_vector_type(2)));
__device__ __forceinline__ unsigned cvt_pk_bf16(float lo, float hi) { const cvf2_t v = {lo, hi}; return __builtin_bit_cast(unsigned, __builtin_convertvector(v, cvb2_t)); }
template <class Epi> __device__ __forceinline__ const char* unit_a(const Gemm& g, const Epi& E, const Unit& u, size_t tstep) {
    if constexpr (Epi::SWAP_AB) { if (E.swap_ab(u)) return (const char*)g.Bt + (size_t)u.pn * tstep; }
    return (const char*)g.A + (size_t)u.pm * tstep; }
template <class Epi> __device__ __forceinline__ const char* unit_b(const Gemm& g, const Epi& E, const Unit& u, size_t tstep) {
    if constexpr (Epi::SWAP_AB) { if (E.swap_ab(u)) return (const char*)g.A + (size_t)u.pm * tstep; }
    return (const char*)g.Bt + (size_t)u.pn * tstep; }
template <class Epi, class Sched, bool ALIGN_EPI = false, bool SP2 = false>
__device__ __forceinline__ void gemm_phase(PG8_LAS unsigned char* lds, const Gemm g, const Sched& S, const Epi& E) {
    const int tid = threadIdx.x, wid = __builtin_amdgcn_readfirstlane(tid >> 6), lane = tid & 63, wr = wid >> 2, wc = wid & 3, fr = lane & 15, fq = lane >> 4;
    const int K = g.K, nt = K / BK;
    unsigned voffA[2], voffB[2];
#pragma unroll
    for (int i = 0; i < 2; ++i) { int R, C; stage_rc(tid * 16 + i * 8192, R, C); const int Rb = Epi::PERM ? ((R & ~31) + perm32(R & 31)) : R;
        voffA[i] = (unsigned)(R * K + C) * 2u; voffB[i] = (unsigned)(Rb * K + C) * 2u; }
    const size_t kstep = (size_t)(BK * 2);
    const size_t hstep = (size_t)HALF * K * 2;
    const size_t tstep = 2 * hstep;
    const unsigned ldsw = (unsigned)wid * 1024u;
    const int aoff = lds_byte(wr * 64 + fr, fq * 8), boff = lds_byte(wc * 32 + fr, fq * 8);
#define PG8_SA(b, h) (((b) * 2 + (h)) * HTB)
#define PG8_SB(b, h) ((4 + (b) * 2 + (h)) * HTB)
#define PG8_STAGE(bufoff, gbase, voff) do { _Pragma("unroll") for (int _i = 0; _i < 2; ++_i) \
        __builtin_amdgcn_global_load_lds((const unsigned*)((const char*)(gbase) + (voff)[_i]), (PG8_LAS unsigned*)(lds + (bufoff) + ldsw + _i * 8192), 16, 0, 0); } while (0)
#define PG8_LDA(dst, b, h) do { _Pragma("unroll") for (int m = 0; m < 4; ++m) _Pragma("unroll") for (int k = 0; k < 2; ++k) dst[m][k] = *(const PG8_LAS bf16x8*)(lds + PG8_SA(b, h) + aoff + m * 2048 + k * 1024); } while (0)
#define PG8_LDB(dst, b, h) do { _Pragma("unroll") for (int n = 0; n < 2; ++n) _Pragma("unroll") for (int k = 0; k < 2; ++k) dst[n][k] = *(const PG8_LAS bf16x8*)(lds + PG8_SB(b, h) + boff + n * 2048 + k * 1024); } while (0)
#define PG8_MMA(ai, bj, At, Bt) do { __builtin_amdgcn_s_setprio(1); _Pragma("unroll") for (int m = 0; m < 4; ++m) _Pragma("unroll") for (int n = 0; n < 2; ++n) _Pragma("unroll") for (int k = 0; k < 2; ++k) \
        acc[ai][bj][m][n] = __builtin_amdgcn_mfma_f32_16x16x32_bf16(Bt[n][k], At[m][k], acc[ai][bj][m][n], 0, 0, 0); __builtin_amdgcn_s_setprio(0); } while (0)
#define PG8_WAIT_V(n) asm volatile("s_waitcnt vmcnt(" #n ")" ::: "memory")
#define PG8_WAIT_L(n) asm volatile("s_waitcnt lgkmcnt(" #n ")" ::: "memory")
#define PG8_BAR __builtin_amdgcn_s_barrier()
#define PG8_SCHED __builtin_amdgcn_sched_barrier(0)
    Unit cur, nxt; int ui = 0;
    if (!S.next(0, cur)) return;
    f32x4 acc[2][2][4][2];
#pragma unroll
    for (int a = 0; a < 2; ++a)
#pragma unroll
        for (int b = 0; b < 2; ++b)
#pragma unroll
            for (int m = 0; m < 4; ++m)
#pragma unroll
                for (int n = 0; n < 2; ++n) acc[a][b][m][n] = (f32x4){0.f, 0.f, 0.f, 0.f};
    bf16x8 At[4][2], B0[2][2], B1[2][2];
    const char* cA = unit_a(g, E, cur, tstep); const char* cB = unit_b(g, E, cur, tstep);
    S.a_ready(cur);
    if constexpr (SP2) {
        PG8_STAGE(PG8_SB(0, 0), cB, voffB); PG8_STAGE(PG8_SB(0, 1), cB + hstep, voffB); PG8_STAGE(PG8_SA(0, 0), cA, voffA); PG8_STAGE(PG8_SA(0, 1), cA + hstep, voffA);
        if (wr == 1) PG8_BAR;
        PG8_WAIT_V(2); PG8_BAR;
        PG8_STAGE(PG8_SB(1, 0), cB + kstep, voffB); PG8_STAGE(PG8_SA(1, 0), cA + kstep, voffA); PG8_STAGE(PG8_SB(1, 1), cB + hstep + kstep, voffB);
        PG8_WAIT_V(6); PG8_BAR;
    } else {
        PG8_STAGE(PG8_SB(0, 0), cB, voffB); PG8_STAGE(PG8_SA(0, 0), cA, voffA); PG8_STAGE(PG8_SB(0, 1), cB + hstep, voffB); PG8_STAGE(PG8_SA(0, 1), cA + hstep, voffA);
        if (wr == 1) PG8_BAR;
        PG8_WAIT_V(4); PG8_BAR;
        PG8_STAGE(PG8_SB(1, 0), cB + kstep, voffB); PG8_STAGE(PG8_SA(1, 0), cA + kstep, voffA); PG8_STAGE(PG8_SB(1, 1), cB + hstep + kstep, voffB);
        PG8_WAIT_V(6); PG8_BAR;
    }
    for (;;) {
        const bool has_next = S.next(ui + 1, nxt);
        const char* nA = has_next ? unit_a(g, E, nxt, tstep) : cA; const char* nB = has_next ? unit_b(g, E, nxt, tstep) : cB;
        for (int t = 0; t < nt; t += 2) {
            const bool last = (t == nt - 2);
            const char* a1 = cA + (size_t)(t + 1) * kstep;
            const char* a2 = last ? nA : cA + (size_t)(t + 2) * kstep; const char* b2 = last ? nB : cB + (size_t)(t + 2) * kstep;
            const char* a3 = a2 + kstep; const char* b3 = b2 + kstep;
            if (last && has_next) S.a_ready(nxt);
            if constexpr (SP2) {
            PG8_LDB(B0, 0, 0); PG8_LDB(B1, 0, 1); PG8_SCHED; PG8_LDA(At, 0, 0); PG8_STAGE(PG8_SA(1, 1), a1 + hstep, voffA);
            PG8_WAIT_V(8); PG8_WAIT_L(0); PG8_BAR; PG8_MMA(0, 0, At, B0); PG8_MMA(0, 1, At, B1); PG8_BAR; PG8_SCHED;
            PG8_LDA(At, 0, 1); PG8_STAGE(PG8_SB(0, 0), b2, voffB); PG8_STAGE(PG8_SB(0, 1), b2 + hstep, voffB); PG8_STAGE(PG8_SA(0, 0), a2, voffA);
            PG8_WAIT_V(8); PG8_WAIT_L(0); PG8_BAR; PG8_MMA(1, 0, At, B0); PG8_MMA(1, 1, At, B1); PG8_BAR; PG8_SCHED;
            PG8_LDB(B0, 1, 0); PG8_LDB(B1, 1, 1); PG8_SCHED; PG8_LDA(At, 1, 0); PG8_STAGE(PG8_SA(0, 1), a2 + hstep, voffA);
            PG8_WAIT_V(8); PG8_WAIT_L(0); PG8_BAR; PG8_MMA(0, 0, At, B0); PG8_MMA(0, 1, At, B1); PG8_BAR; PG8_SCHED;
            PG8_LDA(At, 1, 1); PG8_STAGE(PG8_SB(1, 0), b3, voffB); PG8_STAGE(PG8_SB(1, 1), b3 + hstep, voffB); PG8_STAGE(PG8_SA(1, 0), a3, voffA);
            PG8_WAIT_V(8); PG8_WAIT_L(0); PG8_BAR; PG8_MMA(1, 0, At, B0); PG8_MMA(1, 1, At, B1); PG8_BAR; PG8_SCHED;
            } else {
            PG8_LDB(B0, 0, 0); PG8_SCHED; PG8_LDA(At, 0, 0); PG8_STAGE(PG8_SA(1, 1), a1 + hstep, voffA);
            PG8_WAIT_L(8); PG8_BAR; PG8_WAIT_L(0); PG8_MMA(0, 0, At, B0); PG8_BAR; PG8_SCHED;
            PG8_LDB(B1, 0, 1); PG8_STAGE(PG8_SB(0, 0), b2, voffB);
            PG8_BAR; PG8_WAIT_L(0); PG8_MMA(0, 1, At, B1); PG8_BAR;
            PG8_LDA(At, 0, 1); PG8_STAGE(PG8_SA(0, 0), a2, voffA);
            PG8_BAR; PG8_WAIT_L(0); PG8_MMA(1, 0, At, B0); PG8_BAR; PG8_SCHED;
            PG8_STAGE(PG8_SB(0, 1), b2 + hstep, voffB);
            PG8_WAIT_V(6); PG8_BAR; PG8_MMA(1, 1, At, B1); PG8_BAR;
            PG8_LDB(B0, 1, 0); PG8_SCHED; PG8_LDA(At, 1, 0); PG8_STAGE(PG8_SA(0, 1), a2 + hstep, voffA);
            PG8_WAIT_L(8); PG8_BAR; PG8_WAIT_L(0); PG8_MMA(0, 0, At, B0); PG8_BAR; PG8_SCHED;
            PG8_LDB(B1, 1, 1); PG8_STAGE(PG8_SB(1, 0), b3, voffB);
            PG8_BAR; PG8_WAIT_L(0); PG8_MMA(0, 1, At, B1); PG8_BAR;
            PG8_LDA(At, 1, 1); PG8_STAGE(PG8_SA(1, 0), a3, voffA);
            PG8_BAR; PG8_WAIT_L(0); PG8_MMA(1, 0, At, B0); PG8_BAR; PG8_SCHED;
            PG8_STAGE(PG8_SB(1, 1), b3 + hstep, voffB);
            PG8_WAIT_V(6); PG8_BAR; PG8_MMA(1, 1, At, B1); PG8_BAR;
            }
        }
        if constexpr (ALIGN_EPI) { if (wr == 0) PG8_BAR; }
        if constexpr (!Epi::AFTER_DRAIN) { E(acc, cur, wr, wc, fr, fq); S.done(cur); }
        if (!has_next) break;
#pragma unroll
        for (int a = 0; a < 2; ++a)
#pragma unroll
            for (int b = 0; b < 2; ++b)
#pragma unroll
                for (int m = 0; m < 4; ++m)
#pragma unroll
                    for (int n = 0; n < 2; ++n) acc[a][b][m][n] = (f32x4){0.f, 0.f, 0.f, 0.f};
        cur = nxt; cA = nA; cB = nB; ++ui;
        if constexpr (ALIGN_EPI) { if (wr == 1) PG8_BAR; }
    }
    PG8_WAIT_V(0);
    if constexpr (!ALIGN_EPI) { if (wr == 0) PG8_BAR; }
    PG8_BAR;
    if constexpr (Epi::AFTER_DRAIN) { E.fused(acc, cur, wr, wc, fr, fq, lds, wid, lane); S.done(cur); }
#undef PG8_SA
#undef PG8_SB
#undef PG8_STAGE
#undef PG8_LDA
#undef PG8_LDB
#undef PG8_MMA
#undef PG8_WAIT_V
#undef PG8_WAIT_L
#undef PG8_BAR
#undef PG8_SCHED
}
}


constexpr int BATCH = 4, SEQ = 8192, DM = 1024, CTXL = 256;
constexpr int MLAT = BATCH * SEQ, MCTX = BATCH * CTXL, MTOT = MLAT + MCTX;
constexpr int EVEN_N = 2560, ODD_N = 5120, ODD_IN_W = 5136;
constexpr int NKEYS = CTXL + SEQ;
constexpr int NSLOT = 66;
constexpr float LN_EPS = 1e-6f;
constexpr float ALPHA_RES = 1.4142135623730951f;
constexpr float QSCALE = 0.125f * 1.4426950408889634f;

namespace epi {
using pg8::f32x4; using pg8::u32x4; using pg8::bf16_t; using pg8::Unit;
__device__ __forceinline__ unsigned pk(float lo, float hi) { return pg8::cvt_pk_bf16(lo, hi); }
__device__ __forceinline__ float sigmoidf_(float v) { return __builtin_amdgcn_rcpf(1.0f + __expf(-v)); }
__device__ __forceinline__ float siluf_(float v) { return v * __builtin_amdgcn_rcpf(1.0f + __expf(-v)); }

struct EpiEven {
    static constexpr bool PERM = true, AFTER_DRAIN = false, SWAP_AB = false;
    bf16_t* Q0;
    static constexpr size_t oGA = (size_t)MTOT * 768, oKALL = oGA + (size_t)MTOT * 768, oVALL = oKALL + (size_t)BATCH * NKEYS * 256, oU = oVALL + (size_t)BATCH * NKEYS * 256, oGB = oU + (size_t)MTOT * 256;
    const float *qgain, *kgain, *fgain;
    const float* rope;
    __device__ __forceinline__ void operator()(const f32x4 (&acc)[2][2][4][2], const Unit& u, int wr, int wc, int fr, int fq) const {
        const int pm = u.pm, pn = u.pn;
        const bool lat = pm < 128;
        const int b = lat ? (pm >> 5) : (pm - 128);
        const int type = (pn < 3) ? 0 : (pn < 6) ? 1 : (pn - 4);
        const bool norm = (type == 0 || type == 2 || type == 4);
        const bool dorope = lat && (type == 0 || type == 2);
        f32x4 gn[2][2];
        if (norm) {
            const float* gp = (type == 0) ? qgain : (type == 2) ? kgain : (fgain + 64 * wc);
#pragma unroll
            for (int bj = 0; bj < 2; ++bj)
#pragma unroll
                for (int n = 0; n < 2; ++n) gn[bj][n] = *(const f32x4*)(gp + 32 * bj + 8 * fq + 4 * n);
        }
#pragma unroll
        for (int ai = 0; ai < 2; ++ai)
#pragma unroll
            for (int m = 0; m < 4; ++m) {
                const int rl = ai * 128 + wr * 64 + m * 16 + fr;
                const int mrow = pm * 256 + rl;
                const int t = lat ? ((pm & 31) * 256 + rl) : rl;
                f32x4 v[2][2];
#pragma unroll
                for (int bj = 0; bj < 2; ++bj)
#pragma unroll
                    for (int n = 0; n < 2; ++n) v[bj][n] = acc[ai][bj][m][n];
                if (norm) {
                    float ss = 0.f;
#pragma unroll
                    for (int bj = 0; bj < 2; ++bj)
#pragma unroll
                        for (int n = 0; n < 2; ++n) { const f32x4 x = v[bj][n]; ss += (x[0] * x[0] + x[1] * x[1]) + (x[2] * x[2] + x[3] * x[3]); }
                    ss += __shfl_xor(ss, 16); ss += __shfl_xor(ss, 32);
                    const float r = rsqrtf(ss * (1.0f / 64.0f) + LN_EPS);
#pragma unroll
                    for (int bj = 0; bj < 2; ++bj)
#pragma unroll
                        for (int n = 0; n < 2; ++n) v[bj][n] = v[bj][n] * r * gn[bj][n];
                }
                if (dorope) {
                    const float* cb = (fq < 2) ? (rope + (t >> 6) * 16) : (rope + 4096 + (t & 63) * 16);
                    const int so = (fq < 2) ? 2048 : 1024;
#pragma unroll
                    for (int n = 0; n < 2; ++n) {
                        const f32x4 c4 = *(const f32x4*)(cb + 8 * (fq & 1) + 4 * n), s4 = *(const f32x4*)(cb + so + 8 * (fq & 1) + 4 * n);
                        const f32x4 x1 = v[0][n], x2 = v[1][n];
                        v[0][n] = x1 * c4 - x2 * s4; v[1][n] = x1 * s4 + x2 * c4;
                    }
                }
                if (type == 0) {
#pragma unroll
                    for (int bj = 0; bj < 2; ++bj)
#pragma unroll
                        for (int n = 0; n < 2; ++n) v[bj][n] = v[bj][n] * QSCALE;
                } else if (type == 1 || type == 5) {
#pragma unroll
                    for (int bj = 0; bj < 2; ++bj)
#pragma unroll
                        for (int n = 0; n < 2; ++n) { f32x4 x = v[bj][n]; x[0] = siluf_(x[0]); x[1] = siluf_(x[1]); x[2] = siluf_(x[2]); x[3] = siluf_(x[3]); v[bj][n] = x; }
                }
                size_t doff;
                if (type == 0)      doff = (size_t)mrow * 768 + (4 * pn + wc) * 64;
                else if (type == 1) doff = oGA + (size_t)mrow * 768 + (pn - 3) * 256 + wc * 64;
                else if (type == 2) doff = oKALL + ((size_t)b * NKEYS + (lat ? 256 + t : t)) * 256 + wc * 64;
                else if (type == 3) doff = oVALL + ((size_t)b * NKEYS + (lat ? 256 + t : t)) * 256 + wc * 64;
                else if (type == 4) doff = oU + (size_t)mrow * 256 + wc * 64;
                else                doff = oGB + (size_t)mrow * 256 + wc * 64;
                bf16_t* dst = Q0 + doff;
#pragma unroll
                for (int bj = 0; bj < 2; ++bj) {
                    u32x4 w; w.x = pk(v[bj][0][0], v[bj][0][1]); w.y = pk(v[bj][0][2], v[bj][0][3]); w.z = pk(v[bj][1][0], v[bj][1][1]); w.w = pk(v[bj][1][2], v[bj][1][3]);
                    *(u32x4*)(dst + 32 * bj + 8 * fq) = w;
                }
            }
    }
};

struct EpiOdd {
    static constexpr bool PERM = true, AFTER_DRAIN = false, SWAP_AB = true;
    bf16_t *QB, *OG;
    __device__ __forceinline__ bool swap_ab(const Unit& u) const { return u.pn >= 4 && u.pn < 12; }
    __device__ __forceinline__ void operator()(const f32x4 (&acc)[2][2][4][2], const Unit& u, int wr, int wc, int fr, int fq) const {
        asm volatile("" : "+v"(fr), "+v"(fq));
        const int pm = u.pm, pn = u.pn;
        const bool lat = pm < 128;
        const int b = lat ? (pm >> 5) : (pm - 128);
        if (pn < 4) {
            const int h = pn;
#pragma unroll
            for (int ai = 0; ai < 2; ++ai) {
                const int slot = lat ? (2 + 2 * (pm & 31) + ai) : ai;
                bf16_t* blk = QB + ((size_t)(b * 4 + h) * NSLOT + slot) * 32768;
#pragma unroll
                for (int m = 0; m < 4; ++m)
#pragma unroll
                    for (int bj = 0; bj < 2; ++bj)
#pragma unroll
                        for (int n = 0; n < 2; ++n) {
                            const f32x4 a = acc[ai][bj][m][n];
                            const unsigned long long w = (unsigned long long)pk(a[0], a[1]) | ((unsigned long long)pk(a[2], a[3]) << 32);
                            *(unsigned long long*)(blk + ((((4 * wr + m) * 8 + 4 * bj + wc) * 64 + ((2 * fq + n) & 3) * 16 + fr) * 8) + 4 * (fq >> 1)) = w;
                        }
            }
        } else if (pn < 12) {
            const int h = pn & 3;
            bf16_t* base = QB + (size_t)(pn >> 2) * (size_t)(33 * 1024 * 1024);
#pragma unroll
            for (int bj = 0; bj < 2; ++bj) {
                const int slot = lat ? (2 + 2 * (pm & 31) + bj) : bj;
                bf16_t* blk = base + ((size_t)(b * 4 + h) * NSLOT + slot) * 32768 + (size_t)(wc * 64 + fq * 16 + fr) * 8;
#pragma unroll
                for (int ai = 0; ai < 2; ++ai)
#pragma unroll
                    for (int m = 0; m < 4; ++m) {
                        const f32x4 a0 = acc[ai][bj][m][0], a1 = acc[ai][bj][m][1];
                        u32x4 w; w.x = pk(a0[0], a0[1]); w.y = pk(a0[2], a0[3]); w.z = pk(a1[0], a1[1]); w.w = pk(a1[2], a1[3]);
                        *(u32x4*)(blk + (((4 * ai + 2 * wr + (m >> 1)) * 2 + (m & 1)) * 4) * 512) = w;
                    }
            }
        } else {
#pragma unroll
            for (int ai = 0; ai < 2; ++ai)
#pragma unroll
                for (int m = 0; m < 4; ++m) {
                    const int mrow = pm * 256 + ai * 128 + wr * 64 + m * 16 + fr;
                    float r[8];
#pragma unroll
                    for (int n = 0; n < 2; ++n)
#pragma unroll
                        for (int j = 0; j < 4; ++j) { const float o = acc[ai][0][m][n][j], z = acc[ai][1][m][n][j]; r[4 * n + j] = z * __builtin_amdgcn_rcpf((1.0f + __expf(-o)) * (1.0f + __expf(-z))); }
                    u32x4 w; w.x = pk(r[0], r[1]); w.y = pk(r[2], r[3]); w.z = pk(r[4], r[5]); w.w = pk(r[6], r[7]);
                    *(u32x4*)(OG + (size_t)mrow * 1024 + (pn - 12) * 128 + wc * 32 + 8 * fq) = w;
                }
        }
    }
};

struct EpiGate {
    static constexpr bool PERM = true, AFTER_DRAIN = false, SWAP_AB = false;
    bf16_t* GY; const float* mod;
    __device__ __forceinline__ void operator()(const f32x4 (&acc)[2][2][4][2], const Unit& u, int wr, int wc, int fr, int fq) const {
        const int pm = u.pm, pn = u.pn;
        const bool lat = pm < 128;
        const int b = lat ? (pm >> 5) : (pm - 128);
        const float* gp = mod + (lat ? b : 4) * 3072 + 2048;
        const int col0 = pn * 256 + wc * 32 + 8 * fq;
        f32x4 gv[2][2];
#pragma unroll
        for (int bj = 0; bj < 2; ++bj)
#pragma unroll
            for (int n = 0; n < 2; ++n) gv[bj][n] = *(const f32x4*)(gp + col0 + bj * 128 + n * 4);
#pragma unroll
        for (int ai = 0; ai < 2; ++ai)
#pragma unroll
            for (int m = 0; m < 4; ++m) {
                const int rl = ai * 128 + wr * 64 + m * 16 + fr;
                bf16_t* dst = GY + (size_t)(pm * 256 + rl) * 1024 + col0;
#pragma unroll
                for (int bj = 0; bj < 2; ++bj) { const f32x4 a0 = acc[ai][bj][m][0] * gv[bj][0], a1 = acc[ai][bj][m][1] * gv[bj][1];
                    u32x4 w; w.x = pk(a0[0], a0[1]); w.y = pk(a0[2], a0[3]); w.z = pk(a1[0], a1[1]); w.w = pk(a1[2], a1[3]);
                    *(u32x4*)(dst + bj * 128) = w; }
            }
    }
};

}
#define GAS __attribute__((address_space(1)))
#define LAS __attribute__((address_space(3)))
typedef unsigned short bf16;
typedef unsigned v4u __attribute__((ext_vector_type(4)));
typedef float f32x4 __attribute__((ext_vector_type(4)));
typedef float f32x2v __attribute__((ext_vector_type(2)));
typedef short bf16x8 __attribute__((ext_vector_type(8)));
typedef GAS unsigned gu32;
typedef GAS unsigned long long gu64;
#define RLX_AGENT __ATOMIC_RELAXED, __HIP_MEMORY_SCOPE_AGENT
#define LDS_WAIT() asm volatile("s_waitcnt lgkmcnt(0)" ::: "memory")
#define VM_WAIT() asm volatile("s_waitcnt vmcnt(0)" ::: "memory")
__device__ __forceinline__ unsigned long long rt() { return __builtin_amdgcn_s_memrealtime(); }
__device__ __forceinline__ unsigned pk2(float lo, float hi) { unsigned r; asm("v_cvt_pk_bf16_f32 %0, %1, %2" : "=v"(r) : "v"(lo), "v"(hi)); return r; }
__device__ __forceinline__ unsigned pk2m(float lo, float hi) { return pg8::cvt_pk_bf16(lo, hi); }
__device__ __forceinline__ unsigned f2bf(float f) { return pk2(f, f) & 0xffffu; }

#define XB_TMO      128
#define XB_XCNT(j)  (256  + 64 * (j))
#define XB_XSUB(j)  (1280 + 64 * (j))
#define XB_XGEN(j)  (2304 + 64 * (j))
#define XB_TOP      3328
#define XB_TOPGEN   3392
#define XCD_BAR_WORDS 3456
#define XB_SPIN_CAP (1u << 18)

__device__ __forceinline__ unsigned xb_ld(unsigned* p)              { return __hip_atomic_load(p, __ATOMIC_RELAXED, __HIP_MEMORY_SCOPE_AGENT); }
__device__ __forceinline__ unsigned xb_add(unsigned* p, unsigned v) { return __hip_atomic_fetch_add(p, v, __ATOMIC_RELAXED, __HIP_MEMORY_SCOPE_AGENT); }
__device__ __forceinline__ unsigned xb_xcc_id() { return (unsigned)__builtin_amdgcn_s_getreg((3 << 11) | 20) & 0xFu; }
#define XB_SPIN(cond, bar) do { unsigned _sp = 0; while (cond) { __builtin_amdgcn_s_sleep(1); \
    if ((++_sp & 255u) == 0u) { if (xb_ld(&(bar)[XB_TMO])) break; if (_sp > XB_SPIN_CAP) { atomicAdd(&(bar)[XB_TMO], 1u); break; } } } } while (0)

struct XcdBarrier {
    unsigned* bar; unsigned x;
    volatile LAS unsigned* st;
};

__device__ __forceinline__ XcdBarrier xcd_barrier_post(unsigned* bar, volatile LAS unsigned* st) {
    XcdBarrier b; b.bar = bar; b.x = xb_xcc_id(); b.st = st;
    if (threadIdx.x == 0) (void)xb_add(&bar[XB_XCNT(b.x)], 1u);
    return b;
}
__device__ __forceinline__ void xcd_barrier_complete(unsigned* bar, unsigned x, unsigned& nloc, unsigned& nx) {
    const unsigned G = gridDim.x * gridDim.y * gridDim.z;
    unsigned sum, cnt, mine, sp = 0u;
    for (;;) {
        sum = 0u; cnt = 0u; mine = 0u;
#pragma unroll
        for (unsigned j = 0; j < 16; ++j) { const unsigned c = xb_ld(&bar[XB_XCNT(j)]); sum += c; cnt += (c > 0u) ? 1u : 0u; mine = (j == x) ? c : mine; }
        if (sum == G) break;
        __builtin_amdgcn_s_sleep(1);
        if ((++sp & 255u) == 0u) { if (xb_ld(&bar[XB_TMO])) break; if (sp > XB_SPIN_CAP) { atomicAdd(&bar[XB_TMO], 1u); break; } }
    }
    nloc = mine > 0u ? mine : 1u; nx = cnt > 0u ? cnt : 1u;
}

__device__ __forceinline__ void xcd_barrier(const XcdBarrier& b) {
    asm volatile("s_waitcnt vmcnt(0)" ::: "memory");
    __syncthreads();
    if (threadIdx.x == 0) {
        unsigned* bar = b.bar;
        __builtin_amdgcn_s_waitcnt(0);
        unsigned nloc = b.st[0], nx = b.st[1];
        if (nloc == 0u) { xcd_barrier_complete(bar, b.x, nloc, nx); b.st[0] = nloc; b.st[1] = nx; }
        const unsigned old = xb_add(&bar[XB_XSUB(b.x)], 1u);
        const unsigned gen = old / nloc;
        if (old + 1u == (gen + 1u) * nloc) {
            __builtin_amdgcn_fence(__ATOMIC_RELEASE, "agent");
            asm volatile("s_waitcnt vmcnt(0)" ::: "memory");
            const unsigned og = xb_add(&bar[XB_TOP], 1u);
            const unsigned tg = og / nx;
            if (og + 1u == (tg + 1u) * nx) xb_add(&bar[XB_TOPGEN], 1u);
            else XB_SPIN(xb_ld(&bar[XB_TOPGEN]) == tg, bar);
            __builtin_amdgcn_fence(__ATOMIC_ACQUIRE, "agent");
            xb_add(&bar[XB_XGEN(b.x)], 1u);
            asm volatile("s_waitcnt vmcnt(0)" ::: "memory");
        } else {
            XB_SPIN(xb_ld(&bar[XB_XGEN(b.x)]) == gen, bar);
            __builtin_amdgcn_fence(__ATOMIC_ACQUIRE, "agent");
            asm volatile("s_waitcnt vmcnt(0)" ::: "memory");
        }
    }
    __syncthreads();
}


constexpr int NWAVES = 8;
constexpr size_t MiB = 1u << 20, KiB = 1u << 10;
constexpr size_t WS_CTL = 0, CTL_ZERO_BYTES = 1 * MiB;
constexpr size_t WS_MOD = 1 * MiB;
constexpr size_t WS_ROPE = 1 * MiB + 128 * KiB;
constexpr size_t WS_MISCF = 1 * MiB + 160 * KiB;
constexpr size_t WS_WG = 1 * MiB + 192 * KiB;
constexpr size_t WS_FMT = 1 * MiB + 256 * KiB;
constexpr size_t WS_FMF = 1 * MiB + 320 * KiB;
constexpr size_t WS_A1 = 1 * MiB + 512 * KiB;
constexpr size_t WS_A2 = 1 * MiB + 640 * KiB;
constexpr size_t WS_TW = 1 * MiB + 704 * KiB;
constexpr size_t WS_ACTX = 1 * MiB + 768 * KiB;
constexpr size_t WS_CUM = 2 * MiB, WS_AA = 4 * MiB, WS_PM = 6 * MiB;
constexpr size_t WS_TOT = 8 * MiB, WS_AMAX = 8 * MiB + 16 * KiB;
constexpr size_t WS_GRAW = 10 * MiB;
constexpr size_t WS_W0T = 16 * MiB, WS_WO0T = 21 * MiB, WS_W1T = 23 * MiB, WS_WO1T = 33 * MiB;
constexpr size_t WS_H = 36 * MiB;
constexpr size_t WS_Q0 = 102 * MiB;
constexpr size_t WS_GA = WS_Q0 + (size_t)MTOT * 768 * 2;
constexpr size_t WS_KALL = WS_GA + (size_t)MTOT * 768 * 2;
constexpr size_t WS_VALL = WS_KALL + (size_t)BATCH * NKEYS * 256 * 2;
constexpr size_t WS_U = WS_VALL + (size_t)BATCH * NKEYS * 256 * 2;
constexpr size_t WS_GB = WS_U + (size_t)MTOT * 256 * 2;
constexpr size_t WS_Y = WS_GB + (size_t)MTOT * 256 * 2;
constexpr size_t WS_L0_END = WS_Y + (size_t)MTOT * 1024 * 2;
constexpr size_t WS_QB = 102 * MiB, WS_KB = 168 * MiB, WS_VB = 234 * MiB, WS_OG = 300 * MiB;
constexpr size_t WS_HF = 366 * MiB, WS_HB = 430 * MiB;
constexpr size_t WS_YG = 366 * MiB;
constexpr size_t WS_GY = WS_H;
constexpr size_t WS_S = WS_H;
constexpr size_t WS_YMIX = WS_QB;
constexpr size_t WS_ZC = 494 * MiB;
constexpr size_t WS_END = 498 * MiB;
static_assert(WS_L0_END <= 366 * MiB && WS_W1T + (size_t)ODD_N * 1024 * 2 <= WS_WO1T && WS_H + (size_t)MTOT * 2048 <= WS_Q0, "d_ws map");

constexpr int CW_TMO = 0, CW_CODE = 1;
constexpr int CW_BAR = 4096;
constexpr int RING_OFF = 0, RING_BYTES = 131072;
constexpr int LDSCTL_OFF = RING_BYTES, MISC_OFF = LDSCTL_OFF + 320;
constexpr int LDS_BYTES = 147456;

struct Frame {
    LAS unsigned char* lds;
    volatile LAS unsigned* MISC;
    gu32* ctl;
    int tid, lane, wave;
    int vcu, G;
    unsigned char* ws;
    const float *x, *c, *ctx, *c_ctx, *ada_w, *ada_b, *pgain, *pbias, *w0, *qgain, *kgain, *fgain, *wfmix, *wo0, *w1, *gbias, *wo1;
    float* out;
};
__device__ __forceinline__ float wave_sum(float v) {
#pragma unroll
    for (int o = 1; o < 64; o <<= 1) v += __shfl_xor(v, o);
    return v;
}
__device__ __forceinline__ float silu_acc(float v) { return v / (1.0f + expf(-v)); }

constexpr int P0_ITEMS = 96 + 1 + 1 + 4 + 1 + 1 + 1;
__device__ __forceinline__ void weights_pass(Frame& F, const int gw, const int NGW);
__device__ __forceinline__ void p0_tables(Frame& F) {
    float* mod = (float*)(F.ws + WS_MOD);
    for (int it = blockIdx.x; it < P0_ITEMS; it += F.G) {
        __syncthreads();
        if (it < 96) {
            const int layer = it / 48, cb = it % 48;
            LAS float* sl = (LAS float*)(F.lds);
            LAS float* red = sl + 5 * 1024;
            for (int i = F.tid; i < 5 * 1024; i += NWAVES * 64) { const int r = i >> 10, k = i & 1023; const float v = (r < 4) ? F.c[r * 1024 + k] : F.c_ctx[k]; sl[i] = silu_acc(v); }
            __syncthreads();
            const int col = F.tid & 63, kg = F.tid >> 6;
            const float* W = F.ada_w + (size_t)layer * 1024 * 3072 + cb * 64 + col;
            float a[5] = {0.f, 0.f, 0.f, 0.f, 0.f};
            for (int k0 = kg * 128; k0 < kg * 128 + 128; k0 += 16) {
                float wv[16];
#pragma unroll
                for (int u = 0; u < 16; ++u) wv[u] = W[(size_t)(k0 + u) * 3072];
#pragma unroll
                for (int u = 0; u < 16; ++u)
#pragma unroll
                    for (int r = 0; r < 5; ++r) a[r] += sl[r * 1024 + k0 + u] * wv[u]; }
#pragma unroll
            for (int r = 0; r < 5; ++r) red[(kg * 5 + r) * 64 + col] = a[r];
            __syncthreads();
            if (F.tid < 320) { const int r = F.tid >> 6; float s = 0.f;
#pragma unroll
                for (int g = 0; g < 8; ++g) s += red[(g * 5 + r) * 64 + col];
                mod[(layer * 5 + r) * 3072 + cb * 64 + col] = s + F.ada_b[layer * 3072 + cb * 64 + col]; }
        } else if (it == 96) {
            float* rp = (float*)(F.ws + WS_ROPE);
            for (int i = F.tid; i < 3072; i += NWAVES * 64) {
                const int j = (i < 2048) ? i : (i - 2048); const int pos = j >> 4, fi = j & 15;
                const float invf = powf(10000.0f, -(float)fi / 16.0f); const float ang = (float)pos * invf;
                if (i < 2048) { rp[i] = cosf(ang); rp[2048 + i] = sinf(ang); } else { rp[4096 + j] = cosf(ang); rp[5120 + j] = sinf(ang); }
            }
        } else if (it == 97) {
            if (F.tid == 0) { float gq = 0.f, gk = 0.f; for (int i = 0; i < 64; ++i) { gq = fmaxf(gq, fabsf(F.qgain[i])); gk = fmaxf(gk, fabsf(F.kgain[i])); }
                ((float*)(F.ws + WS_MISCF))[0] = QSCALE * 64.0f * gq * gk * 1.001f; }
        } else if (it < 102) {
            const int g = it - 98;
            LAS float* cs = (LAS float*)(F.lds); LAS float* sn = cs + 64;
            if (F.tid < 64) { cs[F.tid] = cospif((float)F.tid / 32.0f); sn[F.tid] = sinpif((float)F.tid / 32.0f); }
            __syncthreads();
            bf16* fmt = (bf16*)(F.ws + WS_FMT) + (size_t)g * 128 * 64; float* fmf = (float*)(F.ws + WS_FMF) + (size_t)g * 64 * 64 * 2;
            const float* wm = F.wfmix + (size_t)g * 64 * 64;
            for (int i = F.tid; i < 64 * 64; i += NWAVES * 64) { const int cch = i >> 6, d = i & 63; float re = 0.f, im = 0.f;
                for (int kc = 0; kc < 64; ++kc) { const float w = wm[kc * 64 + d]; const int j = (kc * cch) & 63; re += cs[j] * w; im -= sn[j] * w; }
                re *= 0.0013810679320049757f; im *= 0.0013810679320049757f;
                fmf[(cch * 64 + d) * 2] = re; fmf[(cch * 64 + d) * 2 + 1] = im;
                fmt[(2 * d) * 64 + cch] = (bf16)f2bf(re); fmt[(2 * d + 1) * 64 + cch] = (bf16)f2bf(im); }
        } else if (it == 102) {
            LAS float* cs = (LAS float*)(F.lds); LAS float* sn = cs + 128;
            if (F.tid < 128) { cs[F.tid] = cospif((float)F.tid / 64.0f); sn[F.tid] = sinpif((float)F.tid / 64.0f); }
            __syncthreads();
            bf16* a1 = (bf16*)(F.ws + WS_A1);
            for (int i = F.tid; i < 256 * 256; i += NWAVES * 64) { const int row = i >> 8, col = i & 255; const int k1 = row >> 1, ro = row & 1, t1 = col >> 1, ri = col & 1; const int j = (k1 * t1) & 127;
                const float cv = cs[j], sv = sn[j]; const float v = (ro == 0) ? (ri == 0 ? cv : sv) : (ri == 0 ? -sv : cv); a1[i] = (bf16)f2bf(v); }
        } else if (it == 104) {
            LAS float* cs = (LAS float*)(F.lds); LAS float* sn = cs + 256;
            if (F.tid < 256) { cs[F.tid] = cospif((float)F.tid / 128.0f); sn[F.tid] = sinpif((float)F.tid / 128.0f); }
            __syncthreads();
            bf16* ac = (bf16*)(F.ws + WS_ACTX);
            for (int i = F.tid; i < 256 * 512; i += NWAVES * 64) { const int kt = i >> 9, col = i & 511; const int t = col >> 1, ri = col & 1; const int j = (kt * t) & 255; ac[i] = (bf16)f2bf(ri == 0 ? cs[j] : sn[j]); }
        } else {
            LAS float* cs = (LAS float*)(F.lds); LAS float* sn = cs + 64;
            if (F.tid < 64) { cs[F.tid] = cospif((float)F.tid / 32.0f); sn[F.tid] = sinpif((float)F.tid / 32.0f); }
            __syncthreads();
            bf16* a2 = (bf16*)(F.ws + WS_A2);
            for (int i = F.tid; i < 64 * 128; i += NWAVES * 64) { const int k2 = i >> 7, col = i & 127; const int t2 = col >> 1, ri = col & 1; const int j = (k2 * t2) & 63; a2[i] = (bf16)f2bf(ri == 0 ? cs[j] : sn[j]); }
            float* tw = (float*)(F.ws + WS_TW);
            for (int i = F.tid; i < 128 * 64; i += NWAVES * 64) { const int k1 = i >> 6, t2 = i & 63; const float a = (float)(k1 * t2) / 4096.0f; tw[2 * i] = cospif(a); tw[2 * i + 1] = sinpif(a); }
        }
    }
    __syncthreads();
    if (F.G >= P0_ITEMS + 64) { if ((int)blockIdx.x >= P0_ITEMS) weights_pass(F, ((int)blockIdx.x - P0_ITEMS) * NWAVES + F.wave, (F.G - P0_ITEMS) * NWAVES); }
    else weights_pass(F, (int)blockIdx.x * NWAVES + F.wave, F.G * NWAVES);
}

__device__ __forceinline__ void transpose_item(const float* W, int srcN, int n0, int kb, bf16* WT, int drow0, float scale, LAS float* scr, int lane) {
    const int k0 = 64 * kb;
#pragma unroll 8
    for (int i = 0; i < 32; ++i) { const int kk = 2 * i + (lane >> 5); scr[kk * 33 + (lane & 31)] = W[(size_t)(k0 + kk) * srcN + n0 + (lane & 31)] * scale; }
    LDS_WAIT(); asm volatile("" ::: "memory");
    const int c = lane & 7;
#pragma unroll
    for (int j = 0; j < 4; ++j) { const int n = (lane >> 3) + 8 * j; const LAS float* s = scr + (8 * c) * 33 + n;
        v4u o; o.x = pk2(s[0 * 33], s[1 * 33]); o.y = pk2(s[2 * 33], s[3 * 33]); o.z = pk2(s[4 * 33], s[5 * 33]); o.w = pk2(s[6 * 33], s[7 * 33]);
        *(GAS v4u*)(WT + (size_t)(drow0 + n) * 1024 + k0 + 8 * c) = o; }
    LDS_WAIT(); asm volatile("" ::: "memory");
}
__device__ __forceinline__ void weights_pass(Frame& F, const int gw, const int NGW) {
    LAS float* scr = (LAS float*)(F.lds + RING_OFF + F.wave * 16384);
    constexpr int I_W0 = 16 * (EVEN_N / 32), I_WO = 16 * 32, I_W1 = 16 * (ODD_N / 32);
    constexpr int NITEMS = I_W0 + I_WO + I_W1 + I_WO;
    for (int it = gw; it < NITEMS; it += NGW) {
        int r = it;
        if (r < I_W0) { const int kb = r / (EVEN_N / 32), nb = r % (EVEN_N / 32), n0 = nb * 32; const int pn = n0 >> 8, L = n0 & 255, wc = L >> 6, bj = (L >> 5) & 1;
            transpose_item(F.w0, EVEN_N, n0, kb, (bf16*)(F.ws + WS_W0T), pn * 256 + bj * 128 + wc * 32, 1.0f, scr, F.lane); continue; } r -= I_W0;
        if (r < I_WO) { transpose_item(F.wo0, 1024, (r % 32) * 32, r / 32, (bf16*)(F.ws + WS_WO0T), (r % 32) * 32, 1.0f, scr, F.lane); continue; } r -= I_WO;
        if (r < I_W1) { const int kb = r / (ODD_N / 32), nb = r % (ODD_N / 32), n0 = nb * 32; int drow; float sc = 1.0f;
            if (n0 < 3072) { drow = n0; if (n0 >= 1024 && n0 < 2048) sc = 0.0625f; }
            else if (n0 < 4096) { const int fo = n0 - 3072; drow = 256 * (12 + (fo >> 7)) + (fo & 127); }
            else { const int fz = n0 - 4096; drow = 256 * (12 + (fz >> 7)) + 128 + (fz & 127); }
            transpose_item(F.w1, ODD_IN_W, n0, kb, (bf16*)(F.ws + WS_W1T), drow, sc, scr, F.lane); continue; } r -= I_W1;
        transpose_item(F.wo1, 1024, (r % 32) * 32, r / 32, (bf16*)(F.ws + WS_WO1T), (r % 32) * 32, 1.0f, scr, F.lane);
    }
    { float* wg = (float*)(F.ws + WS_WG);
        for (int i = gw * 64 + F.lane; i < 16 * 1024; i += NGW * 64) { const int j = i >> 10, k = i & 1023; wg[i] = F.w1[(size_t)k * ODD_IN_W + ODD_N + j]; } }
}
__device__ __forceinline__ void p1_h0_rows(Frame& F) {
    const int gw = F.vcu * NWAVES + F.wave;
    {
        const float* mod0 = (const float*)(F.ws + WS_MOD);
        int lane = F.lane; asm volatile("" : "+v"(lane));
        const int rpw = (MTOT + F.G * NWAVES - 1) / (F.G * NWAVES);
        const int m0 = gw * rpw, m1 = (m0 + rpw < MTOT) ? (m0 + rpw) : MTOT;
        if (m0 < m1) {
            f32x4 vn[4], sc[4], sh[4]; int rcur = -1;
            { const float* xr = (m0 < MLAT) ? (F.x + (size_t)m0 * 1024) : (F.ctx + (size_t)(m0 - MLAT) * 1024);
#pragma unroll
              for (int j = 0; j < 4; ++j) vn[j] = *((const GAS f32x4*)xr + lane + 64 * j); }
            for (int m = m0; m < m1; ++m) {
                f32x4 v[4];
#pragma unroll
                for (int j = 0; j < 4; ++j) v[j] = vn[j];
                if (m + 1 < m1) { const int m2 = m + 1; const float* xr = (m2 < MLAT) ? (F.x + (size_t)m2 * 1024) : (F.ctx + (size_t)(m2 - MLAT) * 1024);
#pragma unroll
                    for (int j = 0; j < 4; ++j) vn[j] = *((const GAS f32x4*)xr + lane + 64 * j); }
                const int r = (m < MLAT) ? (m >> 13) : 4;
                if (r != rcur) { rcur = r;
#pragma unroll
                    for (int j = 0; j < 4; ++j) { sh[j] = *((const f32x4*)(mod0 + r * 3072) + lane + 64 * j); sc[j] = *((const f32x4*)(mod0 + r * 3072 + 1024) + lane + 64 * j) + 1.0f; } }
                float s = 0.f;
#pragma unroll
                for (int j = 0; j < 4; ++j) s += (v[j].x + v[j].y) + (v[j].z + v[j].w);
                const float mean = wave_sum(s) * (1.f / 1024.f); float s2 = 0.f;
#pragma unroll
                for (int j = 0; j < 4; ++j) { v[j] = v[j] - mean; s2 += (v[j].x * v[j].x + v[j].y * v[j].y) + (v[j].z * v[j].z + v[j].w * v[j].w); }
                const float rstd = rsqrtf(wave_sum(s2) * (1.f / 1024.f) + LN_EPS);
                GAS unsigned long long* o8 = (GAS unsigned long long*)((bf16*)(F.ws + WS_H) + (size_t)m * 1024) + lane;
#pragma unroll
                for (int j = 0; j < 4; ++j) { const f32x4 h = v[j] * rstd * sc[j] + sh[j]; o8[64 * j] = (unsigned long long)pk2(h.x, h.y) | ((unsigned long long)pk2(h.z, h.w) << 32); }
            }
        }
    }
}

__device__ __forceinline__ void p5_rowpass(Frame& F) {
    const float* mod1 = (const float*)(F.ws + WS_MOD) + 5 * 3072;
    const float* wg = (const float*)(F.ws + WS_WG);
    float* zlat = F.out; float* graw = (float*)(F.ws + WS_GRAW);
    int lane = F.lane, wv = F.wave; asm volatile("" : "+v"(lane), "+s"(wv));
    const int gw = F.vcu * NWAVES + wv;
    LAS f32x4* wgl = (LAS f32x4*)(F.lds);
    __syncthreads();
    for (int i = wv * 64 + lane; i < 16 * 256; i += NWAVES * 64) wgl[i] = *((const f32x4*)wg + i);
    __syncthreads();
    const int rpw = (MTOT + F.G * NWAVES - 1) / (F.G * NWAVES);
    const int m0 = gw * rpw, m1 = (m0 + rpw < MTOT) ? (m0 + rpw) : MTOT;
    if (m0 < m1) {
        f32x4 vn[4], sc[4], sh[4], pg[4], pb[4]; int rcur = -1;
#pragma unroll
        for (int j = 0; j < 4; ++j) { pg[j] = *((const f32x4*)F.pgain + lane + 64 * j); pb[j] = *((const f32x4*)F.pbias + lane + 64 * j); }
        const unsigned long long* gyb = (const unsigned long long*)(F.ws + WS_GY);
        unsigned long long gn[4];
        { const float* xr0 = (m0 < MLAT) ? (F.x + (size_t)m0 * 1024) : (F.ctx + (size_t)(m0 - MLAT) * 1024);
#pragma unroll
          for (int j = 0; j < 4; ++j) { vn[j] = *((const GAS f32x4*)xr0 + lane + 64 * j); gn[j] = gyb[(size_t)m0 * 256 + lane + 64 * j]; } }
        const float gb = (lane < 16) ? F.gbias[lane] : 0.f;
        for (int m = m0; m < m1; ++m) {
            f32x4 v[4];
#pragma unroll
            for (int j = 0; j < 4; ++j) { const unsigned lo = (unsigned)gn[j], hi = (unsigned)(gn[j] >> 32);
                v[j].x = vn[j].x * ALPHA_RES + __builtin_bit_cast(float, lo << 16); v[j].y = vn[j].y * ALPHA_RES + __builtin_bit_cast(float, lo & 0xffff0000u);
                v[j].z = vn[j].z * ALPHA_RES + __builtin_bit_cast(float, hi << 16); v[j].w = vn[j].w * ALPHA_RES + __builtin_bit_cast(float, hi & 0xffff0000u); }
            GAS unsigned long long* zr = (GAS unsigned long long*)(zlat + (size_t)m * 1024) + lane;
            if (m + 1 < m1) { const int m2 = m + 1; const float* x2 = (m2 < MLAT) ? (F.x + (size_t)m2 * 1024) : (F.ctx + (size_t)(m2 - MLAT) * 1024);
#pragma unroll
                for (int j = 0; j < 4; ++j) { vn[j] = *((const GAS f32x4*)x2 + lane + 64 * j); gn[j] = gyb[(size_t)m2 * 256 + lane + 64 * j]; } }
            const int r = (m < MLAT) ? (m >> 13) : 4;
            if (r != rcur) { rcur = r;
#pragma unroll
                for (int j = 0; j < 4; ++j) { sh[j] = *((const f32x4*)(mod1 + r * 3072) + lane + 64 * j); sc[j] = *((const f32x4*)(mod1 + r * 3072 + 1024) + lane + 64 * j) + 1.0f; } }
            float s = 0.f;
#pragma unroll
            for (int j = 0; j < 4; ++j) s += (v[j].x + v[j].y) + (v[j].z + v[j].w);
            float mean = wave_sum(s) * (1.f / 1024.f); float s2 = 0.f;
#pragma unroll
            for (int j = 0; j < 4; ++j) { v[j] = v[j] - mean; s2 += (v[j].x * v[j].x + v[j].y * v[j].y) + (v[j].z * v[j].z + v[j].w * v[j].w); }
            float rstd = rsqrtf(wave_sum(s2) * (1.f / 1024.f) + LN_EPS);
            s = 0.f;
#pragma unroll
            for (int j = 0; j < 4; ++j) { v[j] = v[j] * rstd * pg[j] + pb[j]; if (m < MLAT) zr[64 * j] = (unsigned long long)pk2(v[j].x, v[j].y) | ((unsigned long long)pk2(v[j].z, v[j].w) << 32); s += (v[j].x + v[j].y) + (v[j].z + v[j].w); }
            mean = wave_sum(s) * (1.f / 1024.f); s2 = 0.f;
#pragma unroll
            for (int j = 0; j < 4; ++j) { v[j] = v[j] - mean; s2 += (v[j].x * v[j].x + v[j].y * v[j].y) + (v[j].z * v[j].z + v[j].w * v[j].w); }
            rstd = rsqrtf(wave_sum(s2) * (1.f / 1024.f) + LN_EPS);
            GAS unsigned long long* o8 = (GAS unsigned long long*)((bf16*)(F.ws + WS_H) + (size_t)m * 1024) + lane;
#pragma unroll
            for (int j = 0; j < 4; ++j) { v[j] = v[j] * rstd * sc[j] + sh[j]; o8[64 * j] = (unsigned long long)pk2(v[j].x, v[j].y) | ((unsigned long long)pk2(v[j].z, v[j].w) << 32); }
            float d[16];
#pragma unroll
            for (int gi = 0; gi < 16; ++gi) { float a = 0.f;
#pragma unroll
                for (int j = 0; j < 4; ++j) { const f32x4 w = wgl[gi * 256 + lane + 64 * j]; a += (v[j].x * w.x + v[j].y * w.y) + (v[j].z * w.z + v[j].w * w.w); }
                d[gi] = a; if ((gi & 3) == 3) __builtin_amdgcn_sched_barrier(0); }
            { const bool b5 = (lane & 32) != 0, b4 = (lane & 16) != 0, b3 = (lane & 8) != 0, b2 = (lane & 4) != 0;
              float e[8], g4v[4], h2[2];
#pragma unroll
              for (int i = 0; i < 8; ++i) { const float send = b5 ? d[i] : d[8 + i], own = b5 ? d[8 + i] : d[i]; e[i] = own + __shfl_xor(send, 32); }
#pragma unroll
              for (int i = 0; i < 4; ++i) { const float send = b4 ? e[i] : e[4 + i], own = b4 ? e[4 + i] : e[i]; g4v[i] = own + __shfl_xor(send, 16); }
#pragma unroll
              for (int i = 0; i < 2; ++i) { const float send = b3 ? g4v[i] : g4v[2 + i], own = b3 ? g4v[2 + i] : g4v[i]; h2[i] = own + __shfl_xor(send, 8); }
              float t1 = (b2 ? h2[1] : h2[0]) + __shfl_xor(b2 ? h2[0] : h2[1], 4);
              t1 += __shfl_xor(t1, 2); t1 += __shfl_xor(t1, 1);
              const int gidx = ((lane >> 5) & 1) * 8 + ((lane >> 4) & 1) * 4 + ((lane >> 3) & 1) * 2 + ((lane >> 2) & 1);
              const float gbv = __shfl(gb, gidx);
              if ((lane & 3) == 0) graw[(size_t)m * 16 + gidx] = t1 + gbv; }
        }
    }
    __syncthreads();
}
__device__ __forceinline__ void gate_scans(Frame& F) {
    LAS float* gl = (LAS float*)(F.lds);
    const float* graw = (const float*)(F.ws + WS_GRAW);
    int lane = F.lane, wv = F.wave; asm volatile("" : "+v"(lane), "+s"(wv));
    for (int u = F.vcu; u < 264; u += F.G) {
        const bool lat = u < 256; const int b = lat ? (u >> 6) : ((u - 256) >> 1); const int slot = lat ? (2 + (u & 63)) : ((u - 256) & 1);
        const size_t row0 = lat ? (size_t)u * 128 : (size_t)MLAT + (size_t)(u - 256) * 128;
        __syncthreads();
        *(LAS f32x4*)(gl + F.tid * 4) = *(const f32x4*)(graw + row0 * 16 + F.tid * 4);
        __syncthreads();
        const int dir = wv >> 2, h = wv & 3; const int cd = dir * 16 + b * 4 + h;
        const int p0 = dir ? (127 - 2 * lane) : (2 * lane), p1 = dir ? (126 - 2 * lane) : (2 * lane + 1);
        const float li0 = gl[p0 * 16 + 8 * dir + h], fp0 = gl[p0 * 16 + 8 * dir + 4 + h], li1 = gl[p1 * 16 + 8 * dir + h], fp1 = gl[p1 * 16 + 8 * dir + 4 + h];
        const float lf0 = fminf(fp0, 0.f) - log1pf(expf(-fabsf(fp0))), lf1 = fminf(fp1, 0.f) - log1pf(expf(-fabsf(fp1)));
        float ps = lf0 + lf1;
#pragma unroll
        for (int d = 1; d < 64; d <<= 1) { const float t = __shfl_up(ps, d); if (lane >= d) ps += t; }
        const float ex = ps - (lf0 + lf1);
        const float run0 = ex + lf0, run1 = run0 + lf1;
        const float a0 = li0 - run0, a1 = li1 - run1;
        float pm = fmaxf(a0, a1);
#pragma unroll
        for (int d = 1; d < 64; d <<= 1) { const float t = __shfl_up(pm, d); if (lane >= d) pm = fmaxf(pm, t); }
        float em = __shfl_up(pm, 1); if (lane == 0) em = -INFINITY;
        const float mx0 = fmaxf(em, a0), mx1 = fmaxf(mx0, a1);
        float* cum = (float*)(F.ws + WS_CUM) + ((size_t)cd * NSLOT + slot) * 128; float* aa = (float*)(F.ws + WS_AA) + ((size_t)cd * NSLOT + slot) * 128; float* pmx = (float*)(F.ws + WS_PM) + ((size_t)cd * NSLOT + slot) * 128;
        const int pl = dir ? p1 : p0;
        f32x2v cv, av, mv;
        cv.x = dir ? run1 : run0; cv.y = dir ? run0 : run1; av.x = dir ? a1 : a0; av.y = dir ? a0 : a1; mv.x = dir ? mx1 : mx0; mv.y = dir ? mx0 : mx1;
        *(f32x2v*)(cum + pl) = cv; *(f32x2v*)(aa + pl) = av; *(f32x2v*)(pmx + pl) = mv;
        if (lane == 63) { ((float*)(F.ws + WS_TOT))[cd * NSLOT + slot] = run1; ((float*)(F.ws + WS_AMAX))[cd * NSLOT + slot] = mx1; }
    }
    __syncthreads();
}

__device__ __forceinline__ void p11_final_ln(Frame& F) {
    int lane = F.lane, wv = F.wave; asm volatile("" : "+v"(lane), "+s"(wv));
    const int gw = F.vcu * NWAVES + wv;
    const int rpw = (MLAT + F.G * NWAVES - 1) / (F.G * NWAVES);
    const int m0 = gw * rpw, m1 = (m0 + rpw < MLAT) ? (m0 + rpw) : MLAT;
    if (m0 < m1) {
        f32x4 pg[4], pb[4]; unsigned long long xn[4];
#pragma unroll
        for (int j = 0; j < 4; ++j) { pg[j] = *((const f32x4*)(F.pgain + 1024) + lane + 64 * j); pb[j] = *((const f32x4*)(F.pbias + 1024) + lane + 64 * j); }
        const unsigned long long* gyb = (const unsigned long long*)(F.ws + WS_GY); unsigned long long gn[4];
#pragma unroll
        for (int j = 0; j < 4; ++j) { xn[j] = *((const GAS unsigned long long*)(F.out + (size_t)m0 * 1024) + lane + 64 * j); gn[j] = gyb[(size_t)m0 * 256 + lane + 64 * j]; }
        for (int m = m0; m < m1; ++m) {
            f32x4 v[4];
#pragma unroll
            for (int j = 0; j < 4; ++j) { const unsigned lo = (unsigned)gn[j], hi = (unsigned)(gn[j] >> 32), xl = (unsigned)xn[j], xh = (unsigned)(xn[j] >> 32);
                v[j].x = __builtin_bit_cast(float, xl << 16) * ALPHA_RES + __builtin_bit_cast(float, lo << 16); v[j].y = __builtin_bit_cast(float, xl & 0xffff0000u) * ALPHA_RES + __builtin_bit_cast(float, lo & 0xffff0000u);
                v[j].z = __builtin_bit_cast(float, xh << 16) * ALPHA_RES + __builtin_bit_cast(float, hi << 16); v[j].w = __builtin_bit_cast(float, xh & 0xffff0000u) * ALPHA_RES + __builtin_bit_cast(float, hi & 0xffff0000u); }
            GAS f32x4* zr = (GAS f32x4*)(F.out + (size_t)m * 1024) + lane;
            if (m + 1 < m1) {
#pragma unroll
                for (int j = 0; j < 4; ++j) { xn[j] = *((const GAS unsigned long long*)(F.out + (size_t)(m + 1) * 1024) + lane + 64 * j); gn[j] = gyb[(size_t)(m + 1) * 256 + lane + 64 * j]; } }
            float s = 0.f;
#pragma unroll
            for (int j = 0; j < 4; ++j) s += (v[j].x + v[j].y) + (v[j].z + v[j].w);
            const float mean = wave_sum(s) * (1.f / 1024.f); float s2 = 0.f;
#pragma unroll
            for (int j = 0; j < 4; ++j) { v[j] = v[j] - mean; s2 += (v[j].x * v[j].x + v[j].y * v[j].y) + (v[j].z * v[j].z + v[j].w * v[j].w); }
            const float rstd = rsqrtf(wave_sum(s2) * (1.f / 1024.f) + LN_EPS);
#pragma unroll
            for (int j = 0; j < 4; ++j) zr[64 * j] = v[j] * rstd * pg[j] + pb[j];
        }
    }
}

typedef float f32x16 __attribute__((ext_vector_type(16)));

__device__ __forceinline__ float bf2f(unsigned short h) { return __builtin_bit_cast(float, (unsigned)h << 16); }

__device__ __forceinline__ void fourier_s1_f1(Frame& F, int item, LAS unsigned char* L, int lane, int w) {
    const int tp = item & 31, g = (item >> 5) & 3, b = item >> 7;
    const int r = lane & 31, h = lane >> 5;
    const int t2l = w >> 2, t1 = 32 * (w & 3) + r; const int t = 64 * t1 + 2 * tp + t2l;
    const bf16* Ur = (const bf16*)(F.ws + WS_U) + ((size_t)b * SEQ + t) * 256 + g * 64 + 8 * h;
    bf16x8 bu[4];
#pragma unroll
    for (int ks = 0; ks < 4; ++ks) bu[ks] = *(const bf16x8*)(Ur + 16 * ks);
    const bf16* FMT = (const bf16*)(F.ws + WS_FMT) + (size_t)(g * 128 + r) * 64 + 8 * h;
#pragma unroll
    for (int mt = 0; mt < 4; ++mt) {
        f32x16 a = {0.f, 0.f, 0.f, 0.f, 0.f, 0.f, 0.f, 0.f, 0.f, 0.f, 0.f, 0.f, 0.f, 0.f, 0.f, 0.f};
#pragma unroll
        for (int ks = 0; ks < 4; ++ks) { const bf16x8 af = *(const bf16x8*)(FMT + mt * 32 * 64 + 16 * ks); a = __builtin_amdgcn_mfma_f32_32x32x16_bf16(af, bu[ks], a, 0, 0, 0); }
#pragma unroll
        for (int q = 0; q < 8; ++q) { const int d = 16 * mt + 4 * (q >> 1) + 2 * h + (q & 1); const int col = t2l * 64 + d;
            *(LAS unsigned*)(L + col * 512 + (((t1 >> 2) ^ (col & 15)) << 4) + (t1 & 3) * 4) = pk2m(a[2 * q], a[2 * q + 1]); }
    }
}
__device__ __forceinline__ void fourier_s1_dft(Frame& F, int item, const LAS unsigned char* L, const bf16x8 (&a1)[16], int lane, int w) {
    const int tp = item & 31;
    const int r = lane & 31, h = lane >> 5;
    const f32x2v* TW = (const f32x2v*)(F.ws + WS_TW);
    unsigned long long* YG = (unsigned long long*)(F.ws + WS_YG) + (size_t)item * 128 * 64;
#pragma unroll
    for (int np = 0; np < 2; ++np) {
        f32x16 a0 = {0.f, 0.f, 0.f, 0.f, 0.f, 0.f, 0.f, 0.f, 0.f, 0.f, 0.f, 0.f, 0.f, 0.f, 0.f, 0.f}, a2 = a0;
        const int c0 = 32 * np + r, c2 = 64 + 32 * np + r;
#pragma unroll
        for (int ks = 0; ks < 16; ++ks) {
            const bf16x8 b0 = *(const LAS bf16x8*)(L + c0 * 512 + (((2 * ks + h) ^ (c0 & 15)) << 4)), b2 = *(const LAS bf16x8*)(L + c2 * 512 + (((2 * ks + h) ^ (c2 & 15)) << 4));
            a0 = __builtin_amdgcn_mfma_f32_32x32x16_bf16(a1[ks], b0, a0, 0, 0, 0); a2 = __builtin_amdgcn_mfma_f32_32x32x16_bf16(a1[ks], b2, a2, 0, 0, 0);
        }
        const int d = 32 * np + r;
#pragma unroll
        for (int q = 0; q < 8; ++q) {
            const int k1 = 16 * w + 4 * (q >> 1) + 2 * h + (q & 1);
            const f32x2v tw0 = TW[k1 * 64 + 2 * tp], tw1 = TW[k1 * 64 + 2 * tp + 1];
            const float zr0 = a0[2 * q] * tw0.x + a0[2 * q + 1] * tw0.y, zi0 = a0[2 * q + 1] * tw0.x - a0[2 * q] * tw0.y;
            const float zr1 = a2[2 * q] * tw1.x + a2[2 * q + 1] * tw1.y, zi1 = a2[2 * q + 1] * tw1.x - a2[2 * q] * tw1.y;
            YG[k1 * 64 + d] = (unsigned long long)pk2(zr0, zi0) | ((unsigned long long)pk2(zr1, zi1) << 32);
        }
    }
}
__device__ __forceinline__ void fourier_s1_pair(Frame& F, int item0, int item1) {
    LAS unsigned char* L = F.lds + RING_OFF;
    int lane = F.lane, w = F.wave; asm volatile("" : "+v"(lane), "+s"(w));
    __syncthreads();
    fourier_s1_f1(F, item0, L, lane, w);
    fourier_s1_f1(F, item1, L + 65536, lane, w);
    bf16x8 a1[16];
    { const bf16* A1 = (const bf16*)(F.ws + WS_A1) + (size_t)(32 * w + (lane & 31)) * 256 + 8 * (lane >> 5);
#pragma unroll
      for (int ks = 0; ks < 16; ++ks) a1[ks] = *(const bf16x8*)(A1 + 16 * ks); }
    __syncthreads();
    fourier_s1_dft(F, item0, L, a1, lane, w);
    fourier_s1_dft(F, item1, L + 65536, a1, lane, w);
}
__device__ __forceinline__ void fourier_s2_item(Frame& F, int item) {
    const int kp = item & 63, g = (item >> 6) & 3, b = item >> 8;
    int lane = F.lane, w = F.wave; asm volatile("" : "+v"(lane), "+s"(w));
    const int r = lane & 31, h = lane >> 5, nt = w & 3, mt = w >> 2;
    const int k1 = 2 * kp + (nt >> 1), d = 32 * (nt & 1) + r;
    const unsigned long long* YG = (const unsigned long long*)(F.ws + WS_YG) + ((size_t)(b * 4 + g) * 32 * 128 + k1) * 64 + d;
    const bf16* A2 = (const bf16*)(F.ws + WS_A2) + (size_t)(32 * mt + r) * 128 + 8 * h;
    f32x16 acc = {0.f, 0.f, 0.f, 0.f, 0.f, 0.f, 0.f, 0.f, 0.f, 0.f, 0.f, 0.f, 0.f, 0.f, 0.f, 0.f};
    unsigned long long yb[8][2];
#pragma unroll
    for (int ks = 0; ks < 8; ++ks) { yb[ks][0] = YG[(size_t)(4 * ks + 2 * h) * 128 * 64]; yb[ks][1] = YG[(size_t)(4 * ks + 2 * h + 1) * 128 * 64]; }
#pragma unroll
    for (int ks = 0; ks < 8; ++ks) {
        const bf16x8 af = *(const bf16x8*)(A2 + 16 * ks);
        v4u bq; bq.x = (unsigned)yb[ks][0]; bq.y = (unsigned)(yb[ks][0] >> 32); bq.z = (unsigned)yb[ks][1]; bq.w = (unsigned)(yb[ks][1] >> 32);
        acc = __builtin_amdgcn_mfma_f32_32x32x16_bf16(af, __builtin_bit_cast(bf16x8, bq), acc, 0, 0, 0);
    }
    LAS float* stg = (LAS float*)(F.lds + RING_OFF + 86016) + w * 1152;
#pragma unroll
    for (int rg = 0; rg < 16; ++rg) stg[((rg & 3) + 8 * (rg >> 2) + 4 * h) * 36 + r] = acc[rg];
    asm volatile("s_waitcnt lgkmcnt(0)" ::: "memory");
    const int q4 = lane & 3;
#pragma unroll
    for (int ps = 0; ps < 2; ++ps) {
        const int row = 16 * ps + (lane >> 2); const int t = k1 + 128 * (32 * mt + row);
        const f32x4 x0 = *(const LAS f32x4*)(stg + row * 36 + 8 * q4), x1 = *(const LAS f32x4*)(stg + row * 36 + 8 * q4 + 4);
        const v4u gq = *(const GAS v4u*)((const bf16*)(F.ws + WS_GB) + ((size_t)b * SEQ + t) * 256 + g * 64 + 32 * (nt & 1) + 8 * q4);
        v4u o;
        o.x = pk2(x0[0] * __builtin_bit_cast(float, gq.x << 16), x0[1] * __builtin_bit_cast(float, gq.x & 0xffff0000u));
        o.y = pk2(x0[2] * __builtin_bit_cast(float, gq.y << 16), x0[3] * __builtin_bit_cast(float, gq.y & 0xffff0000u));
        o.z = pk2(x1[0] * __builtin_bit_cast(float, gq.z << 16), x1[1] * __builtin_bit_cast(float, gq.z & 0xffff0000u));
        o.w = pk2(x1[2] * __builtin_bit_cast(float, gq.w << 16), x1[3] * __builtin_bit_cast(float, gq.w & 0xffff0000u));
        *(GAS v4u*)((bf16*)(F.ws + WS_Y) + ((size_t)b * SEQ + t) * 1024 + 768 + g * 64 + 32 * (nt & 1) + 8 * q4) = o;
    }
    asm volatile("s_waitcnt lgkmcnt(0)" ::: "memory");
}
__device__ __forceinline__ void fourier_ctx_item(Frame& F, int item) {
    const int g = item & 3, b = item >> 2;
    LAS unsigned char* L = F.lds + RING_OFF;
    int lane = F.lane, w = F.wave; asm volatile("" : "+v"(lane), "+s"(w));
    const int r = lane & 31, h = lane >> 5;
    __syncthreads();
    {
        const int t = 32 * w + r;
        const bf16* Ur = (const bf16*)(F.ws + WS_U) + ((size_t)MLAT + b * CTXL + t) * 256 + g * 64 + 8 * h;
        bf16x8 bu[4];
#pragma unroll
        for (int ks = 0; ks < 4; ++ks) bu[ks] = *(const bf16x8*)(Ur + 16 * ks);
        const bf16* FMT = (const bf16*)(F.ws + WS_FMT) + (size_t)(g * 128 + r) * 64 + 8 * h;
#pragma unroll
        for (int mt = 0; mt < 4; ++mt) {
            f32x16 a = {0.f, 0.f, 0.f, 0.f, 0.f, 0.f, 0.f, 0.f, 0.f, 0.f, 0.f, 0.f, 0.f, 0.f, 0.f, 0.f};
#pragma unroll
            for (int ks = 0; ks < 4; ++ks) { const bf16x8 af = *(const bf16x8*)(FMT + mt * 32 * 64 + 16 * ks); a = __builtin_amdgcn_mfma_f32_32x32x16_bf16(af, bu[ks], a, 0, 0, 0); }
#pragma unroll
            for (int q = 0; q < 8; ++q) { const int d = 16 * mt + 4 * (q >> 1) + 2 * h + (q & 1);
                *(LAS unsigned*)(L + d * 1024 + (((t >> 2) ^ (d & 15)) << 4) + (t & 3) * 4) = pk2(a[2 * q] * 5.656854249492381f, a[2 * q + 1] * 5.656854249492381f); }
        }
    }
    __syncthreads();
    {
        const bf16* AC = (const bf16*)(F.ws + WS_ACTX) + (size_t)(32 * w + r) * 512 + 8 * h;
        f32x16 acc[2];
#pragma unroll
        for (int nt = 0; nt < 2; ++nt) acc[nt] = (f32x16){0.f, 0.f, 0.f, 0.f, 0.f, 0.f, 0.f, 0.f, 0.f, 0.f, 0.f, 0.f, 0.f, 0.f, 0.f, 0.f};
#pragma unroll 4
        for (int ks = 0; ks < 32; ++ks) { const bf16x8 af = *(const bf16x8*)(AC + 16 * ks);
#pragma unroll
            for (int nt = 0; nt < 2; ++nt) { const int d = 32 * nt + r; const bf16x8 bfr = *(const LAS bf16x8*)(L + d * 1024 + (((2 * ks + h) ^ (d & 15)) << 4)); acc[nt] = __builtin_amdgcn_mfma_f32_32x32x16_bf16(af, bfr, acc[nt], 0, 0, 0); } }
        __syncthreads();
        LAS float* stg = (LAS float*)L + w * 2176;
#pragma unroll
        for (int nt = 0; nt < 2; ++nt)
#pragma unroll
            for (int rg = 0; rg < 16; ++rg) stg[((rg & 3) + 8 * (rg >> 2) + 4 * h) * 68 + 32 * nt + r] = acc[nt][rg];
        asm volatile("s_waitcnt lgkmcnt(0)" ::: "memory");
        const int q8 = lane & 7;
#pragma unroll
        for (int ps = 0; ps < 4; ++ps) {
            const int row = 8 * ps + (lane >> 3); const size_t tok = (size_t)MLAT + b * CTXL + 32 * w + row;
            const f32x4 x0 = *(const LAS f32x4*)(stg + row * 68 + 8 * q8), x1 = *(const LAS f32x4*)(stg + row * 68 + 8 * q8 + 4);
            const v4u gq = *(const GAS v4u*)((const bf16*)(F.ws + WS_GB) + tok * 256 + g * 64 + 8 * q8);
            v4u o;
            o.x = pk2(x0[0] * __builtin_bit_cast(float, gq.x << 16), x0[1] * __builtin_bit_cast(float, gq.x & 0xffff0000u));
            o.y = pk2(x0[2] * __builtin_bit_cast(float, gq.y << 16), x0[3] * __builtin_bit_cast(float, gq.y & 0xffff0000u));
            o.z = pk2(x1[0] * __builtin_bit_cast(float, gq.z << 16), x1[1] * __builtin_bit_cast(float, gq.z & 0xffff0000u));
            o.w = pk2(x1[2] * __builtin_bit_cast(float, gq.w << 16), x1[3] * __builtin_bit_cast(float, gq.w & 0xffff0000u));
            *(GAS v4u*)((bf16*)(F.ws + WS_Y) + tok * 1024 + 768 + g * 64 + 8 * q8) = o;
        }
    }
    __syncthreads();
}

namespace attn_body {
using bf16=__hip_bfloat16;
using bf16x8=__attribute__((ext_vector_type(8)))short;
using s16x4=__attribute__((ext_vector_type(4)))short;
using f32x16=__attribute__((ext_vector_type(16)))float;
using u32x4=__attribute__((ext_vector_type(4)))unsigned;
constexpr int NW=8,QBLK=32,QB=QBLK*NW,KVBLK=64;
constexpr int QP=768,KP=256,OP=1024,GP=768;
__device__ __forceinline__ int crow(int r,int hi){return (r&3)+8*(r>>2)+4*hi;}
#define SBAR() __builtin_amdgcn_sched_barrier(0)
constexpr int NSLOT=3, SLOTB=8192;
constexpr int LDS_K=0, LDS_V=NSLOT*SLOTB, LDS_WS=2*NSLOT*SLOTB, LDS_OST=LDS_WS+NW*64*4, LDS_BYTES=LDS_OST+NW*4096;
__device__ __forceinline__ void glds16(const void*gsrc,unsigned lds_dst){unsigned keep;
  asm volatile("s_mov_b32 %0, m0\n\ts_mov_b32 m0, %2\n\ts_nop 0\n\tglobal_load_lds_dwordx4 %1, off\n\ts_mov_b32 m0, %0":"=&s"(keep):"v"(gsrc),"s"(lds_dst):"memory");}
typedef float f32x2_t __attribute__((ext_vector_type(2))); typedef __bf16 bf16x2_t __attribute__((ext_vector_type(2)));
__device__ __forceinline__ unsigned cvtpk_s(float lo,float hi){f32x2_t v={lo,hi};bf16x2_t b=__builtin_convertvector(v,bf16x2_t);return __builtin_bit_cast(unsigned,b);}
#define WAIT_BAR(N) asm volatile("s_waitcnt vmcnt(" #N ") lgkmcnt(0)\n\ts_barrier":::"memory")

__device__ __forceinline__ void qkt(f32x16&p0,f32x16&p1,const char*Kslot,const bf16x8*qr,const f32x16&negm,int r32,int hi){
  const char*kb=Kslot+hi*1024+r32*16;
  #pragma unroll
  for(int d0=0;d0<4;++d0){
    const bf16x8 b0=*reinterpret_cast<const bf16x8*>(kb+d0*2048);
    const bf16x8 b1=*reinterpret_cast<const bf16x8*>(kb+d0*2048+512);
    if(d0==0){p0=__builtin_amdgcn_mfma_f32_32x32x16_bf16(b0,qr[0],negm,0,0,0);p1=__builtin_amdgcn_mfma_f32_32x32x16_bf16(b1,qr[0],negm,0,0,0);}
    else{p0=__builtin_amdgcn_mfma_f32_32x32x16_bf16(b0,qr[d0],p0,0,0,0);p1=__builtin_amdgcn_mfma_f32_32x32x16_bf16(b1,qr[d0],p1,0,0,0);}}
}
typedef __attribute__((address_space(3))) const char* lds_cptr;
typedef short v4i16_t __attribute__((ext_vector_type(4)));
__device__ __forceinline__ void kload8(bf16x8*kf,lds_cptr kp){
  kf[0]=*(const __attribute__((address_space(3))) bf16x8*)(kp);      kf[1]=*(const __attribute__((address_space(3))) bf16x8*)(kp+512);
  kf[2]=*(const __attribute__((address_space(3))) bf16x8*)(kp+2048); kf[3]=*(const __attribute__((address_space(3))) bf16x8*)(kp+2560);
  kf[4]=*(const __attribute__((address_space(3))) bf16x8*)(kp+4096); kf[5]=*(const __attribute__((address_space(3))) bf16x8*)(kp+4608);
  kf[6]=*(const __attribute__((address_space(3))) bf16x8*)(kp+6144); kf[7]=*(const __attribute__((address_space(3))) bf16x8*)(kp+6656);
}
__device__ __forceinline__ void kload2(bf16x8*kf,lds_cptr kp,int j){ kf[2*j]=*(const __attribute__((address_space(3))) bf16x8*)(kp+j*2048); kf[2*j+1]=*(const __attribute__((address_space(3))) bf16x8*)(kp+j*2048+512); }
__device__ __forceinline__ s16x4 vtr(lds_cptr p){ return __builtin_bit_cast(s16x4,__builtin_amdgcn_ds_read_tr16_b64_v4i16((__attribute__((address_space(3))) v4i16_t*)p)); }
__device__ __forceinline__ void pv(f32x16*o,int vb,bf16x8 pa0,bf16x8 pa1,bf16x8 pa2,bf16x8 pa3){
  #pragma unroll
  for(int d0=0;d0<2;++d0){s16x4 lo[4],hi[4];
    #pragma unroll
    for(int ks=0;ks<4;++ks){
      asm volatile("ds_read_b64_tr_b16 %0,%1 offset:%c2":"=&v"(lo[ks]):"v"(vb),"i"(d0*4096+ks*1024):"memory");
      asm volatile("ds_read_b64_tr_b16 %0,%1 offset:%c2":"=&v"(hi[ks]):"v"(vb),"i"(d0*4096+ks*1024+512):"memory");}
    asm volatile("s_waitcnt lgkmcnt(0)":::"memory");SBAR();
    #define PK(k) (bf16x8){lo[k][0],lo[k][1],lo[k][2],lo[k][3],hi[k][0],hi[k][1],hi[k][2],hi[k][3]}
    o[d0]=__builtin_amdgcn_mfma_f32_32x32x16_bf16(pa0,PK(0),o[d0],0,0,0);
    o[d0]=__builtin_amdgcn_mfma_f32_32x32x16_bf16(pa1,PK(1),o[d0],0,0,0);
    o[d0]=__builtin_amdgcn_mfma_f32_32x32x16_bf16(pa2,PK(2),o[d0],0,0,0);
    o[d0]=__builtin_amdgcn_mfma_f32_32x32x16_bf16(pa3,PK(3),o[d0],0,0,0);
    #undef PK
  }
}
__device__ __forceinline__ float bfbits2f(unsigned short h){ return __builtin_bit_cast(float,(unsigned)h<<16); }

__device__ __forceinline__ void attn_unit(const bf16*Qu,const bf16*__restrict__ Kh,const bf16*__restrict__ Vh,const int NT,bf16*Ou,const bf16*Gu,const float shift,char*shm){
  const int tid=threadIdx.x,lane=tid&63,r32=lane&31,hi=lane>>5; const int wid=__builtin_amdgcn_readfirstlane(tid>>6);
  const bf16*Qw=Qu+(long)(wid*QBLK)*QP;
  const unsigned lds0=(unsigned)(uintptr_t)shm;
  float*wsf=(float*)(shm+LDS_WS)+wid*64;
  const bf16*ksrc=Kh+(long)lane*KP+wid*8;
  const bf16*vsrc=Vh+(long)(16*(wid&3)+(lane>>2))*KP+(wid>>2)*32+(lane&3)*8;
  const unsigned kdst=lds0+LDS_K+wid*1024, vdst=lds0+LDS_V+wid*1024;
  #define DMA_K(t,slot) glds16(ksrc+(long)(t)*KVBLK*KP,(unsigned)__builtin_amdgcn_readfirstlane(kdst+(slot)))
  #define DMA_V(t,slot) glds16(vsrc+(long)(t)*KVBLK*KP,(unsigned)__builtin_amdgcn_readfirstlane(vdst+(slot)))
  const int vb0=(int)(lds0+LDS_V)+((lane>>4)&1)*32+(lane&3)*8+(4*hi+((lane&15)>>2))*64;
  const char*Kbase=shm+LDS_K; bf16x8 kf[8];
  const lds_cptr shm3=(lds_cptr)shm; const lds_cptr kp0=shm3+LDS_K+hi*1024+r32*16; const lds_cptr vp0=shm3+LDS_V+((lane>>4)&1)*32+(lane&3)*8+(4*hi+((lane&15)>>2))*64;
  DMA_K(0,0);DMA_V(0,0);DMA_K(1,SLOTB);
  bf16x8 qr[4];
  #pragma unroll
  for(int d0=0;d0<4;++d0)qr[d0]=*reinterpret_cast<const bf16x8*>(&Qw[(long)r32*QP+d0*16+hi*8]);
  float l_reg=0.f;f32x16 o[2];o[0]=f32x16{};o[1]=f32x16{};f32x16 negm;
  #pragma unroll
  for(int r=0;r<16;++r)negm[r]=-shift;
  asm volatile("":"+v"(negm));
  f32x16 pA0,pA1,pB0,pB1;
  int sl_prev=0,sl_cur=0,sl_next=SLOTB;
  #define ROT() do{sl_prev=sl_cur;sl_cur=sl_next;sl_next=(sl_next==(NSLOT-1)*SLOTB)?0:sl_next+SLOTB;}while(0)
  DMA_K(2,2*SLOTB);
  WAIT_BAR(3);
  qkt(pA0,pA1,Kbase,qr,negm,r32,hi);asm volatile("s_nop 15\n\ts_nop 7":"+v"(pA0),"+v"(pA1));
  _Pragma("unroll") for(int r=0;r<16;++r)pA0[r]=__builtin_amdgcn_exp2f(pA0[r]);
  _Pragma("unroll") for(int r=0;r<16;++r)pA1[r]=__builtin_amdgcn_exp2f(pA1[r]);
  WAIT_BAR(0);
  DMA_K(3,0);DMA_V(1,SLOTB);
  ROT();
  kload8(kf,kp0+sl_cur);
  WAIT_BAR(2);
  s16x4 vlo[8],vhi[8]; u32x4 pw0,pw1,pw2,pw3;
  #define PKW(P,B) cvtpk_s(P[B],P[B+1])
  #define PAF(k) __builtin_bit_cast(bf16x8,pw##k)
  #define VFR(i) (bf16x8){vlo[i][0],vlo[i][1],vlo[i][2],vlo[i][3],vhi[i][0],vhi[i][1],vhi[i][2],vhi[i][3]}
  #define PIN(x) asm volatile("":"+v"(x))
  #define GAPA(MF,A0,A1,A2,A3,W0,W1,PW) do{ MF; sacc+=A0; sacc+=A1; sacc+=A2; sacc+=A3; PIN(sacc); W0; W1; PIN(PW); SBAR(); }while(0)
  #define EX(v) __builtin_amdgcn_exp2f(v)
  #define GAPB(MF,X,B) do{ MF; X[B]=EX(X[B]); X[B+1]=EX(X[B+1]); X[B+2]=EX(X[B+2]); X[B+3]=EX(X[B+3]); PIN(X); SBAR(); }while(0)
  #define VRD(i) do{ vlo[i]=vtr(vp_+(((i)>>2)*4096+((i)&3)*1024)); vhi[i]=vtr(vp_+(((i)>>2)*4096+((i)&3)*1024+512)); }while(0)
  #define KRD(G,j) do{ if(G){ kload2(kf,kp0+sl_next,j); SBAR(); } }while(0)
  #define STEP(C0,C1,P0,P1,t,GK,GV,GL) do{ SBAR(); \
    const lds_cptr vp_=vp0+sl_prev; \
    VRD(0); SBAR(); float sacc=(P0[0]+P0[1]); \
    GAPA(C0=__builtin_amdgcn_mfma_f32_32x32x16_bf16(kf[0],qr[0],negm,0,0,0), P0[2],P0[3],P0[4],P0[5],     pw0[0]=PKW(P0,0), pw0[1]=PKW(P0,2), pw0); \
    VRD(4); SBAR(); GAPA(C1=__builtin_amdgcn_mfma_f32_32x32x16_bf16(kf[1],qr[0],negm,0,0,0), P0[6],P0[7],P0[8],P0[9],     pw0[2]=PKW(P0,4), pw0[3]=PKW(P0,6), pw0); \
    VRD(1); SBAR(); GAPA(C0=__builtin_amdgcn_mfma_f32_32x32x16_bf16(kf[2],qr[1],C0,0,0,0),   P0[10],P0[11],P0[12],P0[13], pw1[0]=PKW(P0,8), pw1[1]=PKW(P0,10), pw1); \
    VRD(5); SBAR(); GAPA(C1=__builtin_amdgcn_mfma_f32_32x32x16_bf16(kf[3],qr[1],C1,0,0,0),   P0[14],P0[15],P1[0],P1[1],   pw1[2]=PKW(P0,12),pw1[3]=PKW(P0,14), pw1); \
    VRD(2); SBAR(); GAPA(C0=__builtin_amdgcn_mfma_f32_32x32x16_bf16(kf[4],qr[2],C0,0,0,0),   P1[2],P1[3],P1[4],P1[5],     pw2[0]=PKW(P1,0), pw2[1]=PKW(P1,2), pw2); \
    VRD(6); SBAR(); GAPA(C1=__builtin_amdgcn_mfma_f32_32x32x16_bf16(kf[5],qr[2],C1,0,0,0),   P1[6],P1[7],P1[8],P1[9],     pw2[2]=PKW(P1,4), pw2[3]=PKW(P1,6), pw2); \
    VRD(3); SBAR(); GAPA(C0=__builtin_amdgcn_mfma_f32_32x32x16_bf16(kf[6],qr[3],C0,0,0,0),   P1[10],P1[11],P1[12],P1[13], pw3[0]=PKW(P1,8), pw3[1]=PKW(P1,10), pw3); \
    VRD(7); SBAR(); GAPA(C1=__builtin_amdgcn_mfma_f32_32x32x16_bf16(kf[7],qr[3],C1,0,0,0),   P1[14],P1[15],0.f,0.f,       pw3[2]=PKW(P1,12),pw3[3]=PKW(P1,14), pw3); \
    l_reg+=sacc; \
    if(GK){DMA_K((t)+3,sl_cur);} if(GV){DMA_V((t)+1,sl_next);} \
    SBAR(); \
    GAPB(o[0]=__builtin_amdgcn_mfma_f32_32x32x16_bf16(PAF(0),VFR(0),o[0],0,0,0), C0,0); \
    GAPB(o[1]=__builtin_amdgcn_mfma_f32_32x32x16_bf16(PAF(0),VFR(4),o[1],0,0,0), C0,4); \
    KRD(GL,0); GAPB(o[0]=__builtin_amdgcn_mfma_f32_32x32x16_bf16(PAF(1),VFR(1),o[0],0,0,0), C0,8); \
    KRD(GL,1); GAPB(o[1]=__builtin_amdgcn_mfma_f32_32x32x16_bf16(PAF(1),VFR(5),o[1],0,0,0), C0,12); \
    KRD(GL,2); GAPB(o[0]=__builtin_amdgcn_mfma_f32_32x32x16_bf16(PAF(2),VFR(2),o[0],0,0,0), C1,0); \
    KRD(GL,3); GAPB(o[1]=__builtin_amdgcn_mfma_f32_32x32x16_bf16(PAF(2),VFR(6),o[1],0,0,0), C1,4); \
    GAPB(o[0]=__builtin_amdgcn_mfma_f32_32x32x16_bf16(PAF(3),VFR(3),o[0],0,0,0), C1,8); \
    GAPB(o[1]=__builtin_amdgcn_mfma_f32_32x32x16_bf16(PAF(3),VFR(7),o[1],0,0,0), C1,12); \
    }while(0)
  int t=1;
  for(;t+5<NT;t+=2){
    STEP(pB0,pB1,pA0,pA1,t,true,true,true);     WAIT_BAR(2); ROT();
    STEP(pA0,pA1,pB0,pB1,t+1,true,true,true);   WAIT_BAR(2); ROT();
  }
  #define ENDW(tt) do{ if((tt)+3<NT){WAIT_BAR(2);} else if((tt)+2<NT){WAIT_BAR(1);} else {WAIT_BAR(0);} }while(0)
  for(;t+1<NT;t+=2){
    STEP(pB0,pB1,pA0,pA1,t,(t+3<NT),(t+1<NT),(t+1<NT));       ENDW(t);   ROT();
    STEP(pA0,pA1,pB0,pB1,t+1,(t+4<NT),(t+2<NT),(t+2<NT));     ENDW(t+1); ROT();
  }
  STEP(pB0,pB1,pA0,pA1,NT-1,false,false,false);
  { float sacc=pB0[0]+pB0[1]; _Pragma("unroll") for(int r=2;r<16;++r)sacc+=pB0[r]; _Pragma("unroll") for(int r=0;r<16;++r)sacc+=pB1[r]; l_reg+=sacc;
    pw0=(u32x4){PKW(pB0,0),PKW(pB0,2),PKW(pB0,4),PKW(pB0,6)};pw1=(u32x4){PKW(pB0,8),PKW(pB0,10),PKW(pB0,12),PKW(pB0,14)};pw2=(u32x4){PKW(pB1,0),PKW(pB1,2),PKW(pB1,4),PKW(pB1,6)};pw3=(u32x4){PKW(pB1,8),PKW(pB1,10),PKW(pB1,12),PKW(pB1,14)};
    SBAR(); pv(o,vb0+sl_cur,PAF(0),PAF(1),PAF(2),PAF(3)); }
  #undef PKW
  #undef PAF
  #undef VFR
  #undef PIN
  #undef GAPA
  #undef GAPB
  #undef EX
  #undef VRD
  #undef KRD
  #undef STEP
  #undef ENDW
  {auto rr=__builtin_amdgcn_permlane32_swap(__float_as_uint(l_reg),__float_as_uint(l_reg),false,false);l_reg=__uint_as_float(rr[0])+__uint_as_float(rr[1]);}
  if(hi==0)wsf[32+r32]=l_reg;asm volatile("s_waitcnt lgkmcnt(0)":::"memory");
  float rli[16];
  #pragma unroll
  for(int r=0;r<16;++r)rli[r]=__builtin_amdgcn_rcpf(wsf[32+crow(r,hi)]);
  bf16*Ow=Ou+(long)(wid*QBLK)*OP; const bf16*Gw=Gu+(long)(wid*QBLK)*GP;
  { bf16*stg=(bf16*)(shm+LDS_OST)+wid*2048;
    #pragma unroll
    for(int r=0;r<16;++r){const int orow=crow(r,hi);
      #pragma unroll
      for(int d0=0;d0<2;++d0)stg[orow*64+d0*32+r32]=__float2bfloat16(o[d0][r]*rli[r]);}
    asm volatile("s_waitcnt lgkmcnt(0)":::"memory");
    #pragma unroll
    for(int i=0;i<4;++i){const int row=i*8+(lane>>3),ch=lane&7; const u32x4 v=*(const u32x4*)(stg+row*64+ch*8); const u32x4 gq=*(const u32x4*)(Gw+(long)row*GP+ch*8);
      u32x4 w;
      #pragma unroll
      for(int e=0;e<4;++e){ const float a0=bfbits2f((unsigned short)(v[e]&0xffffu))*bfbits2f((unsigned short)(gq[e]&0xffffu)), a1=bfbits2f((unsigned short)(v[e]>>16))*bfbits2f((unsigned short)(gq[e]>>16)); w[e]=cvtpk_s(a0,a1); }
      *(u32x4*)(Ow+(long)row*OP+ch*8)=w;} }
  asm volatile("s_waitcnt lgkmcnt(0)\n\ts_barrier":::"memory");
  #undef DMA_K
  #undef DMA_V
  #undef ROT
}
constexpr int ATTN_LDS_BYTES=LDS_BYTES;
#undef SBAR
#undef WAIT_BAR
}

__device__ __forceinline__ void p3a_fourier_s1(Frame& F) {
    using abf = attn_body::bf16;
    for (int v = F.vcu; v < 256; v += F.G) {
        fourier_s1_pair(F, v, v + 256);
        if (v < 16) fourier_ctx_item(F, v);
        else if (v < 64) {
            const int u = v - 16; const int b2 = u / 12, hq = u % 12, hk2 = hq / 3; const size_t row0 = (size_t)MLAT + (size_t)b2 * CTXL;
            const abf* Q0 = (const abf*)(F.ws + WS_Q0); const abf* KA = (const abf*)(F.ws + WS_KALL); const abf* VA = (const abf*)(F.ws + WS_VALL);
            __syncthreads();
            attn_body::attn_unit(Q0 + row0 * 768 + hq * 64, KA + (size_t)b2 * NKEYS * 256 + hk2 * 64, VA + (size_t)b2 * NKEYS * 256 + hk2 * 64, CTXL / 64,
                                 (abf*)(F.ws + WS_Y) + row0 * 1024 + hq * 64, (const abf*)(F.ws + WS_GA) + row0 * 768 + hq * 64, ((const float*)(F.ws + WS_MISCF))[0], (char*)(F.lds + RING_OFF));
        }
    }
}
__device__ __forceinline__ void p3_even_mixers(Frame& F) {
    using abf = attn_body::bf16;
    const abf* Q0 = (const abf*)(F.ws + WS_Q0); const abf* KA = (const abf*)(F.ws + WS_KALL); const abf* VA = (const abf*)(F.ws + WS_VALL);
    const abf* GA = (const abf*)(F.ws + WS_GA); abf* Y = (abf*)(F.ws + WS_Y);
    const float shift = ((const float*)(F.ws + WS_MISCF))[0];
    char* shm = (char*)(F.lds + RING_OFF);
    for (int v = F.vcu; v < 256; v += F.G) {
        for (int k = 0; k < 4; ++k) fourier_s2_item(F, v + 256 * k);
        const int pair = v >> 4, b = pair >> 2, hk = pair & 3;
        for (int i = 0; i < 6; ++i) {
            const int j = (v & 15) * 6 + i; const int hq = hk * 3 + (j >> 5), qb = j & 31;
            const size_t row0 = (size_t)b * SEQ + (size_t)qb * 256;
            attn_body::attn_unit(Q0 + row0 * 768 + hq * 64, KA + (size_t)b * NKEYS * 256 + hk * 64, VA + (size_t)b * NKEYS * 256 + hk * 64, NKEYS / 64,
                                 Y + row0 * 1024 + hq * 64, GA + row0 * 768 + hq * 64, shift, shm);
        }
    }
}

__device__ __forceinline__ int chain_slot(int dir, int step) { return dir == 0 ? step : (step == 0 ? 1 : (step == 1 ? 0 : 67 - step)); }

typedef short s16x4 __attribute__((ext_vector_type(4)));
__device__ __forceinline__ void p7_mlstm_prep(Frame& F) {
    LAS unsigned char* L = F.lds + RING_OFF;
    LAS float* msh = (LAS float*)(F.lds + RING_BYTES + 1024);
    int lane = F.lane, w = F.wave; asm volatile("" : "+v"(lane), "+s"(w));
    const int tid = w * 64 + lane;
    const float* TOT = (const float*)(F.ws + WS_TOT); const float* AMAX = (const float*)(F.ws + WS_AMAX);
    float totA = 0.f, amxA = 0.f, totB = 0.f, amxB = 0.f, aval = 0.f; v4u qn[8], kn[8];
#define P7_LOAD(ITX) do { const int itx_ = (ITX); const int bh_ = itx_ >> 6, slot_ = 2 + (itx_ & 63); const size_t it_ = (size_t)(bh_ * NSLOT + slot_); \
        if (w < 2) { const int cd_ = w * 16 + bh_; const int sA_ = chain_slot(w, lane), sB_ = chain_slot(w, 64 + (lane & 1)); \
            totA = TOT[cd_ * NSLOT + sA_]; amxA = AMAX[cd_ * NSLOT + sA_]; totB = TOT[cd_ * NSLOT + sB_]; amxB = AMAX[cd_ * NSLOT + sB_]; } \
        if (tid >= 256) { const int dir_ = (tid - 256) >> 7, s2_ = tid & 127, cd_ = dir_ * 16 + bh_; aval = ((const float*)(F.ws + WS_AA))[((size_t)cd_ * NSLOT + slot_) * 128 + s2_]; } \
        const bf16* kb_ = (const bf16*)(F.ws + WS_KB) + it_ * 32768; const bf16* qb_ = (const bf16*)(F.ws + WS_QB) + it_ * 32768; \
        _Pragma("unroll") for (int ks = 0; ks < 8; ++ks) qn[ks] = *(const GAS v4u*)(qb_ + ((w * 8 + ks) * 64 + lane) * 8); \
        _Pragma("unroll") for (int i = 0; i < 8; ++i) kn[i] = *(const GAS v4u*)(kb_ + (size_t)(tid + 512 * i) * 8); } while (0)
    if (F.vcu < 1024) P7_LOAD(F.vcu);
    for (int itx = F.vcu; itx < 1024; itx += F.G) {
        const int bh = itx >> 6, slot = 2 + (itx & 63);
        __syncthreads();
        v4u qf[8];
#pragma unroll
        for (int ks = 0; ks < 8; ++ks) qf[ks] = qn[ks];
        {
          if (w < 2) {
              const int dir = w;
              const int pos = (dir == 0) ? slot : (slot == 1 ? 0 : (slot == 0 ? 1 : 67 - slot));
              float A = totA, B = amxA + totA;
#pragma unroll
              for (int d = 1; d < 64; d <<= 1) { const float Ap = __shfl_up(A, d), Bp = __shfl_up(B, d); if (lane >= d) { B = fmaxf(Bp + A, B); A = Ap + A; } }
              float m = 0.f;
              if (pos >= 1) { const int pl = (pos - 1 < 63) ? (pos - 1) : 63;
                  float Am = __builtin_bit_cast(float, __builtin_amdgcn_readlane(__builtin_bit_cast(int, A), pl)), Bm = __builtin_bit_cast(float, __builtin_amdgcn_readlane(__builtin_bit_cast(int, B), pl));
                  if (pos == 65) { const float t64 = __builtin_bit_cast(float, __builtin_amdgcn_readlane(__builtin_bit_cast(int, totB), 0)), x64 = __builtin_bit_cast(float, __builtin_amdgcn_readlane(__builtin_bit_cast(int, amxB), 0));
                      Bm = fmaxf(Bm + t64, x64 + t64); Am = Am + t64; }
                  m = fmaxf(Am, Bm); }
              if (lane == 0) msh[dir] = m;
          }
          if (tid >= 256) msh[512 + ((tid - 256) >> 7) * 128 + (tid & 127)] = aval;
#pragma unroll
          for (int i = 0; i < 8; ++i) *(LAS v4u*)(L + (tid + 512 * i) * 16) = kn[i]; }
        __syncthreads();
        if (itx + F.G < 1024) P7_LOAD(itx + F.G);
        {
            const int chunk = slot - 2; const int c = lane & 15, g4 = lane >> 4;
            const int tl = 16 * w + c;
            const LAS unsigned char* kl = L + ((c & 3) >> 1) * 256 + (4 * g4 + (c >> 2)) * 16 + 8 * (c & 1);
            float Mt[2];
#pragma unroll
            for (int dir = 0; dir < 2; ++dir) { const int cd = dir * 16 + bh; Mt[dir] = fmaxf(msh[dir], ((const float*)(F.ws + WS_PM))[((size_t)cd * NSLOT + slot) * 128 + tl]); }
#pragma unroll 2
            for (int nt = 0; nt < 8; ++nt) {
                f32x4 acc = {0.f, 0.f, 0.f, 0.f};
                const LAS unsigned char* kn = kl + (nt >> 1) * 1024 + (nt & 1) * 512;
#pragma unroll
                for (int ks = 0; ks < 8; ++ks) {
                    const s16x4 t0 = __builtin_amdgcn_ds_read_tr16_b64_v4i16((LAS s16x4*)(kn + ks * 8192)), t1 = __builtin_amdgcn_ds_read_tr16_b64_v4i16((LAS s16x4*)(kn + ks * 8192 + 4096));
                    const bf16x8 kf = __builtin_shufflevector(t0, t1, 0, 1, 2, 3, 4, 5, 6, 7);
                    acc = __builtin_amdgcn_mfma_f32_16x16x32_bf16(kf, __builtin_bit_cast(bf16x8, qf[ks]), acc, 0, 0, 0); }
                const int s0 = 16 * nt + 4 * g4;
#pragma unroll
                for (int dir = 0; dir < 2; ++dir) { const int cd = dir * 16 + bh;
                    if (dir == 0 ? ((nt >> 1) > (w >> 1)) : ((nt >> 1) < (w >> 1))) continue;
                    const f32x4 a4 = *(const LAS f32x4*)(msh + 512 + dir * 128 + s0);
                    float v[4];
#pragma unroll
                    for (int r = 0; r < 4; ++r) { const int s2 = s0 + r; const bool on = dir ? (s2 >= tl) : (s2 <= tl); v[r] = on ? acc[r] * __expf(a4[r] - Mt[dir]) : 0.f; }
                    unsigned long long pk8 = (unsigned long long)pk2(v[0], v[1]) | ((unsigned long long)pk2(v[2], v[3]) << 32);
                    unsigned long long* so = (unsigned long long*)((bf16*)(F.ws + WS_S) + ((size_t)(dir * 16 + bh) * 64 + chunk) * 16384);
                    so[(((w * 4 + (nt >> 1)) * 64 + (2 * (nt & 1) + (g4 >> 1)) * 16 + c) * 2) + (g4 & 1)] = pk8; }
            }
        }
    }
#undef P7_LOAD
}

__device__ __forceinline__ void p8_mlstm_scan(Frame& F) {
    LAS unsigned char* CB0 = F.lds + RING_OFF;
    LAS unsigned char* OST = F.lds + RING_OFF + 49152;
    LAS unsigned char* VL = F.lds + RING_OFF + 61440;
    LAS float* msh = (LAS float*)(F.lds + RING_BYTES + 1024);
    int lane = F.lane, w = F.wave; asm volatile("" : "+v"(lane), "+s"(w));
    const int c = lane & 15, g4 = lane >> 4, tid = w * 64 + lane;
    const float* TOT = (const float*)(F.ws + WS_TOT); const float* AMAX = (const float*)(F.ws + WS_AMAX);
    for (int v = F.vcu; v < 256; v += F.G) {
        const int sl = v & 7, cd = v >> 3, dir = cd >> 4, bh = cd & 15, b = bh >> 2, h = bh & 3;
        __syncthreads();
        if (tid < NSLOT) { msh[256 + tid] = TOT[cd * NSLOT + tid]; msh[384 + tid] = AMAX[cd * NSLOT + tid]; }
        __syncthreads();
        if (tid == 0) { float m = 0.f; for (int st = 0; st < NSLOT; ++st) { const int s = chain_slot(dir, st); msh[s] = m; const float M = fmaxf(m, msh[384 + s]); msh[128 + s] = M; m = msh[256 + s] + M; } }
        __syncthreads();
        f32x4 C[2][3];
#pragma unroll
        for (int mt = 0; mt < 2; ++mt)
#pragma unroll
            for (int nt = 0; nt < 3; ++nt) C[mt][nt] = (f32x4){0.f, 0.f, 0.f, 0.f};
        bf16* Hout = (bf16*)(F.ws + (dir ? WS_HB : WS_HF));
        const int pnt = tid >> 8, pks = (tid >> 6) & 3, pc = tid & 15, pkg = (tid >> 4) & 3;
        v4u stg_v; float stg_a = 0.f;
        LAS float* wtab = (LAS float*)(F.lds + RING_BYTES + 4096);
#define P8_STAGE_LOAD(ST) do { const int slot_ = chain_slot(dir, (ST)); const size_t it_ = (size_t)bh * NSLOT + slot_; \
            stg_v = *(const GAS v4u*)((const bf16*)(F.ws + WS_VB) + it_ * 32768 + (size_t)sl * 4096 + tid * 8); \
            } while (0)
#define P8_A_LOAD(ST) do { if (tid < 128 && (ST) < NSLOT) stg_a = ((const float*)(F.ws + WS_AA))[((size_t)cd * NSLOT + chain_slot(dir, (ST))) * 128 + tid]; } while (0)
#define P8_W_WRITE(ST) do { if (tid < 128) wtab[((ST) & 1) * 128 + tid] = __expf(stg_a - msh[128 + chain_slot(dir, (ST))]); } while (0)
#define P8_STAGE_WRITE(ST) do { \
            LAS unsigned char* vb_ = VL + ((ST) & 1) * 20480; float wv_[8]; \
            { const LAS float* wt_ = wtab + ((ST) & 1) * 128 + 32 * pks + 8 * pkg; const f32x4 w0_ = *(const LAS f32x4*)wt_, w1_ = *(const LAS f32x4*)(wt_ + 4); \
              _Pragma("unroll") for (int j = 0; j < 4; ++j) { wv_[j] = w0_[j]; wv_[4 + j] = w1_[j]; } } \
            v4u sc_; _Pragma("unroll") for (int e = 0; e < 4; ++e) { const float lo_ = __builtin_bit_cast(float, stg_v[e] << 16) * wv_[2 * e], hi_ = __builtin_bit_cast(float, stg_v[e] & 0xffff0000u) * wv_[2 * e + 1]; sc_[e] = pk2(lo_, hi_); } \
            *(LAS v4u*)(vb_ + tid * 16) = stg_v; *(LAS v4u*)(vb_ + 8192 + tid * 16) = sc_; \
            if (pnt == 0) { v4u wf_; wf_.x = pk2(wv_[0], wv_[1]); wf_.y = pk2(wv_[2], wv_[3]); wf_.z = pk2(wv_[4], wv_[5]); wf_.w = pk2(wv_[6], wv_[7]); \
                *(LAS v4u*)(vb_ + 16384 + (tid & 255) * 16) = wf_; } } while (0)
        v4u qf[8]; bf16x8 sf[4];
        const int kslo = dir ? (w >> 1) : 0, kshi = dir ? 3 : (w >> 1);
#define P8_Q_LOAD(ST) do { const int slot_ = chain_slot(dir, (ST)); const size_t it_ = (size_t)bh * NSLOT + slot_; \
            const bf16* qfr_ = (const bf16*)(F.ws + WS_QB) + it_ * 32768 + (size_t)w * 4096 + lane * 8; \
            _Pragma("unroll") for (int ks = 0; ks < 8; ++ks) qf[ks] = *(const GAS v4u*)(qfr_ + ks * 512); } while (0)
#define P8_S_LOAD(ST) do { const int slot_ = chain_slot(dir, (ST)); \
            const bf16* Sfr_ = (const bf16*)(F.ws + WS_S) + ((size_t)(dir * 16 + bh) * 64 + (slot_ - 2)) * 16384 + (size_t)w * 2048 + lane * 8; \
            _Pragma("unroll") for (int ks = 0; ks < 4; ++ks) if (ks >= kslo && ks <= kshi) sf[ks] = *(const bf16x8*)(Sfr_ + ks * 512); } while (0)
        P8_A_LOAD(0); P8_STAGE_LOAD(0); P8_W_WRITE(0); P8_A_LOAD(1); __syncthreads(); P8_STAGE_WRITE(0);
        __syncthreads();
        for (int st = 0; st < NSLOT; ++st) {
            const int slot = chain_slot(dir, st); const size_t it = (size_t)bh * NSLOT + slot;
            const bf16* kT = (const bf16*)(F.ws + WS_KB) + it * 32768;
            const float* cumv = (const float*)(F.ws + WS_CUM) + ((size_t)cd * NSLOT + slot) * 128; const float* pmv = (const float*)(F.ws + WS_PM) + ((size_t)cd * NSLOT + slot) * 128;
            const float m_in = msh[slot]; const float M = msh[128 + slot]; const float decay = __expf(m_in - M);
            LAS unsigned char* vb = VL + (st & 1) * 20480; LAS unsigned char* CB = CB0 + (st & 1) * 24576;
            f32x4 p4 = {0.f, 0.f, 0.f, 0.f}, c4 = {0.f, 0.f, 0.f, 0.f};
            if (st >= 2) { p4 = *(const f32x4*)(pmv + 16 * w + 4 * g4); c4 = *(const f32x4*)(cumv + 16 * w + 4 * g4); }
            bf16x8 kf[2][4];
#pragma unroll
            for (int mt = 0; mt < 2; ++mt)
#pragma unroll
                for (int ks = 0; ks < 4; ++ks) kf[mt][ks] = *(const bf16x8*)(kT + (size_t)((w * 2 + mt) * 4 + ks) * 512 + lane * 8);
            if (st + 1 < NSLOT) { P8_W_WRITE(st + 1); P8_STAGE_LOAD(st + 1); }
            P8_A_LOAD(st + 2);
            if (st < 2) __syncthreads();
            if (st >= 2) {
                const int chunk = slot - 2;
#pragma unroll
                for (int nt = 0; nt < 3; ++nt) { v4u f; f.x = pk2m(C[0][nt][0], C[0][nt][1]); f.y = pk2m(C[0][nt][2], C[0][nt][3]); f.z = pk2m(C[1][nt][0], C[1][nt][1]); f.w = pk2m(C[1][nt][2], C[1][nt][3]);
                    *(LAS v4u*)(CB + ((w * 3 + nt) * 64 + lane) * 16) = f; }
                __syncthreads();
                f32x4 acc[3] = {{0.f, 0.f, 0.f, 0.f}, {0.f, 0.f, 0.f, 0.f}, {0.f, 0.f, 0.f, 0.f}};
                {
                    bf16x8 cbf[3][3];
#pragma unroll
                    for (int pk = 0; pk < 2; ++pk)
#pragma unroll
                        for (int nt = 0; nt < 3; ++nt) cbf[pk][nt] = *(const LAS bf16x8*)(CB + ((pk * 3 + nt) * 64 + lane) * 16);
#pragma unroll
                    for (int ks = 0; ks < 8; ++ks) { const bf16x8 qa = __builtin_bit_cast(bf16x8, qf[ks]);
                        if (ks + 2 < 8) {
#pragma unroll
                            for (int nt = 0; nt < 3; ++nt) cbf[(ks + 2) % 3][nt] = *(const LAS bf16x8*)(CB + (((ks + 2) * 3 + nt) * 64 + lane) * 16); }
#pragma unroll
                        for (int nt = 0; nt < 3; ++nt) acc[nt] = __builtin_amdgcn_mfma_f32_16x16x32_bf16(qa, cbf[ks % 3][nt], acc[nt], 0, 0, 0);
                        __builtin_amdgcn_sched_barrier(0);
                    }
                }
                if (st + 1 < NSLOT) P8_Q_LOAD(st + 1);
                float Mt[4], iw[4];
#pragma unroll
                for (int r = 0; r < 4; ++r) { Mt[r] = fmaxf(m_in, p4[r]); iw[r] = __expf(m_in - Mt[r]); }
#pragma unroll
                for (int nt = 0; nt < 3; ++nt)
#pragma unroll
                    for (int r = 0; r < 4; ++r) acc[nt][r] *= iw[r];
                const bf16x8 ones = (bf16x8){0x3F80, 0x3F80, 0x3F80, 0x3F80, 0x3F80, 0x3F80, 0x3F80, 0x3F80};
#pragma unroll
                for (int ks = 0; ks < 4; ++ks) if (ks >= kslo && ks <= kshi) {
                    const bf16x8 v0 = *(const LAS bf16x8*)(vb + ((0 * 4 + ks) * 64 + lane) * 16), v1 = *(const LAS bf16x8*)(vb + ((1 * 4 + ks) * 64 + lane) * 16);
                    acc[0] = __builtin_amdgcn_mfma_f32_16x16x32_bf16(sf[ks], v0, acc[0], 0, 0, 0);
                    acc[1] = __builtin_amdgcn_mfma_f32_16x16x32_bf16(sf[ks], v1, acc[1], 0, 0, 0);
                    acc[2] = __builtin_amdgcn_mfma_f32_16x16x32_bf16(sf[ks], ones, acc[2], 0, 0, 0); }
                if (st + 1 < NSLOT) P8_S_LOAD(st + 1);
                {
                    LAS unsigned short* ost = (LAS unsigned short*)(OST + w * 1280);
#pragma unroll
                    for (int r = 0; r < 4; ++r) { const float den = acc[2][r]; const float dn = fmaxf(fabsf(den), __expf(-c4[r] - Mt[r])); const float inv = __builtin_amdgcn_rcpf(dn);
                        const unsigned pr = pk2(acc[0][r] * inv, acc[1][r] * inv);
                        ost[(4 * g4 + r) * 40 + c] = (unsigned short)(pr & 0xffffu); ost[(4 * g4 + r) * 40 + 16 + c] = (unsigned short)(pr >> 16); }
                    asm volatile("s_waitcnt lgkmcnt(0)" ::: "memory");
                    const int orow = lane >> 2, och = lane & 3;
                    const v4u ov = *(const LAS v4u*)(OST + w * 1280 + orow * 80 + och * 16);
                    *(GAS v4u*)(Hout + ((size_t)b * SEQ + (size_t)chunk * 128 + 16 * w + orow) * 1024 + h * 256 + 32 * sl + 8 * och) = ov;
                }
            }
            if (st == 1) { P8_Q_LOAD(2); P8_S_LOAD(2); }
#pragma unroll
            for (int mt = 0; mt < 2; ++mt)
#pragma unroll
                for (int nt = 0; nt < 3; ++nt) C[mt][nt] = C[mt][nt] * decay;
#pragma unroll
            for (int ks = 0; ks < 4; ++ks) {
                const bf16x8 b0 = *(const LAS bf16x8*)(vb + 8192 + ((0 * 4 + ks) * 64 + lane) * 16), b1 = *(const LAS bf16x8*)(vb + 8192 + ((1 * 4 + ks) * 64 + lane) * 16), b2 = *(const LAS bf16x8*)(vb + 16384 + (ks * 64 + lane) * 16);
#pragma unroll
                for (int mt = 0; mt < 2; ++mt) { C[mt][0] = __builtin_amdgcn_mfma_f32_16x16x32_bf16(kf[mt][ks], b0, C[mt][0], 0, 0, 0); C[mt][1] = __builtin_amdgcn_mfma_f32_16x16x32_bf16(kf[mt][ks], b1, C[mt][1], 0, 0, 0);
                    C[mt][2] = __builtin_amdgcn_mfma_f32_16x16x32_bf16(kf[mt][ks], b2, C[mt][2], 0, 0, 0); }
            }
            if (st + 1 < NSLOT) P8_STAGE_WRITE(st + 1);
            if (st < 2) __syncthreads();
        }
#undef P8_STAGE_LOAD
#undef P8_STAGE_WRITE
#undef P8_W_WRITE
#undef P8_A_LOAD
#undef P8_Q_LOAD
#undef P8_S_LOAD
    }
}

__device__ __forceinline__ void p9_mlstm_merge(Frame& F) {
    const GAS v4u* og = (const GAS v4u*)(F.ws + WS_OG); const GAS v4u* hf = (const GAS v4u*)(F.ws + WS_HF); const GAS v4u* hb = (const GAS v4u*)(F.ws + WS_HB); GAS v4u* y = (GAS v4u*)(F.ws + WS_YMIX);
    const size_t n16 = (size_t)MLAT * 1024 * 2 / 16; const size_t g0 = (size_t)(F.vcu * NWAVES * 64 + F.tid), gs = (size_t)F.G * NWAVES * 64;
    for (size_t i = g0; i < n16; i += gs) { const v4u a = og[i], p = hf[i], q = hb[i]; v4u o;
#pragma unroll
        for (int e = 0; e < 4; ++e) { const float lo = __builtin_bit_cast(float, a[e] << 16) * (__builtin_bit_cast(float, p[e] << 16) + __builtin_bit_cast(float, q[e] << 16));
            const float hi2 = __builtin_bit_cast(float, a[e] & 0xffff0000u) * (__builtin_bit_cast(float, p[e] & 0xffff0000u) + __builtin_bit_cast(float, q[e] & 0xffff0000u)); o[e] = pk2(lo, hi2); }
        y[i] = o; }
}

constexpr int N_PHASES = 12;
#ifndef MK_N_LAUNCHES
#define MK_N_LAUNCHES 1
#endif
struct Args { const float* in[17]; float* out; unsigned char* ws; int ph_lo, ph_hi, li, pad; };
__global__ void __launch_bounds__(NWAVES * 64, 2) hyb_fwd(Args args) {
    extern __shared__ __attribute__((aligned(16))) unsigned char lds[];
    Frame F;
    F.lds = (LAS unsigned char*)lds;
    F.MISC = (volatile LAS unsigned*)(F.lds + MISC_OFF);
    F.tid = threadIdx.x; F.lane = F.tid & 63; F.wave = __builtin_amdgcn_readfirstlane(F.tid >> 6);
    F.G = gridDim.x; { const int bx = blockIdx.x; F.vcu = (F.G % 8 == 0) ? (bx % 8) * (F.G / 8) + bx / 8 : bx; }
    F.ws = args.ws; F.ctl = (gu32*)(args.ws + WS_CTL);
    F.x = args.in[0]; F.c = args.in[1]; F.ctx = args.in[2]; F.c_ctx = args.in[3]; F.ada_w = args.in[4]; F.ada_b = args.in[5]; F.pgain = args.in[6]; F.pbias = args.in[7];
    F.w0 = args.in[8]; F.qgain = args.in[9]; F.kgain = args.in[10]; F.fgain = args.in[11]; F.wfmix = args.in[12]; F.wo0 = args.in[13]; F.w1 = args.in[14]; F.gbias = args.in[15]; F.wo1 = args.in[16];
    F.out = args.out;
    for (int u = F.tid; u < (LDS_BYTES - LDSCTL_OFF) / 4; u += NWAVES * 64) ((LAS unsigned*)(F.lds + LDSCTL_OFF))[u] = 0u;
    __syncthreads();
    XcdBarrier bar = xcd_barrier_post((unsigned*)(F.ctl + CW_BAR) + args.li * XCD_BAR_WORDS, F.MISC + 8);
    const int lo = args.ph_lo, hi = args.ph_hi;
#define IN(k) (lo <= (k) && (k) < hi)
#define SEAM(k) do { if (IN(k) && IN((k) + 1)) xcd_barrier(bar); } while (0)
    unsigned char* ws = args.ws;
    const float* mod = (const float*)(ws + WS_MOD);

    if (IN(0)) { p0_tables(F); } SEAM(0);
    if (IN(1)) { p1_h0_rows(F); } SEAM(1);
    if (IN(2)) {
        pg8::Gemm g{(const pg8::bf16_t*)(ws + WS_H), (const pg8::bf16_t*)(ws + WS_W0T), MTOT, EVEN_N, 1024}; pg8::StaticOrder S; S.init(MTOT, EVEN_N, F.G, (int)blockIdx.x);
        epi::EpiEven E{(pg8::bf16_t*)(ws + WS_Q0),
                       F.qgain, F.kgain, F.fgain, (const float*)(ws + WS_ROPE)};
        pg8::gemm_phase<epi::EpiEven, pg8::StaticOrder, true, true>(F.lds + RING_OFF, g, S, E);
    } SEAM(2);
    if (IN(3)) { p3a_fourier_s1(F); xcd_barrier(bar);
        p3_even_mixers(F);
    } SEAM(3);
    if (IN(4)) {
        pg8::Gemm g{(const pg8::bf16_t*)(ws + WS_Y), (const pg8::bf16_t*)(ws + WS_WO0T), MTOT, 1024, 1024}; pg8::StaticOrder S; S.init(MTOT, 1024, F.G, (int)blockIdx.x);
        epi::EpiGate E{(pg8::bf16_t*)(ws + WS_GY), mod};
        pg8::gemm_phase<epi::EpiGate, pg8::StaticOrder, true, true>(F.lds + RING_OFF, g, S, E);
    } SEAM(4);
    if (IN(5)) { p5_rowpass(F); } SEAM(5);
    if (IN(6)) {
        gate_scans(F);
        pg8::Gemm g{(const pg8::bf16_t*)(ws + WS_H), (const pg8::bf16_t*)(ws + WS_W1T), MTOT, ODD_N, 1024}; pg8::StaticOrder S; S.init(MTOT, ODD_N, F.G, (int)blockIdx.x);
        epi::EpiOdd E{(pg8::bf16_t*)(ws + WS_QB), (pg8::bf16_t*)(ws + WS_OG)};
        pg8::gemm_phase<epi::EpiOdd, pg8::StaticOrder, true, true>(F.lds + RING_OFF, g, S, E);
    } SEAM(6);
    if (IN(7)) { p7_mlstm_prep(F); } SEAM(7);
    if (IN(8)) { p8_mlstm_scan(F);
    } SEAM(8);
    if (IN(9)) { p9_mlstm_merge(F); } SEAM(9);
    if (IN(10)) {
        pg8::Gemm g{(const pg8::bf16_t*)(ws + WS_YMIX), (const pg8::bf16_t*)(ws + WS_WO1T), MLAT, 1024, 1024}; pg8::StaticOrder S; S.init(MLAT, 1024, F.G, (int)blockIdx.x);
        epi::EpiGate E{(pg8::bf16_t*)(ws + WS_GY), mod + 5 * 3072};
        pg8::gemm_phase<epi::EpiGate, pg8::StaticOrder, true, true>(F.lds + RING_OFF, g, S, E);
    } SEAM(10);
    if (IN(11)) { p11_final_ln(F); }
#undef IN
#undef SEAM
}

extern "C" void kernel_launch(void* const* d_in, const int* in_sizes, int n_in, void* d_out, int out_size, void* d_ws, size_t ws_size, hipStream_t stream) {
    static int grid = 0;
    if (grid == 0) {
        if (n_in != 17 || in_sizes[0] != MLAT * 1024 || out_size != MLAT * 1024 || ws_size < WS_END) {
            fprintf(stderr, "kernel_launch: unexpected problem (n_in %d, in0 %d, out %d, ws %zu; need ws >= %zu); nothing launched\n", n_in, n_in > 0 ? in_sizes[0] : -1, out_size, ws_size, (size_t)WS_END); grid = -1; return; }
        int dev = 0, cus = 0, per_cu = 0;
        if (hipGetDevice(&dev) != hipSuccess || hipDeviceGetAttribute(&cus, hipDeviceAttributeMultiprocessorCount, dev) != hipSuccess) { fprintf(stderr, "kernel_launch: device query failed\n"); grid = -1; return; }
        if (hipFuncSetAttribute((const void*)hyb_fwd, hipFuncAttributeMaxDynamicSharedMemorySize, LDS_BYTES) != hipSuccess) { fprintf(stderr, "kernel_launch: hipFuncSetAttribute failed\n"); grid = -1; return; }
        if (hipOccupancyMaxActiveBlocksPerMultiprocessor(&per_cu, (const void*)hyb_fwd, NWAVES * 64, LDS_BYTES) != hipSuccess || per_cu < 1)
            fprintf(stderr, "kernel_launch: note: occupancy query reports %d workgroups per CU\n", per_cu);
        (void)hipGetLastError();
        grid = cus;
    }
    if (grid < 0) return;
    if (hipMemsetAsync((char*)d_ws + WS_CTL, 0, CTL_ZERO_BYTES, stream) != hipSuccess) { fprintf(stderr, "kernel_launch: hipMemsetAsync failed\n"); return; }
    Args a{};
    for (int i = 0; i < 17; ++i) a.in[i] = (const float*)d_in[i];
    a.out = (float*)d_out; a.ws = (unsigned char*)d_ws;
    constexpr int NL = MK_N_LAUNCHES;
    static_assert(NL == 1 || NL == N_PHASES, "MK_N_LAUNCHES: 1 (one launch) or 12 (one launch per phase)");
    for (int li = 0; li < NL; ++li) {
        a.ph_lo = (NL == 1) ? 0 : li; a.ph_hi = (NL == 1) ? N_PHASES : li + 1; a.li = (NL == 1) ? 0 : 1 + li;
        hipLaunchKernelGGL(hyb_fwd, dim3(grid), dim3(NWAVES * 64), LDS_BYTES, stream, a);
        const hipError_t le = hipPeekAtLastError();
        if (le != hipSuccess) { fprintf(stderr, "kernel_launch: launch %d failed: %s\n", li, hipGetErrorName(le)); break; }
    }
}
```
